# Optimizing an MI355X kernel written in HIP

```python
import jax, jax.numpy as jnp
from jax import lax
import numpy as np

D_MODEL = 1024
BATCH = 8
SEQ = 2048
DEPTH = 2

MEM_LEN = 256
GROUP_WIDTH = D_MODEL // 2
D_MIX = 3 * GROUP_WIDTH
MOBA_HEAD_DIM = 64
MOBA_HEADS = GROUP_WIDTH // MOBA_HEAD_DIM
MOBA_BLOCK = 256
MOBA_TOPK = 3
MOBA_Q_CHUNK = 16
HGRN_HEAD_DIM = 128
HGRN_HEADS = GROUP_WIDTH // HGRN_HEAD_DIM
HGRN_CHUNK = 64
MEM_HEAD_DIM = 128
MEM_HEADS = GROUP_WIDTH // MEM_HEAD_DIM
ROPE_THETA = 500000.0
ROPE_DIM = MOBA_HEAD_DIM // 4
NORM_EPS = 1e-6
IN_COLS = 3 * GROUP_WIDTH + 3 * GROUP_WIDTH + GROUP_WIDTH + D_MIX

kernel_name = "hymba_moba_hgrn2_memxattn_block"


def rms_norm(x, g):
    xf = x.astype(jnp.float32)
    y = xf * lax.rsqrt(jnp.mean(xf * xf, axis=-1, keepdims=True) + NORM_EPS)
    return (y * g.astype(jnp.float32)).astype(x.dtype)


def partial_rope(x, positions):
    half = ROPE_DIM // 2
    inv_freq = ROPE_THETA ** (-jnp.arange(half, dtype=jnp.float32) / half)
    ang = positions.astype(jnp.float32)[..., None] * inv_freq
    cos = jnp.cos(ang)[:, :, None, :]
    sin = jnp.sin(ang)[:, :, None, :]
    xr = x[..., :ROPE_DIM].astype(jnp.float32)
    x1, x2 = xr[..., :half], xr[..., half:]
    rot = jnp.concatenate([x1 * cos - x2 * sin, x2 * cos + x1 * sin], axis=-1).astype(x.dtype)
    return jnp.concatenate([rot, x[..., ROPE_DIM:]], axis=-1)


def moba_attention(q, k, v):
    B, S, H, D = q.shape
    BLK, QC = MOBA_BLOCK, MOBA_Q_CHUNK
    nb = -(-S // BLK)
    pad = nb * BLK - S
    topk = min(MOBA_TOPK, nb)
    kbh = jnp.pad(k, ((0, 0), (0, pad), (0, 0), (0, 0))).reshape(B, nb, BLK, H, D).transpose(0, 3, 1, 2, 4)
    vbh = jnp.pad(v, ((0, 0), (0, pad), (0, 0), (0, 0))).reshape(B, nb, BLK, H, D).transpose(0, 3, 1, 2, 4)
    kmean = jnp.mean(kbh.astype(jnp.float32), axis=3)
    scale = D ** -0.5
    nqc = S // QC
    qch = q.reshape(B, nqc, QC, H, D).transpose(1, 0, 3, 2, 4)
    bi = jnp.arange(B)[:, None, None, None]
    hi = jnp.arange(H)[None, :, None, None]
    blk_ids = jnp.arange(nb)

    def one_chunk(args):
        ci, qi = args
        start = ci * QC
        own = start // BLK
        qpos = start + jnp.arange(QC)
        gate = jnp.einsum('bhqd,bhnd->bhqn', qi.astype(jnp.float32), kmean)
        gate = jnp.where(blk_ids < own, gate, -jnp.inf)
        _, sel = lax.top_k(gate, topk)
        sel_ok = sel < own
        k_sel = kbh[bi, hi, sel]
        v_sel = vbh[bi, hi, sel]
        s_sel = jnp.einsum('bhqd,bhqkld->bhqkl', qi, k_sel).astype(jnp.float32) * scale
        s_sel = jnp.where(sel_ok[..., None], s_sel, -jnp.inf).reshape(B, H, QC, topk * BLK)
        k_own = lax.dynamic_index_in_dim(kbh, own, axis=2, keepdims=False)
        v_own = lax.dynamic_index_in_dim(vbh, own, axis=2, keepdims=False)
        kpos = own * BLK + jnp.arange(BLK)
        s_own = jnp.einsum('bhqd,bhld->bhql', qi, k_own).astype(jnp.float32) * scale
        s_own = jnp.where(kpos[None, :] <= qpos[:, None], s_own, -jnp.inf)
        p = jax.nn.softmax(jnp.concatenate([s_sel, s_own], axis=-1), axis=-1).astype(v.dtype)
        p_sel = p[..., :topk * BLK].reshape(B, H, QC, topk, BLK)
        p_own = p[..., topk * BLK:]
        return (jnp.einsum('bhqkl,bhqkld->bhqd', p_sel, v_sel)
                + jnp.einsum('bhql,bhld->bhqd', p_own, v_own))

    o = lax.map(one_chunk, (jnp.arange(nqc), qch))
    return o.transpose(1, 0, 3, 2, 4).reshape(B, S, H, D)


def hgrn2_chunkwise(q, f_logit, i, lb):
    B, S, H, DK = q.shape
    DV = i.shape[-1]
    C = HGRN_CHUNK
    NC = S // C
    fl = f_logit.astype(jnp.float32)
    qf = jax.nn.silu(q.astype(jnp.float32))
    log_f = jnp.logaddexp(jnp.log(lb), jnp.log1p(-lb) + jax.nn.log_sigmoid(fl))
    kf = (1.0 - lb) * jax.nn.sigmoid(-fl)
    vf = i.astype(jnp.float32)

    def to_chunks(t):
        return t.reshape(B, NC, C, H, t.shape[-1]).transpose(1, 0, 3, 2, 4)

    causal = jnp.tril(jnp.ones((C, C), dtype=bool))

    def step(state, inp):
        qc, lfc, kc, vc = inp
        A = jnp.cumsum(lfc, axis=2)
        diff = A[:, :, :, None, :] - A[:, :, None, :, :]
        decay = jnp.exp(jnp.where(causal[:, :, None], diff, -jnp.inf))
        scores = jnp.einsum('bhtd,bhtsd,bhsd->bhts', qc, decay, kc)
        o = (jnp.einsum('bhts,bhsv->bhtv', scores, vc)
             + jnp.einsum('bhtd,bhdv->bhtv', qc * jnp.exp(A), state))
        A_end = A[:, :, -1:, :]
        state = (jnp.exp(A_end[:, :, 0, :])[..., None] * state
                 + jnp.einsum('bhsd,bhsv->bhdv', kc * jnp.exp(A_end - A), vc))
        return state, o

    s0 = jnp.zeros((B, H, DK, DV), jnp.float32)
    _, o = lax.scan(step, s0, (to_chunks(qf), to_chunks(log_f), to_chunks(kf), to_chunks(vf)))
    return o.transpose(1, 0, 3, 2, 4).reshape(B, S, H, DV)


def memory_attention(q, k, v):
    scale = q.shape[-1] ** -0.5
    s = jnp.einsum('bshd,bmhd->bhsm', q, k).astype(jnp.float32) * scale
    p = jax.nn.softmax(s, axis=-1).astype(v.dtype)
    return jnp.einsum('bhsm,bmhd->bshd', p, v)


def setup_inputs(seed: int = 0) -> dict:
    key = jax.random.key(seed)
    ks = jax.random.split(key, 14)
    f32 = jnp.float32

    def gain(k, shape):
        return 1.0 + 0.02 * jax.random.normal(k, shape, f32)

    return {
        "x": jax.random.normal(ks[0], (BATCH, SEQ, D_MODEL), f32),
        "mem": jax.random.normal(ks[1], (BATCH, MEM_LEN, D_MODEL), f32),
        "positions": jnp.tile(jnp.arange(SEQ, dtype=jnp.int32)[None, :], (BATCH, 1)),
        "norm_g": gain(ks[2], (DEPTH, D_MODEL)),
        "w_in": jax.random.normal(ks[3], (DEPTH, D_MODEL, IN_COLS), f32) * D_MODEL ** -0.5,
        "w_out": jax.random.normal(ks[4], (DEPTH, D_MIX, D_MODEL), f32) * D_MIX ** -0.5,
        "moba_q_norm": gain(ks[5], (DEPTH, MOBA_HEAD_DIM)),
        "moba_k_norm": gain(ks[6], (DEPTH, MOBA_HEAD_DIM)),
        "hgrn_lb_logits": 0.5 * jax.random.normal(ks[7], (DEPTH, GROUP_WIDTH), f32),
        "hgrn_o_norm": gain(ks[8], (DEPTH, HGRN_HEAD_DIM)),
        "mem_norm_g": gain(ks[9], (DEPTH, D_MODEL)),
        "w_mem_kv": jax.random.normal(ks[10], (DEPTH, D_MODEL, 2 * GROUP_WIDTH), f32) * D_MODEL ** -0.5,
        "mem_q_norm": gain(ks[11], (DEPTH, MEM_HEAD_DIM)),
        "mem_k_norm": gain(ks[12], (DEPTH, MEM_HEAD_DIM)),
    }


def reference(x, mem, positions, norm_g, w_in, w_out, moba_q_norm, moba_k_norm, hgrn_lb_logits,
              hgrn_o_norm, mem_norm_g, w_mem_kv, mem_q_norm, mem_k_norm):
    B, S, _ = x.shape
    M = mem.shape[1]
    G = GROUP_WIDTH
    lb_all = jnp.cumsum(jax.nn.softmax(hgrn_lb_logits.astype(jnp.float32), axis=0), axis=0)
    lb_all = lb_all - lb_all[0:1]
    split_points = [G * n for n in range(1, 8)]
    for l in range(DEPTH):
        h = rms_norm(x, norm_g[l])
        proj = h @ w_in[l]
        q_a, k_a, v_a, q_h, f_h, i_h, q_m, z = jnp.split(proj, split_points, axis=-1)

        qa = partial_rope(rms_norm(q_a.reshape(B, S, MOBA_HEADS, MOBA_HEAD_DIM), moba_q_norm[l]), positions)
        ka = partial_rope(rms_norm(k_a.reshape(B, S, MOBA_HEADS, MOBA_HEAD_DIM), moba_k_norm[l]), positions)
        va = v_a.reshape(B, S, MOBA_HEADS, MOBA_HEAD_DIM)
        o_a = moba_attention(qa, ka, va).reshape(B, S, G)

        o_h = hgrn2_chunkwise(q_h.reshape(B, S, HGRN_HEADS, HGRN_HEAD_DIM),
                              f_h.reshape(B, S, HGRN_HEADS, HGRN_HEAD_DIM),
                              i_h.reshape(B, S, HGRN_HEADS, HGRN_HEAD_DIM),
                              lb_all[l].reshape(HGRN_HEADS, HGRN_HEAD_DIM))
        o_h = rms_norm(o_h, hgrn_o_norm[l]).astype(x.dtype).reshape(B, S, G)

        kv_m = rms_norm(mem, mem_norm_g[l]) @ w_mem_kv[l]
        k_m, v_m = jnp.split(kv_m, 2, axis=-1)
        km = rms_norm(k_m.reshape(B, M, MEM_HEADS, MEM_HEAD_DIM), mem_k_norm[l])
        vm = v_m.reshape(B, M, MEM_HEADS, MEM_HEAD_DIM)
        qm = rms_norm(q_m.reshape(B, S, MEM_HEADS, MEM_HEAD_DIM), mem_q_norm[l])
        o_m = memory_attention(qm, km, vm).reshape(B, S, G)

        y = jnp.concatenate([o_a, o_h, o_m], axis=-1) * jax.nn.silu(z)
        x = x + y @ w_out[l]
    return x
```

```cpp
#include <hip/hip_runtime.h>
#include <hip/hip_cooperative_groups.h>
#include <cstdio>
#include <cstdint>
namespace cg = cooperative_groups;

#ifndef MK_ONE_LAUNCH
#define MK_ONE_LAUNCH 1
#endif

#define LAS __attribute__((address_space(3)))
typedef unsigned short bf16_t;
typedef short bf16x8 __attribute__((ext_vector_type(8)));
typedef short s16x4 __attribute__((ext_vector_type(4)));
typedef float f32x4 __attribute__((ext_vector_type(4)));
typedef unsigned u32x4 __attribute__((ext_vector_type(4)));
typedef unsigned u32x2 __attribute__((ext_vector_type(2)));

constexpr int NB = 8, SEQ = 2048, DM = 1024, NTOK = NB * SEQ, MEML = 256, NMEM = NB * MEML, NCOL = 4096  , NIN = 5120  , DMIX = 1536;
constexpr int CQA = 0, CQH = 512, CQM = 1024, CZ = 1536, CFH = 3072, CIH = 3584;
constexpr float EPS = 1e-6f;
constexpr float LOG2E = 1.4426950408889634f;
constexpr size_t MiB = 1u << 20;
constexpr size_t WS_WIN = 0, WS_WOUT = 20 * MiB, WS_WMEM = 26 * MiB, WS_H = 30 * MiB  , WS_MEMH = 62 * MiB, WS_KVM = 66 * MiB,
                 WS_PROJ = 70 * MiB, WS_KC = 198 * MiB, WS_VC = 214 * MiB, WS_VT = 230 * MiB, WS_KMEAN = 246 * MiB, WS_DECAY = 246 * MiB + 128 * 1024, WS_ROPE = 247 * MiB, WS_END = 248 * MiB, WS_MEMH1 = 230 * MiB  , WS_RSS = 250 * MiB  , WS_LB = 251 * MiB  , WS_BAR = 252 * MiB  ;
constexpr int LDS_BYTES = 147456;
constexpr int NPHASE = 11;

struct Args {
    const float *x, *mem; const int* pos; const float *norm_g, *w_in, *w_out, *mqn, *mkn, *lbl, *hon, *mng, *wmem, *memqn, *memkn;
    float* out; unsigned char* ws; int ph_lo, ph_hi, rep, pad;
};

typedef float f32x2_t __attribute__((ext_vector_type(2))); typedef __bf16 bf16x2_t __attribute__((ext_vector_type(2)));
__device__ __forceinline__ unsigned pk2(float lo, float hi) { f32x2_t v = {lo, hi}; bf16x2_t b = __builtin_convertvector(v, bf16x2_t); return __builtin_bit_cast(unsigned, b); }
__device__ __forceinline__ unsigned f2bf(float f) { return pk2(f, 0.f) & 0xffffu; }
__device__ __forceinline__ float bflo(unsigned u) { return __uint_as_float(u << 16); }
__device__ __forceinline__ float bfhi(unsigned u) { return __uint_as_float(u & 0xffff0000u); }
__device__ __forceinline__ float bf2f(short s) { return __uint_as_float(((unsigned)(unsigned short)s) << 16); }
__device__ __forceinline__ float wave_sum(float v) {
#pragma unroll
    for (int o = 1; o < 64; o <<= 1) v += __shfl_xor(v, o);
    return v;
}
__device__ __forceinline__ float ex2(float x) { return __builtin_amdgcn_exp2f(x); }
__device__ __forceinline__ float fexp(float x) { return __builtin_amdgcn_exp2f(x * LOG2E); }
__device__ __forceinline__ float frcp(float x) { return __builtin_amdgcn_rcpf(x); }
__device__ __forceinline__ float frsq(float x) { return __builtin_amdgcn_rsqf(x); }
__device__ __forceinline__ float sigm(float x) { return frcp(1.f + fexp(-x)); }
__device__ __forceinline__ float silu(float x) { return x * frcp(1.f + fexp(-x)); }
#define LDS_WAIT() asm volatile("s_waitcnt lgkmcnt(0)" ::: "memory")
__device__ __forceinline__ int otid() { int t = threadIdx.x; asm volatile("" : "+v"(t)); return t; }
typedef short v4i16_t __attribute__((ext_vector_type(4)));
__device__ __forceinline__ s16x4 tr4(const LAS unsigned char* base, int pitch, int r0, int c0, int lane) {
    const int q = (lane & 15) >> 2, p = lane & 3;
    return __builtin_bit_cast(s16x4, __builtin_amdgcn_ds_read_tr16_b64_v4i16((LAS v4i16_t*)(base + (r0 + q) * pitch + (c0 + 4 * p) * 2)));
}
#define MFMA16(a, b, c) __builtin_amdgcn_mfma_f32_16x16x32_bf16((a), (b), (c), 0, 0, 0)

namespace pg8 {
constexpr int BM = 256, BK = 64, HALF = 128, HTB = HALF * BK * 2, NXCD = 8, WGM = 8;
__host__ __device__ __forceinline__ int lds_byte(int r, int c) { const int st = (r >> 4) * 2 + (c >> 5), rr = r & 15, cc = c & 31, ob = rr * 64 + cc * 2; return st * 1024 + (ob ^ (((ob >> 9) & 1) << 5)); }
__host__ __device__ __forceinline__ void stage_rc(int b, int& R, int& C) { const int st = b / 1024, sb = b % 1024, swz = sb ^ (((sb >> 9) & 1) << 5); R = (st >> 1) * 16 + swz / 64; C = (st & 1) * 32 + (swz % 64) / 2; }
__host__ __device__ __forceinline__ int perm32(int rho) { const int n = rho >> 4, i = rho & 15; return 8 * (i >> 2) + 4 * n + (i & 3); }
struct Unit { int pm, pn; };
struct Gemm { const bf16_t* A; const bf16_t* Bt; int M, N, K, lda; };
struct StaticOrder {
    int nM, nN, nwg, G, c;
    __device__ void init(int M, int N, int G_, int c_) { nM = M / BM; nN = N / BM; nwg = nM * nN; G = G_; c = c_; }
    __device__ bool next(int i, Unit& u) const {
        const long L = (long)i * G + c; if (L >= nwg) return false;
        int wgid = (int)L; { const int q = nwg / NXCD, r = nwg % NXCD, xcd = wgid % NXCD, off = wgid / NXCD; wgid = (xcd < r ? xcd * (q + 1) : r * (q + 1) + (xcd - r) * q) + off; }
        const int nig = WGM * nN, gid = wgid / nig, fm = gid * WGM, gsz = (nM - fm) < WGM ? (nM - fm) : WGM;
        u.pm = fm + ((wgid % nig) % gsz); u.pn = (wgid % nig) / gsz; return true;
    }
};
__device__ __forceinline__ unsigned cvt_pk_bf16(float lo, float hi) { unsigned r; asm volatile("v_cvt_pk_bf16_f32 %0, %1, %2" : "=v"(r) : "v"(lo), "v"(hi)); return r; }
struct EpiBf16 {
    static constexpr bool PERM = true;
    bf16_t* O; int ldc;
    __device__ __forceinline__ void operator()(const f32x4 (&acc)[2][2][4][2], const Unit& u, int wr, int wc, int fr, int fq, LAS unsigned char*) const {
        const int row0 = u.pm * BM + wr * 64 + fr; const int col0 = u.pn * BM + wc * 32 + 8 * fq;
#pragma unroll
        for (int ai = 0; ai < 2; ++ai)
#pragma unroll
            for (int m = 0; m < 4; ++m) { bf16_t* rowp = O + (size_t)(row0 + ai * HALF + m * 16) * ldc + col0;
#pragma unroll
                for (int bj = 0; bj < 2; ++bj) { const f32x4 v0 = acc[ai][bj][m][0], v1 = acc[ai][bj][m][1];
                    u32x4 w; w.x = cvt_pk_bf16(v0[0], v0[1]); w.y = cvt_pk_bf16(v0[2], v0[3]); w.z = cvt_pk_bf16(v1[0], v1[1]); w.w = cvt_pk_bf16(v1[2], v1[3]);
                    *(u32x4*)(rowp + bj * HALF) = w; } }
    }
};
struct EpiBf16Scale {
    static constexpr bool PERM = true;
    bf16_t* O; int ldc; bf16_t* Kc; bf16_t* Vc;
    __device__ __forceinline__ void operator()(const f32x4 (&acc)[2][2][4][2], const Unit& u, int wr, int wc, int fr, int fq, LAS unsigned char* lds) const {
        const int row0 = u.pm * BM + wr * 64 + fr; const int col0 = u.pn * BM + wc * 32 + 8 * fq;
        const LAS float* rtab = (const LAS float*)(lds + 131072);
        const bool compact = u.pn >= 16;
#pragma unroll
        for (int ai = 0; ai < 2; ++ai)
#pragma unroll
            for (int m = 0; m < 4; ++m) { const int row = row0 + ai * HALF + m * 16;
                const float r = rtab[ai * HALF + wr * 64 + m * 16 + fr];
#pragma unroll
                for (int bj = 0; bj < 2; ++bj) { const f32x4 v0 = acc[ai][bj][m][0] * r, v1 = acc[ai][bj][m][1] * r;
                    u32x4 w; w.x = cvt_pk_bf16(v0[0], v0[1]); w.y = cvt_pk_bf16(v0[2], v0[3]); w.z = cvt_pk_bf16(v1[0], v1[1]); w.w = cvt_pk_bf16(v1[2], v1[3]);
                    bf16_t* dst;
                    if (compact) { const int cc = col0 + bj * HALF - 4096, hc = cc & 511, hh = hc >> 6, d = hc & 63;
                        dst = ((cc >> 9) ? Vc : Kc) + ((size_t)((row >> 11) * 8 + hh) * 2048 + (row & 2047)) * 64 + d; }
                    else dst = O + (size_t)row * ldc + col0 + bj * HALF;
                    *(u32x4*)dst = w; } }
    }
};
struct EpiResF32Norm {
    static constexpr bool PERM = false;
    const float* res; float* O; int ldc; const float* g; bf16_t* H; float* rss;
    __device__ __forceinline__ void operator()(const f32x4 (&acc)[2][2][4][2], const Unit& u, int wr, int wc, int fr, int fq, LAS unsigned char* lds) const {
        const int row0 = u.pm * BM + wr * 64 + fr; const int col0 = u.pn * BM + wc * 32 + 4 * fq;
        LAS float* part = (LAS float*)(lds + 131072);
#pragma unroll
        for (int ai = 0; ai < 2; ++ai)
#pragma unroll
            for (int m = 0; m < 4; ++m) { const size_t ro = (size_t)(row0 + ai * HALF + m * 16) * ldc + col0; float ssq = 0.f;
#pragma unroll
                for (int bj = 0; bj < 2; ++bj)
#pragma unroll
                    for (int n = 0; n < 2; ++n) { const size_t o = ro + bj * HALF + n * 16; const f32x4 r = *(const f32x4*)(res + o); const f32x4 x1 = r + acc[ai][bj][m][n]; *(f32x4*)(O + o) = x1;
                        const f32x4 gg = *(const f32x4*)(g + col0 + bj * HALF + n * 16);
                        u32x2 hb; hb.x = cvt_pk_bf16(x1[0] * gg[0], x1[1] * gg[1]); hb.y = cvt_pk_bf16(x1[2] * gg[2], x1[3] * gg[3]); *(u32x2*)(H + o) = hb;
                        ssq += (x1[0] * x1[0] + x1[1] * x1[1]) + (x1[2] * x1[2] + x1[3] * x1[3]); }
                ssq += __shfl_xor(ssq, 16); ssq += __shfl_xor(ssq, 32);
                if (fq == 0) part[(ai * HALF + wr * 64 + m * 16 + fr) * 4 + wc] = ssq; }
        asm volatile("s_waitcnt lgkmcnt(0)" ::: "memory"); __builtin_amdgcn_s_barrier(); asm volatile("" ::: "memory");
        const int t = threadIdx.x;
        if (t < 256) { const f32x4 p = *(const LAS f32x4*)(part + t * 4); rss[(size_t)u.pn * NTOK + u.pm * BM + t] = (p[0] + p[1]) + (p[2] + p[3]); }
    }
};
struct EpiResF32 {
    static constexpr bool PERM = false;
    const float* res; float* O; int ldc;
    __device__ __forceinline__ void operator()(const f32x4 (&acc)[2][2][4][2], const Unit& u, int wr, int wc, int fr, int fq, LAS unsigned char*) const {
        const int row0 = u.pm * BM + wr * 64 + fr; const int col0 = u.pn * BM + wc * 32 + 4 * fq;
#pragma unroll
        for (int ai = 0; ai < 2; ++ai)
#pragma unroll
            for (int m = 0; m < 4; ++m) { const size_t ro = (size_t)(row0 + ai * HALF + m * 16) * ldc + col0;
#pragma unroll
                for (int bj = 0; bj < 2; ++bj)
#pragma unroll
                    for (int n = 0; n < 2; ++n) { const size_t o = ro + bj * HALF + n * 16; const f32x4 r = *(const f32x4*)(res + o); *(f32x4*)(O + o) = r + acc[ai][bj][m][n]; } }
    }
};

template <class Epi, class Sched>
__device__ __forceinline__ void gemm_phase(LAS unsigned char* lds, const Gemm g, const Sched& S, const Epi& E) {
    const int tid = otid(), wid = __builtin_amdgcn_readfirstlane(tid >> 6), lane = tid & 63, wr = wid >> 2, wc = wid & 3, fr = lane & 15, fq = lane >> 4;
    const int K = g.K, nt = K / BK, lda = g.lda;
    unsigned voffA[2], voffB[2];
#pragma unroll
    for (int i = 0; i < 2; ++i) { int R, C; stage_rc(tid * 16 + i * 8192, R, C); const int Rb = Epi::PERM ? ((R & ~31) + perm32(R & 31)) : R;
        voffA[i] = (unsigned)(R * lda + C) * 2u; voffB[i] = (unsigned)(Rb * K + C) * 2u; }
    const size_t kstep = (size_t)(BK * 2);
    const size_t hstepA = (size_t)HALF * lda * 2, hstepB = (size_t)HALF * K * 2;
    const size_t tstepA = 2 * hstepA, tstepB = 2 * hstepB;
    const unsigned ldsw = (unsigned)wid * 1024u;
    const int aoff = lds_byte(wr * 64 + fr, fq * 8), boff = lds_byte(wc * 32 + fr, fq * 8);
#define PG8_SA(b, h) (((b) * 2 + (h)) * HTB)
#define PG8_SB(b, h) ((4 + (b) * 2 + (h)) * HTB)
#define PG8_STAGE(bufoff, gbase, voff) do { _Pragma("unroll") for (int _i = 0; _i < 2; ++_i) \
        __builtin_amdgcn_global_load_lds((const unsigned*)((const char*)(gbase) + (voff)[_i]), (LAS unsigned*)(lds + (bufoff) + ldsw + _i * 8192), 16, 0, 0); } while (0)
#define PG8_LDA(dst, b, h) do { _Pragma("unroll") for (int m = 0; m < 4; ++m) _Pragma("unroll") for (int k = 0; k < 2; ++k) dst[m][k] = *(const LAS bf16x8*)(lds + PG8_SA(b, h) + aoff + m * 2048 + k * 1024); } while (0)
#define PG8_LDB(dst, b, h) do { _Pragma("unroll") for (int n = 0; n < 2; ++n) _Pragma("unroll") for (int k = 0; k < 2; ++k) dst[n][k] = *(const LAS bf16x8*)(lds + PG8_SB(b, h) + boff + n * 2048 + k * 1024); } while (0)
#define PG8_MMA(ai, bj, At, Bt) do { __builtin_amdgcn_s_setprio(1); _Pragma("unroll") for (int m = 0; m < 4; ++m) _Pragma("unroll") for (int n = 0; n < 2; ++n) _Pragma("unroll") for (int k = 0; k < 2; ++k) \
        acc[ai][bj][m][n] = __builtin_amdgcn_mfma_f32_16x16x32_bf16(Bt[n][k], At[m][k], acc[ai][bj][m][n], 0, 0, 0); __builtin_amdgcn_s_setprio(0); } while (0)
#define PG8_WAIT_V(n) asm volatile("s_waitcnt vmcnt(" #n ")" ::: "memory")
#define PG8_WAIT_L(n) asm volatile("s_waitcnt lgkmcnt(" #n ")" ::: "memory")
#define PG8_BAR __builtin_amdgcn_s_barrier()
#define PG8_SCHED __builtin_amdgcn_sched_barrier(0)
    Unit cur, nxt; int ui = 0;
    if (!S.next(0, cur)) return;
    f32x4 acc[2][2][4][2];
#pragma unroll
    for (int a = 0; a < 2; ++a)
#pragma unroll
        for (int b = 0; b < 2; ++b)
#pragma unroll
            for (int m = 0; m < 4; ++m)
#pragma unroll
                for (int n = 0; n < 2; ++n) acc[a][b][m][n] = (f32x4){0.f, 0.f, 0.f, 0.f};
    bf16x8 At[4][2], B0[2][2], B1[2][2];
    const char* cA = (const char*)g.A + (size_t)cur.pm * tstepA; const char* cB = (const char*)g.Bt + (size_t)cur.pn * tstepB;
    PG8_STAGE(PG8_SB(0, 0), cB, voffB); PG8_STAGE(PG8_SB(0, 1), cB + hstepB, voffB); PG8_STAGE(PG8_SA(0, 0), cA, voffA); PG8_STAGE(PG8_SA(0, 1), cA + hstepA, voffA);
    if (wr == 1) PG8_BAR;
    PG8_WAIT_V(2); PG8_BAR;
    PG8_STAGE(PG8_SB(1, 0), cB + kstep, voffB); PG8_STAGE(PG8_SA(1, 0), cA + kstep, voffA); PG8_STAGE(PG8_SB(1, 1), cB + hstepB + kstep, voffB);
    PG8_WAIT_V(6); PG8_BAR;
    for (;;) {
        const bool has_next = S.next(ui + 1, nxt);
        const char* nA = has_next ? (const char*)g.A + (size_t)nxt.pm * tstepA : cA; const char* nB = has_next ? (const char*)g.Bt + (size_t)nxt.pn * tstepB : cB;
        for (int t = 0; t < nt; t += 2) {
            const bool last = (t == nt - 2);
            const char* a1 = cA + (size_t)(t + 1) * kstep;
            const char* a2 = last ? nA : cA + (size_t)(t + 2) * kstep; const char* b2 = last ? nB : cB + (size_t)(t + 2) * kstep;
            const char* a3 = a2 + kstep; const char* b3 = b2 + kstep;
            PG8_LDB(B0, 0, 0); PG8_LDB(B1, 0, 1); PG8_SCHED; PG8_LDA(At, 0, 0); PG8_STAGE(PG8_SA(1, 1), a1 + hstepA, voffA);
            PG8_WAIT_V(8); PG8_WAIT_L(0); PG8_BAR; PG8_MMA(0, 0, At, B0); PG8_MMA(0, 1, At, B1); PG8_BAR; PG8_SCHED;
            PG8_LDA(At, 0, 1); PG8_STAGE(PG8_SB(0, 0), b2, voffB); PG8_STAGE(PG8_SB(0, 1), b2 + hstepB, voffB); PG8_STAGE(PG8_SA(0, 0), a2, voffA);
            PG8_WAIT_V(8); PG8_WAIT_L(0); PG8_BAR; PG8_MMA(1, 0, At, B0); PG8_MMA(1, 1, At, B1); PG8_BAR; PG8_SCHED;
            PG8_LDB(B0, 1, 0); PG8_LDB(B1, 1, 1); PG8_SCHED; PG8_LDA(At, 1, 0); PG8_STAGE(PG8_SA(0, 1), a2 + hstepA, voffA);
            PG8_WAIT_V(8); PG8_WAIT_L(0); PG8_BAR; PG8_MMA(0, 0, At, B0); PG8_MMA(0, 1, At, B1); PG8_BAR; PG8_SCHED;
            PG8_LDA(At, 1, 1); PG8_STAGE(PG8_SB(1, 0), b3, voffB); PG8_STAGE(PG8_SB(1, 1), b3 + hstepB, voffB); PG8_STAGE(PG8_SA(1, 0), a3, voffA);
            PG8_WAIT_V(8); PG8_WAIT_L(0); PG8_BAR; PG8_MMA(1, 0, At, B0); PG8_MMA(1, 1, At, B1); PG8_BAR; PG8_SCHED;
        }
        if (wr == 0) PG8_BAR;
        E(acc, cur, wr, wc, fr, fq, lds);
        if (!has_next) break;
#pragma unroll
        for (int a = 0; a < 2; ++a)
#pragma unroll
            for (int b = 0; b < 2; ++b)
#pragma unroll
                for (int m = 0; m < 4; ++m)
#pragma unroll
                    for (int n = 0; n < 2; ++n) acc[a][b][m][n] = (f32x4){0.f, 0.f, 0.f, 0.f};
        cur = nxt; cA = nA; cB = nB; ++ui;
        if (wr == 1) PG8_BAR;
    }
    PG8_WAIT_V(0);
    PG8_BAR;
#undef PG8_SA
#undef PG8_SB
#undef PG8_STAGE
#undef PG8_LDA
#undef PG8_LDB
#undef PG8_MMA
#undef PG8_WAIT_V
#undef PG8_WAIT_L
#undef PG8_BAR
#undef PG8_SCHED
}
}

__device__ __forceinline__ void transpose_item(const float* W, int ldw, int K, int ncols, bf16_t* WT, int row_off, LAS float* scr, int item, int lane) {
    const int nblk = ncols / 64, kb = item / nblk, nb = item % nblk, k0 = 64 * kb, n0 = 64 * nb;
    f32x4 v[16];
#pragma unroll
    for (int i = 0; i < 16; ++i) v[i] = *(const f32x4*)(W + (size_t)(k0 + 4 * i + (lane >> 4)) * ldw + n0 + (lane & 15) * 4);
#pragma unroll
    for (int i = 0; i < 16; ++i) { LAS float* d = scr + (4 * i + (lane >> 4)) * 65 + (lane & 15) * 4; d[0] = v[i].x; d[1] = v[i].y; d[2] = v[i].z; d[3] = v[i].w; }
    LDS_WAIT();
    const int c = lane & 7;
#pragma unroll
    for (int j = 0; j < 8; ++j) { const int n = (lane >> 3) + 8 * j; const LAS float* s = scr + (8 * c) * 65 + n;
        u32x4 o; o.x = pk2(s[0 * 65], s[1 * 65]); o.y = pk2(s[2 * 65], s[3 * 65]); o.z = pk2(s[4 * 65], s[5 * 65]); o.w = pk2(s[6 * 65], s[7 * 65]);
        *(u32x4*)(WT + (size_t)(row_off + n0 + n) * K + k0 + 8 * c) = o; }
    LDS_WAIT();
}
__device__ __forceinline__ void norm_phase(const Args& a) {
    const int tid = otid(); const int lane = tid & 63, gw = blockIdx.x * 8 + (tid >> 6), NGW = gridDim.x * 8;
    bf16_t* H = (bf16_t*)(a.ws + WS_H); float* rss = (float*)(a.ws + WS_RSS);
    constexpr int NROWS = NTOK + 2 * NMEM;
    for (int m0 = gw; m0 < NROWS; m0 += 4 * NGW) {
        f32x4 v[4][4]; const float* gp[4]; bf16_t* op[4]; int mm[4];
#pragma unroll
        for (int r = 0; r < 4; ++r) { int m = m0 + r * NGW; if (m >= NROWS) m = m0; mm[r] = m;
            const float* xrow; if (m < NTOK) { xrow = a.x + (size_t)m * DM; gp[r] = a.norm_g; op[r] = H + (size_t)m * DM; }
            else { const int q = (m - NTOK) & (NMEM - 1), l = (m - NTOK) >> 11; xrow = a.mem + (size_t)q * DM; gp[r] = a.mng + l * DM; op[r] = (bf16_t*)(a.ws + (l ? WS_MEMH1 : WS_MEMH)) + (size_t)q * DM; }
#pragma unroll
            for (int j = 0; j < 4; ++j) v[r][j] = ((const f32x4*)xrow + lane)[64 * j]; }
#pragma unroll
        for (int r = 0; r < 4; ++r) {
            float sacc = 0.f;
#pragma unroll
            for (int j = 0; j < 4; ++j) sacc += (v[r][j].x * v[r][j].x + v[r][j].y * v[r][j].y) + (v[r][j].z * v[r][j].z + v[r][j].w * v[r][j].w);
            const float tot = wave_sum(sacc); const bool tokrow = mm[r] < NTOK;
            const float rr = tokrow ? 1.f : 1.f / sqrtf(tot * (1.f / DM) + EPS);
            unsigned long long* o8 = (unsigned long long*)op[r] + lane;
#pragma unroll
            for (int j = 0; j < 4; ++j) { const f32x4 gg = ((const f32x4*)gp[r] + lane)[64 * j];
                o8[64 * j] = (unsigned long long)pk2(v[r][j].x * rr * gg.x, v[r][j].y * rr * gg.y) | ((unsigned long long)pk2(v[r][j].z * rr * gg.z, v[r][j].w * rr * gg.w) << 32); }
            if (tokrow && lane < 4) rss[lane * NTOK + mm[r]] = (lane == 0) ? tot : 0.f;
        }
    }
}
__device__ __forceinline__ void p0_phase(const Args& a, LAS unsigned char* lds) {
    const int tid = otid(), lane = tid & 63, wave = tid >> 6;
    LAS float* scr = (LAS float*)(lds + wave * 17408);
    const int gw = blockIdx.x * 8 + wave, NGW = gridDim.x * 8;
    bf16_t* WinT = (bf16_t*)(a.ws + WS_WIN); bf16_t* WoutT = (bf16_t*)(a.ws + WS_WOUT); bf16_t* WmemT = (bf16_t*)(a.ws + WS_WMEM);
    for (int it = gw; it < 3840; it += NGW) {
        const int l = it / 1920; int r = it % 1920;
        if (r < 1280) { const int seg = r >> 7, sub = r & 127; const int oseg = (int)((0x2154987630ULL >> (4 * seg)) & 15ULL);
            transpose_item(a.w_in + (size_t)l * DM * NIN + oseg * 512, NIN, DM, 512, WinT + (size_t)l * NIN * DM, seg * 512, scr, sub, lane); }
        else if (r < 1664) { r -= 1280; transpose_item(a.w_out + (size_t)l * DMIX * DM, DM, DMIX, DM, WoutT + (size_t)l * DM * DMIX, 0, scr, r, lane); }
        else { r -= 1664; transpose_item(a.wmem + (size_t)l * DM * DM, DM, DM, DM, WmemT + (size_t)l * DM * DM, 0, scr, r, lane); }
    }
    float* rope = (float*)(a.ws + WS_ROPE);
    for (int e = blockIdx.x * 512 + tid; e < NTOK * 8; e += gridDim.x * 512) {
        const int tok = e >> 3, i = e & 7;
        const float inv = powf(500000.0f, -(float)i * 0.125f);
        const float ang = (float)a.pos[tok] * inv;
        const double ad = (double)ang; const double n = rint(ad * 0.15915494309189535); const float rr = (float)(ad - n * 6.283185307179586);
        rope[tok * 16 + i] = cosf(rr); rope[tok * 16 + 8 + i] = sinf(rr);
    }
    if (blockIdx.x == 0) { float* LB = (float*)(a.ws + WS_LB); LB[tid] = 0.f; const float l0 = a.lbl[tid], l1 = a.lbl[512 + tid]; LB[512 + tid] = 1.f / (1.f + expf(l0 - l1)); }
    norm_phase(a);
}

#define BAR_LDS() do { asm volatile("s_waitcnt lgkmcnt(0)" ::: "memory"); __builtin_amdgcn_s_barrier(); asm volatile("" ::: "memory"); } while (0)
struct PrepIn { u32x4 q[4], k[4]; float cs[8], sn[8]; };
__device__ __forceinline__ void moba_prep_load(const Args& a, int tid, int u, PrepIn& r) {
    const int b = u >> 6, j = (u >> 3) & 7, h = u & 7, tok = tid >> 1, half = tid & 1;
    const size_t row = (size_t)b * SEQ + j * 256 + tok;
    const bf16_t* p = (const bf16_t*)(a.ws + WS_PROJ) + row * NCOL + h * 64 + half * 32;
    const bf16_t* pk = (const bf16_t*)(a.ws + WS_KC) + ((size_t)(b * 8 + h) * SEQ + j * 256 + tok) * 64 + half * 32;
#pragma unroll
    for (int c = 0; c < 4; ++c) { r.q[c] = *(const u32x4*)(p + CQA + c * 8); r.k[c] = *(const u32x4*)(pk + c * 8); }
    const f32x4* rope = (const f32x4*)((const float*)(a.ws + WS_ROPE) + row * 16);
    const f32x4 c0 = rope[0], c1 = rope[1], s0 = rope[2], s1 = rope[3];
    r.cs[0] = c0.x; r.cs[1] = c0.y; r.cs[2] = c0.z; r.cs[3] = c0.w; r.cs[4] = c1.x; r.cs[5] = c1.y; r.cs[6] = c1.z; r.cs[7] = c1.w;
    r.sn[0] = s0.x; r.sn[1] = s0.y; r.sn[2] = s0.z; r.sn[3] = s0.w; r.sn[4] = s1.x; r.sn[5] = s1.y; r.sn[6] = s1.z; r.sn[7] = s1.w;
}
__device__ __forceinline__ void moba_prep_unit(const Args& a, int l, LAS unsigned char* lds, int tid, int u, const PrepIn& in, PrepIn& nxt, int unext) {
    const int b = u >> 6, j = (u >> 3) & 7, h = u & 7, tok = tid >> 1, half = tid & 1;
    bf16_t* proj = (bf16_t*)(a.ws + WS_PROJ);
    const size_t row = (size_t)b * SEQ + j * 256 + tok;
    LAS float* kt = (LAS float*)lds;
    LAS float* part = (LAS float*)(lds + 66560);
    float vq[32], vk[32];
#pragma unroll
    for (int c = 0; c < 4; ++c) { const u32x4 uq = in.q[c], uk = in.k[c];
        vq[c * 8 + 0] = bflo(uq.x); vq[c * 8 + 1] = bfhi(uq.x); vq[c * 8 + 2] = bflo(uq.y); vq[c * 8 + 3] = bfhi(uq.y); vq[c * 8 + 4] = bflo(uq.z); vq[c * 8 + 5] = bfhi(uq.z); vq[c * 8 + 6] = bflo(uq.w); vq[c * 8 + 7] = bfhi(uq.w);
        vk[c * 8 + 0] = bflo(uk.x); vk[c * 8 + 1] = bfhi(uk.x); vk[c * 8 + 2] = bflo(uk.y); vk[c * 8 + 3] = bfhi(uk.y); vk[c * 8 + 4] = bflo(uk.z); vk[c * 8 + 5] = bfhi(uk.z); vk[c * 8 + 6] = bflo(uk.w); vk[c * 8 + 7] = bfhi(uk.w); }
    float cs[8], sn[8];
#pragma unroll
    for (int i = 0; i < 8; ++i) { cs[i] = in.cs[i]; sn[i] = in.sn[i]; }
    asm volatile("" ::: "memory");
    moba_prep_load(a, tid, unext, nxt);
#pragma unroll
    for (int which = 0; which < 2; ++which) {
        bf16_t* p = which ? (bf16_t*)(a.ws + WS_KC) + ((size_t)(b * 8 + h) * SEQ + j * 256 + tok) * 64 + half * 32 : proj + row * NCOL + CQA + h * 64 + half * 32;
        const float* g = (which ? a.mkn : a.mqn) + l * 64 + half * 32;
        float v[32]; float ss = 0.f;
#pragma unroll
        for (int i = 0; i < 32; ++i) { v[i] = which ? vk[i] : vq[i]; ss += v[i] * v[i]; }
        ss += __shfl_xor(ss, 1);
        const float r = frsq(ss * (1.f / 64.f) + EPS) * (which ? 1.f : 0.125f * LOG2E);
#pragma unroll
        for (int c = 0; c < 8; ++c) { const f32x4 gg = *(const f32x4*)(g + c * 4); v[c * 4] *= r * gg.x; v[c * 4 + 1] *= r * gg.y; v[c * 4 + 2] *= r * gg.z; v[c * 4 + 3] *= r * gg.w; }
        if (half == 0) {
#pragma unroll
            for (int i = 0; i < 8; ++i) { const float x1 = v[i], x2 = v[8 + i]; v[i] = x1 * cs[i] - x2 * sn[i]; v[8 + i] = x2 * cs[i] + x1 * sn[i]; }
        }
#pragma unroll
        for (int c = 0; c < 4; ++c) { u32x4 uu; uu.x = pk2(v[c * 8 + 0], v[c * 8 + 1]); uu.y = pk2(v[c * 8 + 2], v[c * 8 + 3]); uu.z = pk2(v[c * 8 + 4], v[c * 8 + 5]); uu.w = pk2(v[c * 8 + 6], v[c * 8 + 7]);
            *(u32x4*)(p + c * 8) = uu; }
        if (which == 1) {
#pragma unroll
            for (int i = 0; i < 32; ++i) kt[tok * 65 + half * 32 + i] = v[i];
        }
    }
    BAR_LDS();
    {
        const int d = tid & 63, pt = tid >> 6; float sacc = 0.f;
#pragma unroll 8
        for (int t = 0; t < 32; ++t) sacc += kt[(pt * 32 + t) * 65 + d];
        part[pt * 64 + d] = sacc;
    }
    BAR_LDS();
    if (tid < 64) { float sacc = 0.f;
#pragma unroll
        for (int p = 0; p < 8; ++p) sacc += part[p * 64 + tid];
        ((float*)(a.ws + WS_KMEAN))[((size_t)(b * 8 + h) * 8 + j) * 64 + tid] = sacc * (1.f / 256.f); }
    BAR_LDS();
}

struct HIn { u32x4 f[2], q[2], v[2]; };
template <bool NEEDQ>
__device__ __forceinline__ void hgrn_load(const Args& a, int tid, int u, HIn& r) {
    const int bh = u >> 5, c = u & 31, b = bh >> 2, hh = bh & 3; const size_t row0 = (size_t)b * SEQ + c * 64;
#pragma unroll
    for (int ii = 0; ii < 2; ++ii) { const int cid = tid + 512 * ii, t = cid >> 4, d0 = (cid & 15) * 8;
        const bf16_t* p = (const bf16_t*)(a.ws + WS_PROJ) + (row0 + t) * NCOL + hh * 128 + d0;
        r.f[ii] = *(const u32x4*)(p + CFH); r.v[ii] = *(const u32x4*)(p + CIH); if (NEEDQ) r.q[ii] = *(const u32x4*)(p + CQH); }
}
__device__ __forceinline__ void hgrn_stepA(const Args& a, int l, LAS unsigned char* lds, int tid, int hh, const HIn& in, float (&kf)[16]) {
    LAS float* LF = (LAS float*)lds;
    LAS float* PT = (LAS float*)(lds + 32768);
#pragma unroll
    for (int ii = 0; ii < 2; ++ii) {
        const int cid = tid + 512 * ii, t = cid >> 4, d0 = (cid & 15) * 8;
        const u32x4 u = in.f[ii];
        float fl[8] = {bflo(u.x), bfhi(u.x), bflo(u.y), bfhi(u.y), bflo(u.z), bfhi(u.z), bflo(u.w), bfhi(u.w)};
        float lf[8];
        const float* LB = (const float*)(a.ws + WS_LB) + l * 512 + hh * 128 + d0; const f32x4 lb0 = *(const f32x4*)LB, lb1 = *(const f32x4*)(LB + 4);
        const float lbv[8] = {lb0.x, lb0.y, lb0.z, lb0.w, lb1.x, lb1.y, lb1.z, lb1.w};
#pragma unroll
        for (int i = 0; i < 8; ++i) { const float lb = lbv[i]; const float sg = sigm(fl[i]);
            const float f = lb + (1.f - lb) * sg; lf[i] = __logf(f); kf[ii * 8 + i] = (1.f - lb) * (1.f - sg); }
        *(LAS f32x4*)(LF + t * 128 + d0) = (f32x4){lf[0], lf[1], lf[2], lf[3]}; *(LAS f32x4*)(LF + t * 128 + d0 + 4) = (f32x4){lf[4], lf[5], lf[6], lf[7]};
    }
}
__device__ __forceinline__ void hgrn_cumsum_scan(LAS unsigned char* lds, int tid) {
    LAS float* LF = (LAS float*)lds;
    LAS float* PT = (LAS float*)(lds + 32768);
    BAR_LDS();
    { const int d = tid & 127, pt = tid >> 7; float run = 0.f;
#pragma unroll
      for (int t = 0; t < 16; ++t) { run += LF[(pt * 16 + t) * 128 + d]; LF[(pt * 16 + t) * 128 + d] = run; }
      PT[pt * 128 + d] = run; }
    BAR_LDS();
    { const int d = tid & 127, pt = tid >> 7; float off = 0.f;
#pragma unroll
      for (int p = 0; p < 3; ++p) off += (p < pt) ? PT[p * 128 + d] : 0.f;
      if (pt > 0) {
#pragma unroll
        for (int t = 0; t < 16; ++t) LF[(pt * 16 + t) * 128 + d] += off; } }
    BAR_LDS();
}
__device__ __forceinline__ void hgrn_stage1_unit(const Args& a, int l, LAS unsigned char* lds, int tid, int u, const HIn& in, HIn& nxt, int unext) {
    const int lane = tid & 63, w = __builtin_amdgcn_readfirstlane(tid >> 6), fr = lane & 15, fq = lane >> 4;
    const int bh = u >> 5, c = u & 31, hh = bh & 3;
    LAS float* LF = (LAS float*)lds;
    LAS unsigned char* KN = lds + 34816;
    LAS unsigned char* VN = lds + 34816 + 18432;
    float kf[16];
    hgrn_stepA(a, l, lds, tid, hh, in, kf);
    hgrn_load<false>(a, tid, unext, nxt);
    hgrn_cumsum_scan(lds, tid);
    if (tid < 128) ((float*)(a.ws + WS_DECAY))[((size_t)bh * 32 + c) * 128 + tid] = fexp(LF[63 * 128 + tid]);
#pragma unroll
    for (int ii = 0; ii < 2; ++ii) {
        const int cid = tid + 512 * ii, t = cid >> 4, d0 = (cid & 15) * 8;
        const f32x4 ae0 = *(const LAS f32x4*)(LF + 63 * 128 + d0), ae1 = *(const LAS f32x4*)(LF + 63 * 128 + d0 + 4), at0 = *(const LAS f32x4*)(LF + t * 128 + d0), at1 = *(const LAS f32x4*)(LF + t * 128 + d0 + 4);
        const f32x4 e0 = ae0 - at0, e1 = ae1 - at1;
        u32x4 o; o.x = pk2(kf[ii * 8 + 0] * fexp(e0.x), kf[ii * 8 + 1] * fexp(e0.y)); o.y = pk2(kf[ii * 8 + 2] * fexp(e0.z), kf[ii * 8 + 3] * fexp(e0.w));
        o.z = pk2(kf[ii * 8 + 4] * fexp(e1.x), kf[ii * 8 + 5] * fexp(e1.y)); o.w = pk2(kf[ii * 8 + 6] * fexp(e1.z), kf[ii * 8 + 7] * fexp(e1.w));
        *(LAS u32x4*)(KN + t * 288 + d0 * 2) = o;
        *(LAS u32x4*)(VN + t * 288 + d0 * 2) = in.v[ii];
    }
    BAR_LDS();
    f32x4 acc[8];
#pragma unroll
    for (int n = 0; n < 8; ++n) acc[n] = (f32x4){0.f, 0.f, 0.f, 0.f};
#pragma unroll
    for (int ks = 0; ks < 2; ++ks) {
        const s16x4 alo = tr4(VN, 288, ks * 32 + fq * 4, w * 16, fr), ahi = tr4(VN, 288, ks * 32 + 16 + fq * 4, w * 16, fr);
        const bf16x8 af = __builtin_shufflevector(alo, ahi, 0, 1, 2, 3, 4, 5, 6, 7);
#pragma unroll
        for (int n = 0; n < 8; ++n) { const s16x4 blo = tr4(KN, 288, ks * 32 + fq * 4, n * 16, fr), bhi = tr4(KN, 288, ks * 32 + 16 + fq * 4, n * 16, fr);
            const bf16x8 bfr = __builtin_shufflevector(blo, bhi, 0, 1, 2, 3, 4, 5, 6, 7); acc[n] = MFMA16(bfr, af, acc[n]); }
    }
    bf16_t* ST = (bf16_t*)(a.ws + WS_H) + ((size_t)bh * 32 + c) * 16384;
#pragma unroll
    for (int n = 0; n < 8; ++n) { u32x2 o; o.x = pk2(acc[n][0], acc[n][1]); o.y = pk2(acc[n][2], acc[n][3]); *(u32x2*)(ST + (w * 16 + fr) * 128 + n * 16 + fq * 4) = o; }
    BAR_LDS();
}
__device__ __forceinline__ void hgrn_scan_phase(const Args& a) {
    const int id = blockIdx.x * 512 + otid(), NT = gridDim.x * 512;
    for (int it = id; it < 32 * 128 * 32; it += NT) {
        const int bh = it >> 12, dv = (it >> 5) & 127, dkc = it & 31;
        u32x2* st = (u32x2*)((bf16_t*)(a.ws + WS_H) + (size_t)bh * 32 * 16384 + dv * 128 + dkc * 4);
        const f32x4* dc = (const f32x4*)((const float*)(a.ws + WS_DECAY) + (size_t)bh * 32 * 128 + dkc * 4);
        float r0 = 0.f, r1 = 0.f, r2 = 0.f, r3 = 0.f;
#pragma unroll 8
        for (int c = 0; c < 32; ++c) {
            const u32x2 u = st[(size_t)c * 4096]; const f32x4 dd = dc[c * 32];
            u32x2 o; o.x = pk2(r0, r1); o.y = pk2(r2, r3); st[(size_t)c * 4096] = o;
            r0 = dd.x * r0 + bflo(u.x); r1 = dd.y * r1 + bfhi(u.x); r2 = dd.z * r2 + bflo(u.y); r3 = dd.w * r3 + bfhi(u.y);
        }
    }
}
__device__ __forceinline__ void hgrn_stage3_unit(const Args& a, int l, LAS unsigned char* lds, int tid, int u, const HIn& in, HIn& nxt, int unext) {
    const int lane = tid & 63, w = __builtin_amdgcn_readfirstlane(tid >> 6), fr = lane & 15, fq = lane >> 4;
    const int bh = u >> 5, c = u & 31, b = bh >> 2, hh = bh & 3; const size_t row0 = (size_t)b * SEQ + c * 64;
    const int tt = w & 3, vh = w >> 2;
    bf16_t* proj = (bf16_t*)(a.ws + WS_PROJ);
    LAS float* LF = (LAS float*)lds;
    LAS unsigned char* QM = lds + 34816;
    LAS unsigned char* Q0 = QM + 17408;
    LAS unsigned char* KM = Q0 + 17408;
    LAS unsigned char* VN = KM + 17408;
    LAS float* SSQ = (LAS float*)(VN + 18432);
    float kf[16];
    hgrn_stepA(a, l, lds, tid, hh, in, kf);
    const size_t row = row0 + tt * 16 + fr;
    const bf16_t* ST = (const bf16_t*)(a.ws + WS_H) + ((size_t)bh * 32 + c) * 16384;
    bf16x8 stf[4][4]; u32x2 zz[4];
#pragma unroll
    for (int ks = 0; ks < 4; ++ks)
#pragma unroll
        for (int v = 0; v < 4; ++v) stf[ks][v] = *(const bf16x8*)(ST + ((vh * 4 + v) * 16 + fr) * 128 + ks * 32 + fq * 8);
#pragma unroll
    for (int v = 0; v < 4; ++v) zz[v] = *(const u32x2*)(proj + row * NCOL + CZ + 512 + hh * 128 + (vh * 4 + v) * 16 + fq * 4);
    hgrn_load<true>(a, tid, unext, nxt);
    hgrn_cumsum_scan(lds, tid);
#pragma unroll
    for (int ii = 0; ii < 2; ++ii) {
        const int cid = tid + 512 * ii, t = cid >> 4, d0 = (cid & 15) * 8;
        const u32x4 uq = in.q[ii];
        float q[8] = {bflo(uq.x), bfhi(uq.x), bflo(uq.y), bfhi(uq.y), bflo(uq.z), bfhi(uq.z), bflo(uq.w), bfhi(uq.w)};
        float qm[8], q0[8], km[8];
        const f32x4 at0 = *(const LAS f32x4*)(LF + t * 128 + d0), at1 = *(const LAS f32x4*)(LF + t * 128 + d0 + 4), am0 = *(const LAS f32x4*)(LF + 31 * 128 + d0), am1 = *(const LAS f32x4*)(LF + 31 * 128 + d0 + 4);
        const float Atv[8] = {at0.x, at0.y, at0.z, at0.w, at1.x, at1.y, at1.z, at1.w}, Amv[8] = {am0.x, am0.y, am0.z, am0.w, am1.x, am1.y, am1.z, am1.w};
#pragma unroll
        for (int i = 0; i < 8; ++i) { const float At = Atv[i], Am = Amv[i]; const float sq = silu(q[i]);
            qm[i] = sq * fexp(At - Am); q0[i] = sq * fexp(At); km[i] = kf[ii * 8 + i] * fexp(Am - At); }
        u32x4 o;
        o.x = pk2(qm[0], qm[1]); o.y = pk2(qm[2], qm[3]); o.z = pk2(qm[4], qm[5]); o.w = pk2(qm[6], qm[7]); *(LAS u32x4*)(QM + t * 272 + d0 * 2) = o;
        o.x = pk2(q0[0], q0[1]); o.y = pk2(q0[2], q0[3]); o.z = pk2(q0[4], q0[5]); o.w = pk2(q0[6], q0[7]); *(LAS u32x4*)(Q0 + t * 272 + d0 * 2) = o;
        o.x = pk2(km[0], km[1]); o.y = pk2(km[2], km[3]); o.z = pk2(km[4], km[5]); o.w = pk2(km[6], km[7]); *(LAS u32x4*)(KM + t * 272 + d0 * 2) = o;
        *(LAS u32x4*)(VN + t * 288 + d0 * 2) = in.v[ii];
    }
    BAR_LDS();
    f32x4 sc[4];
#pragma unroll
    for (int s = 0; s < 4; ++s) sc[s] = (f32x4){0.f, 0.f, 0.f, 0.f};
#pragma unroll
    for (int ks = 0; ks < 4; ++ks) {
        const bf16x8 qf = *(const LAS bf16x8*)(QM + (tt * 16 + fr) * 272 + (ks * 32 + fq * 8) * 2);
#pragma unroll
        for (int s = 0; s < 4; ++s) if (s <= tt) { const bf16x8 kfr = *(const LAS bf16x8*)(KM + (s * 16 + fr) * 272 + (ks * 32 + fq * 8) * 2); sc[s] = MFMA16(kfr, qf, sc[s]); }
    }
#pragma unroll
    for (int s = 0; s < 4; ++s)
#pragma unroll
        for (int jj = 0; jj < 4; ++jj) { const bool ok = (s < tt) || (s == tt && (fq * 4 + jj) <= fr); sc[s][jj] = ok ? sc[s][jj] : 0.f; }
    f32x4 o[4];
#pragma unroll
    for (int v = 0; v < 4; ++v) o[v] = (f32x4){0.f, 0.f, 0.f, 0.f};
#pragma unroll
    for (int kst = 0; kst < 2; ++kst) {
        if (kst * 2 <= tt) {
            u32x4 pw; pw.x = pk2(sc[2 * kst][0], sc[2 * kst][1]); pw.y = pk2(sc[2 * kst][2], sc[2 * kst][3]); pw.z = pk2(sc[2 * kst + 1][0], sc[2 * kst + 1][1]); pw.w = pk2(sc[2 * kst + 1][2], sc[2 * kst + 1][3]);
            const bf16x8 pb = __builtin_bit_cast(bf16x8, pw);
#pragma unroll
            for (int v = 0; v < 4; ++v) { const s16x4 lo = tr4(VN, 288, kst * 32 + fq * 4, (vh * 4 + v) * 16, fr), hi = tr4(VN, 288, kst * 32 + 16 + fq * 4, (vh * 4 + v) * 16, fr);
                const bf16x8 vf = __builtin_shufflevector(lo, hi, 0, 1, 2, 3, 4, 5, 6, 7);
                o[v] = MFMA16(vf, pb, o[v]); }
        }
    }
#pragma unroll
    for (int ks = 0; ks < 4; ++ks) {
        const bf16x8 q0f = *(const LAS bf16x8*)(Q0 + (tt * 16 + fr) * 272 + (ks * 32 + fq * 8) * 2);
#pragma unroll
        for (int v = 0; v < 4; ++v) o[v] = MFMA16(stf[ks][v], q0f, o[v]);
    }
    float ss = 0.f;
#pragma unroll
    for (int v = 0; v < 4; ++v)
#pragma unroll
        for (int jj = 0; jj < 4; ++jj) ss += o[v][jj] * o[v][jj];
    ss += __shfl_xor(ss, 16); ss += __shfl_xor(ss, 32);
    if (fq == 0) SSQ[vh * 64 + tt * 16 + fr] = ss;
    BAR_LDS();
    const float tot = SSQ[tt * 16 + fr] + SSQ[64 + tt * 16 + fr];
    const float r = frsq(tot * (1.f / 128.f) + EPS);
#pragma unroll
    for (int v = 0; v < 4; ++v) { const int v0 = (vh * 4 + v) * 16 + fq * 4;
        const f32x4 g = *(const f32x4*)(a.hon + l * 128 + v0);
        const u32x2 z = zz[v];
        u32x2 y; y.x = pk2(o[v][0] * r * g.x * silu(bflo(z.x)), o[v][1] * r * g.y * silu(bfhi(z.x))); y.y = pk2(o[v][2] * r * g.z * silu(bflo(z.y)), o[v][3] * r * g.w * silu(bfhi(z.y)));
        *(u32x2*)(proj + row * NCOL + CQH + hh * 128 + v0) = y; }
    BAR_LDS();
}

template <int D, int QT0>
__device__ __forceinline__ void qk_tile(const LAS unsigned char* Ks, int KP, const bf16x8 (&qf)[2][D / 32], f32x4 (&s)[4][2], int fr, int fq, float b0, float b1) {
#pragma unroll
    for (int a = 0; a < 4; ++a) { s[a][0] = (f32x4){b0, b0, b0, b0}; s[a][1] = (f32x4){b1, b1, b1, b1}; }
#pragma unroll
    for (int a = 0; a < 4; ++a)
#pragma unroll
        for (int ks = 0; ks < D / 32; ++ks) { const bf16x8 kfr = *(const LAS bf16x8*)(Ks + (a * 16 + fr) * KP + (ks * 32 + fq * 8) * 2);
            if (QT0 == 0) s[a][0] = MFMA16(kfr, qf[0][ks], s[a][0]);
            s[a][1] = MFMA16(kfr, qf[1][ks], s[a][1]); }
}
#define ONES8 ((bf16x8){16256, 16256, 16256, 16256, 16256, 16256, 16256, 16256})
template <int D, bool DIAG, int QT0>
__device__ __forceinline__ void sm_pv_tile(f32x4 (&s)[4][2], const LAS unsigned char* Vs, int VP, f32x4 (&o)[D / 16][2], f32x4 (&ol)[2], int fr, int fq, int keyl0, int qla, int qlb) {
#pragma unroll
    for (int qt = QT0; qt < 2; ++qt) {
        if (DIAG) {
            const int ql = (qt == 0 ? qla : qlb) + fr - keyl0 - fq * 4;
#pragma unroll
            for (int a = 0; a < 4; ++a)
#pragma unroll
                for (int jj = 0; jj < 4; ++jj) s[a][qt][jj] = (a * 16 + jj > ql) ? -1e30f : s[a][qt][jj];
        }
#pragma unroll
        for (int a = 0; a < 4; ++a)
#pragma unroll
            for (int jj = 0; jj < 4; ++jj) s[a][qt][jj] = ex2(s[a][qt][jj]);
    }
#pragma unroll
    for (int kst = 0; kst < 2; ++kst) {
        bf16x8 pb[2];
#pragma unroll
        for (int qt = QT0; qt < 2; ++qt) { u32x4 pw; pw.x = pk2(s[2 * kst][qt][0], s[2 * kst][qt][1]); pw.y = pk2(s[2 * kst][qt][2], s[2 * kst][qt][3]);
            pw.z = pk2(s[2 * kst + 1][qt][0], s[2 * kst + 1][qt][1]); pw.w = pk2(s[2 * kst + 1][qt][2], s[2 * kst + 1][qt][3]); pb[qt] = __builtin_bit_cast(bf16x8, pw); }
        if (QT0 == 0) ol[0] = MFMA16(ONES8, pb[0], ol[0]);
        ol[1] = MFMA16(ONES8, pb[1], ol[1]);
#pragma unroll
        for (int dt = 0; dt < D / 16; ++dt) { const s16x4 lo = tr4(Vs, VP, kst * 32 + fq * 4, dt * 16, fr), hi = tr4(Vs, VP, kst * 32 + 16 + fq * 4, dt * 16, fr);
            const bf16x8 vf = __builtin_shufflevector(lo, hi, 0, 1, 2, 3, 4, 5, 6, 7);
            if (QT0 == 0) o[dt][0] = MFMA16(vf, pb[0], o[dt][0]);
            o[dt][1] = MFMA16(vf, pb[1], o[dt][1]); }
    }
}
__device__ __forceinline__ void sm_pv_tile128(f32x4 (&sa)[4][2], f32x4 (&sb)[4][2], const LAS unsigned char* Vs, int VP, f32x4 (&o)[4][2], f32x4 (&ol)[2], int fr, int fq) {
#pragma unroll
    for (int qt = 0; qt < 2; ++qt)
#pragma unroll
        for (int a = 0; a < 4; ++a)
#pragma unroll
            for (int jj = 0; jj < 4; ++jj) { sa[a][qt][jj] = ex2(sa[a][qt][jj]); sb[a][qt][jj] = ex2(sb[a][qt][jj]); }
#pragma unroll
    for (int half = 0; half < 2; ++half)
#pragma unroll
        for (int kst = 0; kst < 2; ++kst) {
            bf16x8 pb[2];
#pragma unroll
            for (int qt = 0; qt < 2; ++qt) { const f32x4 x0 = half ? sb[2 * kst][qt] : sa[2 * kst][qt], x1 = half ? sb[2 * kst + 1][qt] : sa[2 * kst + 1][qt];
                u32x4 pw; pw.x = pk2(x0[0], x0[1]); pw.y = pk2(x0[2], x0[3]); pw.z = pk2(x1[0], x1[1]); pw.w = pk2(x1[2], x1[3]); pb[qt] = __builtin_bit_cast(bf16x8, pw); }
            ol[0] = MFMA16(ONES8, pb[0], ol[0]); ol[1] = MFMA16(ONES8, pb[1], ol[1]);
#pragma unroll
            for (int dt = 0; dt < 4; ++dt) { const s16x4 lo = tr4(Vs, VP, half * 64 + kst * 32 + fq * 4, dt * 16, fr), hi = tr4(Vs, VP, half * 64 + kst * 32 + 16 + fq * 4, dt * 16, fr);
                const bf16x8 vf = __builtin_shufflevector(lo, hi, 0, 1, 2, 3, 4, 5, 6, 7);
                o[dt][0] = MFMA16(vf, pb[0], o[dt][0]); o[dt][1] = MFMA16(vf, pb[1], o[dt][1]); }
            __builtin_amdgcn_sched_barrier(0);
        }
}
template <int D, bool DIAG, int QT0>
__device__ __forceinline__ void attn_tile(const LAS unsigned char* Ks, int KP, const LAS unsigned char* Vs, int VP, const bf16x8 (&qf)[2][D / 32], f32x4 (&o)[D / 16][2], f32x4 (&ol)[2],
                                          int fr, int fq, int keyl0, int qla, int qlb, float b0, float b1) {
    f32x4 s[4][2];
    qk_tile<D, QT0>(Ks, KP, qf, s, fr, fq, b0, b1);
    sm_pv_tile<D, DIAG, QT0>(s, Vs, VP, o, ol, fr, fq, keyl0, qla, qlb);
}

__device__ __forceinline__ void moba_unit(const Args& a, int l, LAS unsigned char* lds, int b, int h, int qb) {
    const int tid = otid(), lane = tid & 63, w = __builtin_amdgcn_readfirstlane(tid >> 6), fr = lane & 15, fq = lane >> 4;
    bf16_t* proj = (bf16_t*)(a.ws + WS_PROJ);
    LAS float* kml = (LAS float*)(lds + 77824);
    kml[tid] = ((const float*)(a.ws + WS_KMEAN))[(size_t)(b * 8 + h) * 512 + tid];
    const size_t rowbase = (size_t)b * SEQ;
    const bf16_t* Kc = (const bf16_t*)(a.ws + WS_KC) + (size_t)(b * 8 + h) * SEQ * 64; const bf16_t* Vc = (const bf16_t*)(a.ws + WS_VC) + (size_t)(b * 8 + h) * SEQ * 64;
    const int qrow[2] = {qb * 256 + w * 16, qb * 256 + (15 - w) * 16};
    bf16x8 qf[2][2];
#pragma unroll
    for (int qt = 0; qt < 2; ++qt)
#pragma unroll
        for (int ks = 0; ks < 2; ++ks) qf[qt][ks] = *(const bf16x8*)(proj + (rowbase + qrow[qt] + fr) * NCOL + CQA + h * 64 + ks * 32 + fq * 8);
    const int NT2 = (qb + 1) * 2;
    u32x4 kreg[2], vreg[2];
#define MOBA_T128(i) ((i) < 2 ? qb * 2 + (i) : (i) - 2)
#define MOBA_LOAD(t128) do { _Pragma("unroll") for (int ii = 0; ii < 2; ++ii) { const int cid = tid + 512 * ii; \
        kreg[ii] = *(const u32x4*)(Kc + (size_t)((t128) * 128) * 64 + cid * 8); \
        vreg[ii] = *(const u32x4*)(Vc + (size_t)((t128) * 128) * 64 + cid * 8); } } while (0)
#define MOBA_STORE(buf) do { _Pragma("unroll") for (int ii = 0; ii < 2; ++ii) { const int cid = tid + 512 * ii; \
        *(LAS u32x4*)(lds + (buf) * 38912 + (cid >> 3) * 144 + (cid & 7) * 16) = kreg[ii]; \
        *(LAS u32x4*)(lds + (buf) * 38912 + 18432 + (cid >> 3) * 160 + (cid & 7) * 16) = vreg[ii]; } } while (0)
    MOBA_LOAD(MOBA_T128(0));
    __syncthreads();
    unsigned selmask[2];
    if (qb <= 3) { selmask[0] = selmask[1] = (1u << qb) - 1u; }
    else {
#pragma unroll
        for (int qt = 0; qt < 2; ++qt) {
            float g[8];
#pragma unroll
            for (int j = 0; j < 8; ++j) { float psum = 0.f;
                if (j < qb) {
#pragma unroll
                    for (int ks = 0; ks < 2; ++ks)
#pragma unroll
                        for (int i = 0; i < 8; ++i) psum += bf2f(qf[qt][ks][i]) * kml[j * 64 + ks * 32 + fq * 8 + i];
                    psum += __shfl_xor(psum, 16); psum += __shfl_xor(psum, 32);
                }
                g[j] = (j < qb) ? psum : -INFINITY; }
            unsigned msk = 0u;
#pragma unroll
            for (int j = 0; j < 8; ++j) { int rank = 0;
#pragma unroll
                for (int mth = 0; mth < 8; ++mth) if (mth != j) rank += (g[mth] > g[j] || (g[mth] == g[j] && mth < j)) ? 1 : 0;
                if (j < qb && rank < 3) msk |= (1u << j); }
            selmask[qt] = msk;
        }
    }
    f32x4 o[4][2];
#pragma unroll
    for (int dt = 0; dt < 4; ++dt) { o[dt][0] = (f32x4){0.f, 0.f, 0.f, 0.f}; o[dt][1] = (f32x4){0.f, 0.f, 0.f, 0.f}; }
    float gm; { float xq = fabsf(a.mqn[l * 64 + lane]), xk = fabsf(a.mkn[l * 64 + lane]);
#pragma unroll
      for (int ofs = 1; ofs < 64; ofs <<= 1) { xq = fmaxf(xq, __shfl_xor(xq, ofs)); xk = fmaxf(xk, __shfl_xor(xk, ofs)); }
      gm = xq * xk * (8.f * 1.03f * LOG2E); }
    f32x4 ol[2] = {(f32x4){0.f, 0.f, 0.f, 0.f}, (f32x4){0.f, 0.f, 0.f, 0.f}};
    MOBA_STORE(0);
    BAR_LDS();
    for (int i = 0; i < NT2; ++i) {
        if (i + 1 < NT2) { const int tn = MOBA_T128(i + 1); MOBA_LOAD(tn); }
        const int t128 = MOBA_T128(i), j = t128 >> 1, hb = t128 & 1; const bool diag = (j == qb);
        const LAS unsigned char* Kb = lds + (i & 1) * 38912;
        const unsigned rs0 = diag ? 1u : ((selmask[0] >> j) & 1u), rs1 = diag ? 1u : ((selmask[1] >> j) & 1u);
        if (!diag) {
            f32x4 sA[4][2], sB[4][2];
            const float b0 = rs0 ? -gm : -1e30f, b1 = rs1 ? -gm : -1e30f;
            qk_tile<64, 0>(Kb, 144, qf, sA, fr, fq, b0, b1);
            qk_tile<64, 0>(Kb + 64 * 144, 144, qf, sB, fr, fq, b0, b1);
            sm_pv_tile128(sA, sB, Kb + 18432, 160, o, ol, fr, fq);
        } else
#pragma unroll
        for (int sub = 0; sub < 2; ++sub) {
            const int ktl = hb * 2 + sub;
            if (diag) {
                if (ktl <= (w >> 2)) attn_tile<64, true, 0>(Kb + sub * 64 * 144, 144, Kb + 18432 + sub * 64 * 160, 160, qf, o, ol, fr, fq, ktl * 64, w * 16, (15 - w) * 16, -gm, -gm);
                else if (ktl <= ((15 - w) >> 2)) attn_tile<64, true, 1>(Kb + sub * 64 * 144, 144, Kb + 18432 + sub * 64 * 160, 160, qf, o, ol, fr, fq, ktl * 64, w * 16, (15 - w) * 16, -gm, -gm);
            } else attn_tile<64, false, 0>(Kb + sub * 64 * 144, 144, Kb + 18432 + sub * 64 * 160, 160, qf, o, ol, fr, fq, 0, 0, 0, rs0 ? -gm : -1e30f, rs1 ? -gm : -1e30f);
        }
        if (i + 1 < NT2) MOBA_STORE((i + 1) & 1);
        BAR_LDS();
    }
#undef MOBA_T128
#undef MOBA_LOAD
#undef MOBA_STORE
#pragma unroll
    for (int qt = 0; qt < 2; ++qt) {
        const float inv = frcp(ol[qt][0]);
        const size_t row = rowbase + qrow[qt] + fr;
#pragma unroll
        for (int dt = 0; dt < 4; ++dt) { const int d0 = dt * 16 + fq * 4;
            const u32x2 z = *(const u32x2*)(proj + row * NCOL + CZ + h * 64 + d0);
            u32x2 y; y.x = pk2(o[dt][qt][0] * inv * silu(bflo(z.x)), o[dt][qt][1] * inv * silu(bfhi(z.x))); y.y = pk2(o[dt][qt][2] * inv * silu(bflo(z.y)), o[dt][qt][3] * inv * silu(bfhi(z.y)));
            *(u32x2*)(proj + row * NCOL + CQA + h * 64 + d0) = y; }
    }
    __syncthreads();
}

__device__ __forceinline__ void mem_unit(const Args& a, int l, LAS unsigned char* lds, int b, int hm, int qb) {
    const int tid = otid(), lane = tid & 63, w = __builtin_amdgcn_readfirstlane(tid >> 6), fr = lane & 15, fq = lane >> 4;
    bf16_t* proj = (bf16_t*)(a.ws + WS_PROJ);
    const bf16_t* kvm = (const bf16_t*)(a.ws + WS_KVM) + (size_t)b * MEML * 1024;
    const size_t rowbase = (size_t)b * SEQ; const int q0 = qb * 256 + w * 32;
    u32x4 ukr[2], uvr[2];
#define MEM_LOAD(kt) do { _Pragma("unroll") for (int ii = 0; ii < 2; ++ii) { const int cid = tid + 512 * ii; \
        ukr[ii] = *(const u32x4*)(kvm + (size_t)((kt) * 64 + (cid >> 4)) * 1024 + hm * 128 + (cid & 15) * 8); \
        uvr[ii] = *(const u32x4*)(kvm + (size_t)((kt) * 64 + (cid >> 4)) * 1024 + 512 + hm * 128 + (cid & 15) * 8); } } while (0)
    MEM_LOAD(0);
    bf16x8 qf[2][4];
#pragma unroll
    for (int qt = 0; qt < 2; ++qt) {
        u32x4 u[4]; float ss = 0.f;
#pragma unroll
        for (int ks = 0; ks < 4; ++ks) { u[ks] = *(const u32x4*)(proj + (rowbase + q0 + qt * 16 + fr) * NCOL + CQM + hm * 128 + ks * 32 + fq * 8);
            ss += bflo(u[ks].x) * bflo(u[ks].x) + bfhi(u[ks].x) * bfhi(u[ks].x) + bflo(u[ks].y) * bflo(u[ks].y) + bfhi(u[ks].y) * bfhi(u[ks].y)
                + bflo(u[ks].z) * bflo(u[ks].z) + bfhi(u[ks].z) * bfhi(u[ks].z) + bflo(u[ks].w) * bflo(u[ks].w) + bfhi(u[ks].w) * bfhi(u[ks].w); }
        ss += __shfl_xor(ss, 16); ss += __shfl_xor(ss, 32);
        const float r = frsq(ss * (1.f / 128.f) + EPS) * (0.08838834764831845f * LOG2E);
#pragma unroll
        for (int ks = 0; ks < 4; ++ks) { const float* g = a.memqn + l * 128 + ks * 32 + fq * 8; const f32x4 g0 = *(const f32x4*)g, g1 = *(const f32x4*)(g + 4);
            u32x4 o; o.x = pk2(bflo(u[ks].x) * r * g0.x, bfhi(u[ks].x) * r * g0.y); o.y = pk2(bflo(u[ks].y) * r * g0.z, bfhi(u[ks].y) * r * g0.w);
            o.z = pk2(bflo(u[ks].z) * r * g1.x, bfhi(u[ks].z) * r * g1.y); o.w = pk2(bflo(u[ks].w) * r * g1.z, bfhi(u[ks].w) * r * g1.w);
            qf[qt][ks] = __builtin_bit_cast(bf16x8, o); }
    }
    f32x4 o[8][2];
#pragma unroll
    for (int dt = 0; dt < 8; ++dt) { o[dt][0] = (f32x4){0.f, 0.f, 0.f, 0.f}; o[dt][1] = (f32x4){0.f, 0.f, 0.f, 0.f}; }
    float gm; { float xq = fmaxf(fabsf(a.memqn[l * 128 + lane]), fabsf(a.memqn[l * 128 + 64 + lane])), xk = fmaxf(fabsf(a.memkn[l * 128 + lane]), fabsf(a.memkn[l * 128 + 64 + lane]));
#pragma unroll
      for (int ofs = 1; ofs < 64; ofs <<= 1) { xq = fmaxf(xq, __shfl_xor(xq, ofs)); xk = fmaxf(xk, __shfl_xor(xk, ofs)); }
      gm = xq * xk * (11.3137085f * 1.03f * LOG2E); }
    f32x4 ol[2] = {(f32x4){0.f, 0.f, 0.f, 0.f}, (f32x4){0.f, 0.f, 0.f, 0.f}};
    LAS unsigned char* Ks = lds;
    LAS unsigned char* Vs = lds + 17408;
#define MEM_STORE(buf) do { _Pragma("unroll") for (int ii = 0; ii < 2; ++ii) { \
            const int cid = tid + 512 * ii, key = cid >> 4, dc = cid & 15; \
            const u32x4 uk = ukr[ii]; \
            float kv[8] = {bflo(uk.x), bfhi(uk.x), bflo(uk.y), bfhi(uk.y), bflo(uk.z), bfhi(uk.z), bflo(uk.w), bfhi(uk.w)}; \
            float ss = 0.f; \
            _Pragma("unroll") for (int i = 0; i < 8; ++i) ss += kv[i] * kv[i]; \
            ss += __shfl_xor(ss, 1); ss += __shfl_xor(ss, 2); ss += __shfl_xor(ss, 4); ss += __shfl_xor(ss, 8); \
            const float r = frsq(ss * (1.f / 128.f) + EPS); \
            const float* g = a.memkn + l * 128 + dc * 8; const f32x4 g0 = *(const f32x4*)g, g1 = *(const f32x4*)(g + 4); \
            u32x4 ok; ok.x = pk2(kv[0] * r * g0.x, kv[1] * r * g0.y); ok.y = pk2(kv[2] * r * g0.z, kv[3] * r * g0.w); ok.z = pk2(kv[4] * r * g1.x, kv[5] * r * g1.y); ok.w = pk2(kv[6] * r * g1.z, kv[7] * r * g1.w); \
            *(LAS u32x4*)(Ks + (buf) * 35840 + key * 272 + dc * 16) = ok; \
            *(LAS u32x4*)(Vs + (buf) * 35840 + key * 288 + dc * 16) = uvr[ii]; } } while (0)
    MEM_STORE(0);
    BAR_LDS();
    for (int kt = 0; kt < 4; ++kt) {
        if (kt < 3) MEM_LOAD(kt + 1);
        attn_tile<128, false, 0>(Ks + (kt & 1) * 35840, 272, Vs + (kt & 1) * 35840, 288, qf, o, ol, fr, fq, 0, 0, 0, -gm, -gm);
        if (kt < 3) MEM_STORE((kt + 1) & 1);
        BAR_LDS();
    }
#undef MEM_STORE
#undef MEM_LOAD
#pragma unroll
    for (int qt = 0; qt < 2; ++qt) {
        const float inv = frcp(ol[qt][0]);
        const size_t row = rowbase + q0 + qt * 16 + fr;
#pragma unroll
        for (int dt = 0; dt < 8; ++dt) { const int d0 = dt * 16 + fq * 4;
            const u32x2 z = *(const u32x2*)(proj + row * NCOL + CZ + 1024 + hm * 128 + d0);
            u32x2 y; y.x = pk2(o[dt][qt][0] * inv * silu(bflo(z.x)), o[dt][qt][1] * inv * silu(bfhi(z.x))); y.y = pk2(o[dt][qt][2] * inv * silu(bflo(z.y)), o[dt][qt][3] * inv * silu(bfhi(z.y)));
            *(u32x2*)(proj + row * NCOL + CQM + hm * 128 + d0) = y; }
    }
}

#define XB_TMO      128
#define XB_XCNT(j)  (256  + 64 * (j))
#define XB_XSUB(j)  (1280 + 64 * (j))
#define XB_XGEN(j)  (2304 + 64 * (j))
#define XB_TOP      3328
#define XB_TOPGEN   3392
#define XCD_BAR_WORDS 3456
#define XB_SPIN_CAP (1u << 18)
__device__ __forceinline__ unsigned xb_ld(unsigned* p)              { return __hip_atomic_load(p, __ATOMIC_RELAXED, __HIP_MEMORY_SCOPE_AGENT); }
__device__ __forceinline__ unsigned xb_add(unsigned* p, unsigned v) { return __hip_atomic_fetch_add(p, v, __ATOMIC_RELAXED, __HIP_MEMORY_SCOPE_AGENT); }
__device__ __forceinline__ unsigned xb_xcc_id() { return (unsigned)__builtin_amdgcn_s_getreg((3 << 11) | 20) & 0xFu; }
#define XB_SPIN(cond, bar) do { unsigned _sp = 0; while (cond) { __builtin_amdgcn_s_sleep(1); \
    if ((++_sp & 255u) == 0u) { if (xb_ld(&(bar)[XB_TMO])) break; if (_sp > XB_SPIN_CAP) { atomicAdd(&(bar)[XB_TMO], 1u); break; } } } } while (0)
struct XcdBarrier { unsigned* bar; unsigned x; volatile LAS unsigned* st; };
__device__ __forceinline__ XcdBarrier xcd_barrier_post(unsigned* bar, volatile LAS unsigned* st) {
    XcdBarrier b; b.bar = bar; b.x = xb_xcc_id(); b.st = st;
    if (threadIdx.x == 0) (void)xb_add(&bar[XB_XCNT(b.x)], 1u);
    return b;
}
__device__ __forceinline__ void xcd_barrier_complete(unsigned* bar, unsigned x, unsigned& nloc, unsigned& nx) {
    const unsigned G = gridDim.x * gridDim.y * gridDim.z;
    unsigned sum, cnt, mine, sp = 0u;
    for (;;) {
        sum = 0u; cnt = 0u; mine = 0u;
#pragma unroll
        for (unsigned j = 0; j < 16; ++j) { const unsigned c = xb_ld(&bar[XB_XCNT(j)]); sum += c; cnt += (c > 0u) ? 1u : 0u; mine = (j == x) ? c : mine; }
        if (sum == G) break;
        __builtin_amdgcn_s_sleep(1);
        if ((++sp & 255u) == 0u) { if (xb_ld(&bar[XB_TMO])) break; if (sp > XB_SPIN_CAP) { atomicAdd(&bar[XB_TMO], 1u); break; } }
    }
    nloc = mine > 0u ? mine : 1u; nx = cnt > 0u ? cnt : 1u;
}
__device__ __forceinline__ void xcd_barrier(const XcdBarrier& b) {
    asm volatile("s_waitcnt vmcnt(0)" ::: "memory");
    __syncthreads();
    if (threadIdx.x == 0) {
        unsigned* bar = b.bar;
        __builtin_amdgcn_s_waitcnt(0);
        unsigned nloc = b.st[0], nx = b.st[1];
        if (nloc == 0u) { xcd_barrier_complete(bar, b.x, nloc, nx); b.st[0] = nloc; b.st[1] = nx; }
        const unsigned old = xb_add(&bar[XB_XSUB(b.x)], 1u);
        const unsigned gen = old / nloc;
        if (old + 1u == (gen + 1u) * nloc) {
            __builtin_amdgcn_fence(__ATOMIC_RELEASE, "agent");
            asm volatile("s_waitcnt vmcnt(0)" ::: "memory");
            const unsigned og = xb_add(&bar[XB_TOP], 1u);
            const unsigned tg = og / nx;
            if (og + 1u == (tg + 1u) * nx) xb_add(&bar[XB_TOPGEN], 1u);
            else XB_SPIN(xb_ld(&bar[XB_TOPGEN]) == tg, bar);
            __builtin_amdgcn_fence(__ATOMIC_ACQUIRE, "agent");
            xb_add(&bar[XB_XGEN(b.x)], 1u);
            asm volatile("s_waitcnt vmcnt(0)" ::: "memory");
        } else {
            XB_SPIN(xb_ld(&bar[XB_XGEN(b.x)]) == gen, bar);
            __builtin_amdgcn_fence(__ATOMIC_ACQUIRE, "agent");
            asm volatile("s_waitcnt vmcnt(0)" ::: "memory");
        }
    }
    __syncthreads();
}

__global__ void __launch_bounds__(512) hymba_fwd(Args a) {
    extern __shared__ __attribute__((aligned(16))) unsigned char lds_raw[];
    LAS unsigned char* lds = (LAS unsigned char*)lds_raw;
    const int G = gridDim.x, bx = blockIdx.x;
    const int lo = a.ph_lo, hi = a.ph_hi;
    bf16_t* proj = (bf16_t*)(a.ws + WS_PROJ);
#define IN(k) (lo <= (k) && (k) < hi)
#define SEAM(k) do { if (IN(k) && IN((k) + 1)) { if (a.pad == 0x5eed) cg::this_grid().sync(); xcd_barrier(xbar); } } while (0)
    volatile LAS unsigned* xst = (volatile LAS unsigned*)(lds + LDS_BYTES - 16);
    if (threadIdx.x < 2) xst[threadIdx.x] = 0u;
    __syncthreads();
    XcdBarrier xbar; xbar.bar = (unsigned*)(a.ws + WS_BAR); xbar.x = 0; xbar.st = xst;
    if (hi - lo > 1) xbar = xcd_barrier_post((unsigned*)(a.ws + WS_BAR), xst);
    if (IN(0)) { p0_phase(a, lds); __syncthreads(); }
    SEAM(0);
#pragma unroll 1
    for (int l = 0; l < 2; ++l) {
        const int base = 1 + 5 * l;
        if (IN(base)) {
            {
            pg8::Gemm g{(const bf16_t*)(a.ws + WS_H), (const bf16_t*)(a.ws + WS_WIN) + (size_t)l * NIN * DM, NTOK, NIN, DM, DM};
            pg8::StaticOrder S; S.init(NTOK, NIN, G, bx);
            pg8::EpiBf16Scale E{proj, NCOL, (bf16_t*)(a.ws + WS_KC), (bf16_t*)(a.ws + WS_VC)};
            if (G == 256) {
                pg8::Unit u0; if (S.next(0, u0) && threadIdx.x < 256) { const float* rss = (const float*)(a.ws + WS_RSS) + u0.pm * 256 + threadIdx.x;
                    ((LAS float*)(lds + 131072))[threadIdx.x] = frsq(((rss[0] + rss[NTOK]) + (rss[2 * NTOK] + rss[3 * NTOK])) * (1.f / 1024.f) + EPS); }
                __syncthreads();
                pg8::gemm_phase<pg8::EpiBf16Scale, pg8::StaticOrder>(lds, g, S, E);
            } else {
                for (int i = 0; ; ++i) { pg8::Unit u0; if (!S.next(i, u0)) break;
                    if (threadIdx.x < 256) { const float* rss = (const float*)(a.ws + WS_RSS) + u0.pm * 256 + threadIdx.x;
                        ((LAS float*)(lds + 131072))[threadIdx.x] = frsq(((rss[0] + rss[NTOK]) + (rss[2 * NTOK] + rss[3 * NTOK])) * (1.f / 1024.f) + EPS); }
                    __syncthreads();
                    pg8::StaticOrder S1; S1.init(NTOK, NIN, 1 << 30, i * G + bx);
                    pg8::gemm_phase<pg8::EpiBf16Scale, pg8::StaticOrder>(lds, g, S1, E); __syncthreads(); }
            }
            __syncthreads();
            }
        }
        SEAM(base);
        if (IN(base + 1)) {
            const int NKV = (G >= 64) ? 32 : 0;
            {
            {
                pg8::Gemm g{(const bf16_t*)(a.ws + (l ? WS_MEMH1 : WS_MEMH)), (const bf16_t*)(a.ws + WS_WMEM) + (size_t)l * DM * DM, NMEM, 1024, DM, DM};
                pg8::StaticOrder S; S.init(NMEM, 1024, G, bx);
                pg8::EpiBf16 E{(bf16_t*)(a.ws + WS_KVM), 1024};
                pg8::gemm_phase<pg8::EpiBf16, pg8::StaticOrder>(lds, g, S, E);
                __syncthreads();
            }
            if (bx >= NKV) {
                const int wb = bx - NKV, WG = G - NKV;
                const int tid = otid();
                { PrepIn cur; int u = wb; moba_prep_load(a, tid, u < 512 ? u : 0, cur);
                  for (; u < 512; u += WG) { PrepIn nxt; moba_prep_unit(a, l, lds, tid, u, cur, nxt, (u + WG < 512) ? u + WG : u); cur = nxt; } }
                { HIn cur; int u = (wb + 160) % WG;     hgrn_load<false>(a, tid, u < 1024 ? u : 0, cur);
                  for (; u < 1024; u += WG) { HIn nxt; hgrn_stage1_unit(a, l, lds, tid, u, cur, nxt, (u + WG < 1024) ? u + WG : u); cur = nxt; } }
                __syncthreads();
            }
            }
        }
        SEAM(base + 1);
        if (IN(base + 2)) {
            {
                for (int u = bx; u < 512; u += G) {
                    int bh, qb; if (G == 256) { bh = bx >> 2; const int s = bx & 3; qb = (u < 256) ? 7 - s : s; } else { bh = u >> 3; qb = 7 - (u & 7); }
                    moba_unit(a, l, lds, bh >> 3, bh & 7, qb);
                }
            }
            for (int u = bx; u < 256; u += G) mem_unit(a, l, lds, u >> 5, (u >> 3) & 3, u & 7);
            hgrn_scan_phase(a);
            __syncthreads();
        }
        SEAM(base + 2);
        if (IN(base + 3)) {
            { const int tid = otid(); HIn cur; int u = bx; hgrn_load<true>(a, tid, u < 1024 ? u : 0, cur);
                for (; u < 1024; u += G) { HIn nxt; hgrn_stage3_unit(a, l, lds, tid, u, cur, nxt, (u + G < 1024) ? u + G : u); cur = nxt; } }
            __syncthreads();
        }
        SEAM(base + 3);
        if (IN(base + 4)) {
            pg8::Gemm g{proj, (const bf16_t*)(a.ws + WS_WOUT) + (size_t)l * DM * DMIX, NTOK, DM, DMIX, NCOL};
            pg8::StaticOrder S; S.init(NTOK, DM, G, bx);
            if (l == 0) { {
                pg8::EpiResF32Norm E{a.x, a.out, DM, a.norm_g + DM, (bf16_t*)(a.ws + WS_H), (float*)(a.ws + WS_RSS)};
                pg8::gemm_phase<pg8::EpiResF32Norm, pg8::StaticOrder>(lds, g, S, E); __syncthreads(); } }
            else { pg8::EpiResF32 E{(const float*)a.out, a.out, DM};
                pg8::gemm_phase<pg8::EpiResF32, pg8::StaticOrder>(lds, g, S, E); __syncthreads(); }
        }
        if (l == 0) SEAM(base + 4);
    }
#undef IN
#undef SEAM
}

extern "C" void kernel_launch(void* const* d_in, const int* in_sizes, int n_in, void* d_out, int out_size, void* d_ws, size_t ws_size, hipStream_t stream) {
    static int grid = 0;
    if (grid == 0) {
        if (n_in != 14 || out_size != NTOK * DM || ws_size < WS_BAR + 65536) { fprintf(stderr, "kernel_launch: unexpected shapes (n_in %d out %d ws %zu)\n", n_in, out_size, ws_size); grid = -1; return; }
        int dev = 0, cus = 0, per_cu = 0;
        hipGetDevice(&dev); hipDeviceGetAttribute(&cus, hipDeviceAttributeMultiprocessorCount, dev);
        if (hipFuncSetAttribute((const void*)hymba_fwd, hipFuncAttributeMaxDynamicSharedMemorySize, LDS_BYTES) != hipSuccess) { fprintf(stderr, "kernel_launch: hipFuncSetAttribute failed\n"); grid = -1; return; }
        if (hipOccupancyMaxActiveBlocksPerMultiprocessor(&per_cu, (const void*)hymba_fwd, 512, LDS_BYTES) != hipSuccess || per_cu < 1) { fprintf(stderr, "kernel_launch: occupancy query says %d\n", per_cu); per_cu = 1; }
        (void)hipGetLastError();
        grid = cus * (per_cu > 1 ? 1 : per_cu);
    }
    if (grid < 0) return;
    if (hipMemsetAsync((char*)d_ws + WS_BAR, 0, XCD_BAR_WORDS * 4, stream) != hipSuccess) { fprintf(stderr, "kernel_launch: memset failed\n"); return; }
    Args a{};
    a.x = (const float*)d_in[0]; a.mem = (const float*)d_in[1]; a.pos = (const int*)d_in[2]; a.norm_g = (const float*)d_in[3]; a.w_in = (const float*)d_in[4]; a.w_out = (const float*)d_in[5];
    a.mqn = (const float*)d_in[6]; a.mkn = (const float*)d_in[7]; a.lbl = (const float*)d_in[8]; a.hon = (const float*)d_in[9]; a.mng = (const float*)d_in[10]; a.wmem = (const float*)d_in[11];
    a.memqn = (const float*)d_in[12]; a.memkn = (const float*)d_in[13]; a.out = (float*)d_out; a.ws = (unsigned char*)d_ws; a.rep = 0;
#if MK_ONE_LAUNCH
    a.ph_lo = 0; a.ph_hi = NPHASE;
    void* args[] = {&a};
    hipError_t e = hipLaunchCooperativeKernel((const void*)hymba_fwd, dim3(grid), dim3(512), args, LDS_BYTES, stream);
    if (e != hipSuccess) fprintf(stderr, "cooperative launch failed: %s (grid %d)\n", hipGetErrorString(e), grid);
#else
    for (int p = 0; p < NPHASE; ++p) { a.ph_lo = p; a.ph_hi = p + 1; hipLaunchKernelGGL(hymba_fwd, dim3(grid), dim3(512), LDS_BYTES, stream, a); }
#endif
}
```

```cpp
#include <hip/hip_runtime.h>
#include <hip/hip_cooperative_groups.h>
#include <cstdio>
#include <cstdint>
namespace cg = cooperative_groups;

#ifndef MK_ONE_LAUNCH
#define MK_ONE_LAUNCH 1
#endif

#define LAS __attribute__((address_space(3)))
typedef unsigned short bf16_t;
typedef short bf16x8 __attribute__((ext_vector_type(8)));
typedef short s16x4 __attribute__((ext_vector_type(4)));
typedef float f32x4 __attribute__((ext_vector_type(4)));
typedef unsigned u32x4 __attribute__((ext_vector_type(4)));
typedef unsigned u32x2 __attribute__((ext_vector_type(2)));

constexpr int NB = 8, SEQ = 2048, DM = 1024, NTOK = NB * SEQ, MEML = 256, NMEM = NB * MEML, NCOL = 4096  , NIN = 5120  , DMIX = 1536;
constexpr int CQA = 0, CQH = 512, CQM = 1024, CZ = 1536, CFH = 3072, CIH = 3584;
constexpr float EPS = 1e-6f;
constexpr float LOG2E = 1.4426950408889634f;
constexpr size_t MiB = 1u << 20;
constexpr size_t WS_WIN = 0, WS_WOUT = 20 * MiB, WS_WMEM = 26 * MiB, WS_H = 30 * MiB  , WS_MEMH = 62 * MiB, WS_KVM = 66 * MiB,
                 WS_PROJ = 70 * MiB, WS_KC = 198 * MiB, WS_VC = 214 * MiB, WS_VT = 230 * MiB, WS_KMEAN = 246 * MiB, WS_DECAY = 246 * MiB + 128 * 1024, WS_ROPE = 247 * MiB, WS_END = 248 * MiB, WS_MEMH1 = 230 * MiB  , WS_RSS = 250 * MiB  , WS_LB = 251 * MiB  , WS_BAR = 252 * MiB  ;
constexpr int LDS_BYTES = 147456;
constexpr int NPHASE = 11;

struct Args {
    const float *x, *mem; const int* pos; const float *norm_g, *w_in, *w_out, *mqn, *mkn, *lbl, *hon, *mng, *wmem, *memqn, *memkn;
    float* out; unsigned char* ws; int ph_lo, ph_hi, rep, pad;
};

typedef float f32x2_t __attribute__((ext_vector_type(2))); typedef __bf16 bf16x2_t __attribute__((ext_vector_type(2)));
__device__ __forceinline__ unsigned pk2(float lo, float hi) { f32x2_t v = {lo, hi}; bf16x2_t b = __builtin_convertvector(v, bf16x2_t); return __builtin_bit_cast(unsigned, b); }
__device__ __forceinline__ unsigned f2bf(float f) { return pk2(f, 0.f) & 0xffffu; }
__device__ __forceinline__ float bflo(unsigned u) { return __uint_as_float(u << 16); }
__device__ __forceinline__ float bfhi(unsigned u) { return __uint_as_float(u & 0xffff0000u); }
__device__ __forceinline__ float bf2f(short s) { return __uint_as_float(((unsigned)(unsigned short)s) << 16); }
__device__ __forceinline__ float wave_sum(float v) {
#pragma unroll
    for (int o = 1; o < 64; o <<= 1) v += __shfl_xor(v, o);
    return v;
}
__device__ __forceinline__ float ex2(float x) { return __builtin_amdgcn_exp2f(x); }
__device__ __forceinline__ float fexp(float x) { return __builtin_amdgcn_exp2f(x * LOG2E); }
__device__ __forceinline__ float frcp(float x) { return __builtin_amdgcn_rcpf(x); }
__device__ __forceinline__ float frsq(float x) { return __builtin_amdgcn_rsqf(x); }
__device__ __forceinline__ float sigm(float x) { return frcp(1.f + fexp(-x)); }
__device__ __forceinline__ float silu(float x) { return x * frcp(1.f + fexp(-x)); }
#define LDS_WAIT() asm volatile("s_waitcnt lgkmcnt(0)" ::: "memory")
__device__ __forceinline__ int otid() { int t = threadIdx.x; asm volatile("" : "+v"(t)); return t; }
typedef short v4i16_t __attribute__((ext_vector_type(4)));
__device__ __forceinline__ s16x4 tr4(const LAS unsigned char* base, int pitch, int r0, int c0, int lane) {
    const int q = (lane & 15) >> 2, p = lane & 3;
    return __builtin_bit_cast(s16x4, __builtin_amdgcn_ds_read_tr16_b64_v4i16((LAS v4i16_t*)(base + (r0 + q) * pitch + (c0 + 4 * p) * 2)));
}
#define MFMA16(a, b, c) __builtin_amdgcn_mfma_f32_16x16x32_bf16((a), (b), (c), 0, 0, 0)

namespace pg8 {
constexpr int BM = 256, BK = 64, HALF = 128, HTB = HALF * BK * 2, NXCD = 8, WGM = 8;
__host__ __device__ __forceinline__ int lds_byte(int r, int c) { const int st = (r >> 4) * 2 + (c >> 5), rr = r & 15, cc = c & 31, ob = rr * 64 + cc * 2; return st * 1024 + (ob ^ (((ob >> 9) & 1) << 5)); }
__host__ __device__ __forceinline__ void stage_rc(int b, int& R, int& C) { const int st = b / 1024, sb = b % 1024, swz = sb ^ (((sb >> 9) & 1) << 5); R = (st >> 1) * 16 + swz / 64; C = (st & 1) * 32 + (swz % 64) / 2; }
__host__ __device__ __forceinline__ int perm32(int rho) { const int n = rho >> 4, i = rho & 15; return 8 * (i >> 2) + 4 * n + (i & 3); }
struct Unit { int pm, pn; };
struct Gemm { const bf16_t* A; const bf16_t* Bt; int M, N, K, lda; };
struct StaticOrder {
    int nM, nN, nwg, G, c;
    __device__ void init(int M, int N, int G_, int c_) { nM = M / BM; nN = N / BM; nwg = nM * nN; G = G_; c = c_; }
    __device__ bool next(int i, Unit& u) const {
        const long L = (long)i * G + c; if (L >= nwg) return false;
        int wgid = (int)L; { const int q = nwg / NXCD, r = nwg % NXCD, xcd = wgid % NXCD, off = wgid / NXCD; wgid = (xcd < r ? xcd * (q + 1) : r * (q + 1) + (xcd - r) * q) + off; }
        const int nig = WGM * nN, gid = wgid / nig, fm = gid * WGM, gsz = (nM - fm) < WGM ? (nM - fm) : WGM;
        u.pm = fm + ((wgid % nig) % gsz); u.pn = (wgid % nig) / gsz; return true;
    }
};
__device__ __forceinline__ unsigned cvt_pk_bf16(float lo, float hi) { unsigned r; asm volatile("v_cvt_pk_bf16_f32 %0, %1, %2" : "=v"(r) : "v"(lo), "v"(hi)); return r; }
struct EpiBf16 {
    static constexpr bool PERM = true;
    bf16_t* O; int ldc;
    __device__ __forceinline__ void operator()(const f32x4 (&acc)[2][2][4][2], const Unit& u, int wr, int wc, int fr, int fq, LAS unsigned char*) const {
        const int row0 = u.pm * BM + wr * 64 + fr; const int col0 = u.pn * BM + wc * 32 + 8 * fq;
#pragma unroll
        for (int ai = 0; ai < 2; ++ai)
#pragma unroll
            for (int m = 0; m < 4; ++m) { bf16_t* rowp = O + (size_t)(row0 + ai * HALF + m * 16) * ldc + col0;
#pragma unroll
                for (int bj = 0; bj < 2; ++bj) { const f32x4 v0 = acc[ai][bj][m][0], v1 = acc[ai][bj][m][1];
                    u32x4 w; w.x = cvt_pk_bf16(v0[0], v0[1]); w.y = cvt_pk_bf16(v0[2], v0[3]); w.z = cvt_pk_bf16(v1[0], v1[1]); w.w = cvt_pk_bf16(v1[2], v1[3]);
                    *(u32x4*)(rowp + bj * HALF) = w; } }
    }
};
struct EpiBf16Scale {
    static constexpr bool PERM = true;
    bf16_t* O; int ldc; bf16_t* Kc; bf16_t* Vc;
    __device__ __forceinline__ void operator()(const f32x4 (&acc)[2][2][4][2], const Unit& u, int wr, int wc, int fr, int fq, LAS unsigned char* lds) const {
        const int row0 = u.pm * BM + wr * 64 + fr; const int col0 = u.pn * BM + wc * 32 + 8 * fq;
        const LAS float* rtab = (const LAS float*)(lds + 131072);
        const bool compact = u.pn >= 16;
#pragma unroll
        for (int ai = 0; ai < 2; ++ai)
#pragma unroll
            for (int m = 0; m < 4; ++m) { const int row = row0 + ai * HALF + m * 16;
                const float r = rtab[ai * HALF + wr * 64 + m * 16 + fr];
#pragma unroll
                for (int bj = 0; bj < 2; ++bj) { const f32x4 v0 = acc[ai][bj][m][0] * r, v1 = acc[ai][bj][m][1] * r;
                    u32x4 w; w.x = cvt_pk_bf16(v0[0], v0[1]); w.y = cvt_pk_bf16(v0[2], v0[3]); w.z = cvt_pk_bf16(v1[0], v1[1]); w.w = cvt_pk_bf16(v1[2], v1[3]);
                    bf16_t* dst;
                    if (compact) { const int cc = col0 + bj * HALF - 4096, hc = cc & 511, hh = hc >> 6, d = hc & 63;
                        dst = ((cc >> 9) ? Vc : Kc) + ((size_t)((row >> 11) * 8 + hh) * 2048 + (row & 2047)) * 64 + d; }
                    else dst = O + (size_t)row * ldc + col0 + bj * HALF;
                    *(u32x4*)dst = w; } }
    }
};
struct EpiResF32Norm {
    static constexpr bool PERM = true;
    const float* res; float* O; int ldc; const float* g; bf16_t* H; float* rss;
    __device__ __forceinline__ void operator()(const f32x4 (&acc)[2][2][4][2], const Unit& u, int wr, int wc, int fr, int fq, LAS unsigned char* lds) const {
        const int row0 = u.pm * BM + wr * 64 + fr; const int col0 = u.pn * BM + wc * 32 + 8 * fq;
        LAS float* part = (LAS float*)(lds + 131072);
        f32x4 gg[2][2];
#pragma unroll
        for (int bj = 0; bj < 2; ++bj)
#pragma unroll
            for (int n = 0; n < 2; ++n) gg[bj][n] = *(const f32x4*)(g + col0 + bj * HALF + 4 * n);
#pragma unroll
        for (int ai = 0; ai < 2; ++ai)
#pragma unroll
            for (int m = 0; m < 4; ++m) { const size_t ro = (size_t)(row0 + ai * HALF + m * 16) * ldc + col0; float ssq = 0.f;
#pragma unroll
                for (int bj = 0; bj < 2; ++bj) { const size_t o = ro + bj * HALF;
                    const f32x4 r0 = *(const f32x4*)(res + o), r1 = *(const f32x4*)(res + o + 4);
                    const f32x4 x0 = r0 + acc[ai][bj][m][0], x1 = r1 + acc[ai][bj][m][1];
                    *(f32x4*)(O + o) = x0; *(f32x4*)(O + o + 4) = x1;
                    u32x4 hb; hb.x = cvt_pk_bf16(x0[0] * gg[bj][0][0], x0[1] * gg[bj][0][1]); hb.y = cvt_pk_bf16(x0[2] * gg[bj][0][2], x0[3] * gg[bj][0][3]);
                    hb.z = cvt_pk_bf16(x1[0] * gg[bj][1][0], x1[1] * gg[bj][1][1]); hb.w = cvt_pk_bf16(x1[2] * gg[bj][1][2], x1[3] * gg[bj][1][3]);
                    *(u32x4*)(H + o) = hb;
                    ssq += ((x0[0] * x0[0] + x0[1] * x0[1]) + (x0[2] * x0[2] + x0[3] * x0[3])) + ((x1[0] * x1[0] + x1[1] * x1[1]) + (x1[2] * x1[2] + x1[3] * x1[3])); }
                ssq += __shfl_xor(ssq, 16); ssq += __shfl_xor(ssq, 32);
                if (fq == 0) part[(ai * HALF + wr * 64 + m * 16 + fr) * 4 + wc] = ssq; }
        asm volatile("s_waitcnt lgkmcnt(0)" ::: "memory"); __builtin_amdgcn_s_barrier(); asm volatile("" ::: "memory");
        const int t = threadIdx.x;
        if (t < 256) { const f32x4 p = *(const LAS f32x4*)(part + t * 4); rss[(size_t)u.pn * NTOK + u.pm * BM + t] = (p[0] + p[1]) + (p[2] + p[3]); }
    }
};
struct EpiResF32 {
    static constexpr bool PERM = true;
    const float* res; float* O; int ldc;
    __device__ __forceinline__ void operator()(const f32x4 (&acc)[2][2][4][2], const Unit& u, int wr, int wc, int fr, int fq, LAS unsigned char*) const {
        const int row0 = u.pm * BM + wr * 64 + fr; const int col0 = u.pn * BM + wc * 32 + 8 * fq;
#pragma unroll
        for (int ai = 0; ai < 2; ++ai)
#pragma unroll
            for (int m = 0; m < 4; ++m) { const size_t ro = (size_t)(row0 + ai * HALF + m * 16) * ldc + col0;
#pragma unroll
                for (int bj = 0; bj < 2; ++bj) { const size_t o = ro + bj * HALF; const f32x4 r0 = *(const f32x4*)(res + o), r1 = *(const f32x4*)(res + o + 4);
                    *(f32x4*)(O + o) = r0 + acc[ai][bj][m][0]; *(f32x4*)(O + o + 4) = r1 + acc[ai][bj][m][1]; } }
    }
};

template <class Epi, class Sched>
__device__ __forceinline__ void gemm_phase(LAS unsigned char* lds, const Gemm g, const Sched& S, const Epi& E) {
    const int tid = otid(), wid = __builtin_amdgcn_readfirstlane(tid >> 6), lane = tid & 63, wr = wid >> 2, wc = wid & 3, fr = lane & 15, fq = lane >> 4;
    const int K = g.K, nt = K / BK, lda = g.lda;
    unsigned voffA[2], voffB[2];
#pragma unroll
    for (int i = 0; i < 2; ++i) { int R, C; stage_rc(tid * 16 + i * 8192, R, C); const int Rb = Epi::PERM ? ((R & ~31) + perm32(R & 31)) : R;
        voffA[i] = (unsigned)(R * lda + C) * 2u; voffB[i] = (unsigned)(Rb * K + C) * 2u; }
    const size_t kstep = (size_t)(BK * 2);
    const size_t hstepA = (size_t)HALF * lda * 2, hstepB = (size_t)HALF * K * 2;
    const size_t tstepA = 2 * hstepA, tstepB = 2 * hstepB;
    const unsigned ldsw = (unsigned)wid * 1024u;
    const int aoff = lds_byte(wr * 64 + fr, fq * 8), boff = lds_byte(wc * 32 + fr, fq * 8);
#define PG8_SA(b, h) (((b) * 2 + (h)) * HTB)
#define PG8_SB(b, h) ((4 + (b) * 2 + (h)) * HTB)
#define PG8_STAGE(bufoff, gbase, voff) do { _Pragma("unroll") for (int _i = 0; _i < 2; ++_i) \
        __builtin_amdgcn_global_load_lds((const unsigned*)((const char*)(gbase) + (voff)[_i]), (LAS unsigned*)(lds + (bufoff) + ldsw + _i * 8192), 16, 0, 0); } while (0)
#define PG8_LDA(dst, b, h) do { _Pragma("unroll") for (int m = 0; m < 4; ++m) _Pragma("unroll") for (int k = 0; k < 2; ++k) dst[m][k] = *(const LAS bf16x8*)(lds + PG8_SA(b, h) + aoff + m * 2048 + k * 1024); } while (0)
#define PG8_LDB(dst, b, h) do { _Pragma("unroll") for (int n = 0; n < 2; ++n) _Pragma("unroll") for (int k = 0; k < 2; ++k) dst[n][k] = *(const LAS bf16x8*)(lds + PG8_SB(b, h) + boff + n * 2048 + k * 1024); } while (0)
#define PG8_MMA(ai, bj, At, Bt) do { __builtin_amdgcn_s_setprio(1); _Pragma("unroll") for (int m = 0; m < 4; ++m) _Pragma("unroll") for (int n = 0; n < 2; ++n) _Pragma("unroll") for (int k = 0; k < 2; ++k) \
        acc[ai][bj][m][n] = __builtin_amdgcn_mfma_f32_16x16x32_bf16(Bt[n][k], At[m][k], acc[ai][bj][m][n], 0, 0, 0); __builtin_amdgcn_s_setprio(0); } while (0)
#define PG8_WAIT_V(n) asm volatile("s_waitcnt vmcnt(" #n ")" ::: "memory")
#define PG8_WAIT_L(n) asm volatile("s_waitcnt lgkmcnt(" #n ")" ::: "memory")
#define PG8_BAR __builtin_amdgcn_s_barrier()
#define PG8_SCHED __builtin_amdgcn_sched_barrier(0)
    Unit cur, nxt; int ui = 0;
    if (!S.next(0, cur)) return;
    f32x4 acc[2][2][4][2];
#pragma unroll
    for (int a = 0; a < 2; ++a)
#pragma unroll
        for (int b = 0; b < 2; ++b)
#pragma unroll
            for (int m = 0; m < 4; ++m)
#pragma unroll
                for (int n = 0; n < 2; ++n) acc[a][b][m][n] = (f32x4){0.f, 0.f, 0.f, 0.f};
    bf16x8 At[4][2], B0[2][2], B1[2][2];
    const char* cA = (const char*)g.A + (size_t)cur.pm * tstepA; const char* cB = (const char*)g.Bt + (size_t)cur.pn * tstepB;
    PG8_STAGE(PG8_SB(0, 0), cB, voffB); PG8_STAGE(PG8_SB(0, 1), cB + hstepB, voffB); PG8_STAGE(PG8_SA(0, 0), cA, voffA); PG8_STAGE(PG8_SA(0, 1), cA + hstepA, voffA);
    if (wr == 1) PG8_BAR;
    PG8_WAIT_V(2); PG8_BAR;
    PG8_STAGE(PG8_SB(1, 0), cB + kstep, voffB); PG8_STAGE(PG8_SA(1, 0), cA + kstep, voffA); PG8_STAGE(PG8_SB(1, 1), cB + hstepB + kstep, voffB);
    PG8_WAIT_V(6); PG8_BAR;
    for (;;) {
        const bool has_next = S.next(ui + 1, nxt);
        const char* nA = has_next ? (const char*)g.A + (size_t)nxt.pm * tstepA : cA; const char* nB = has_next ? (const char*)g.Bt + (size_t)nxt.pn * tstepB : cB;
        for (int t = 0; t < nt; t += 2) {
            const bool last = (t == nt - 2);
            const char* a1 = cA + (size_t)(t + 1) * kstep;
            const char* a2 = last ? nA : cA + (size_t)(t + 2) * kstep; const char* b2 = last ? nB : cB + (size_t)(t + 2) * kstep;
            const char* a3 = a2 + kstep; const char* b3 = b2 + kstep;
            PG8_LDB(B0, 0, 0); PG8_LDB(B1, 0, 1); PG8_SCHED; PG8_LDA(At, 0, 0); PG8_STAGE(PG8_SA(1, 1), a1 + hstepA, voffA);
            PG8_WAIT_V(8); PG8_WAIT_L(0); PG8_BAR; PG8_MMA(0, 0, At, B0); PG8_MMA(0, 1, At, B1); PG8_BAR; PG8_SCHED;
            PG8_LDA(At, 0, 1); PG8_STAGE(PG8_SB(0, 0), b2, voffB); PG8_STAGE(PG8_SB(0, 1), b2 + hstepB, voffB); PG8_STAGE(PG8_SA(0, 0), a2, voffA);
            PG8_WAIT_V(8); PG8_WAIT_L(0); PG8_BAR; PG8_MMA(1, 0, At, B0); PG8_MMA(1, 1, At, B1); PG8_BAR; PG8_SCHED;
            PG8_LDB(B0, 1, 0); PG8_LDB(B1, 1, 1); PG8_SCHED; PG8_LDA(At, 1, 0); PG8_STAGE(PG8_SA(0, 1), a2 + hstepA, voffA);
            PG8_WAIT_V(8); PG8_WAIT_L(0); PG8_BAR; PG8_MMA(0, 0, At, B0); PG8_MMA(0, 1, At, B1); PG8_BAR; PG8_SCHED;
            PG8_LDA(At, 1, 1); PG8_STAGE(PG8_SB(1, 0), b3, voffB); PG8_STAGE(PG8_SB(1, 1), b3 + hstepB, voffB); PG8_STAGE(PG8_SA(1, 0), a3, voffA);
            PG8_WAIT_V(8); PG8_WAIT_L(0); PG8_BAR; PG8_MMA(1, 0, At, B0); PG8_MMA(1, 1, At, B1); PG8_BAR; PG8_SCHED;
        }
        if (wr == 0) PG8_BAR;
        E(acc, cur, wr, wc, fr, fq, lds);
        if (!has_next) break;
#pragma unroll
        for (int a = 0; a < 2; ++a)
#pragma unroll
            for (int b = 0; b < 2; ++b)
#pragma unroll
                for (int m = 0; m < 4; ++m)
#pragma unroll
                    for (int n = 0; n < 2; ++n) acc[a][b][m][n] = (f32x4){0.f, 0.f, 0.f, 0.f};
        cur = nxt; cA = nA; cB = nB; ++ui;
        if (wr == 1) PG8_BAR;
    }
    PG8_WAIT_V(0);
    PG8_BAR;
#undef PG8_SA
#undef PG8_SB
#undef PG8_STAGE
#undef PG8_LDA
#undef PG8_LDB
#undef PG8_MMA
#undef PG8_WAIT_V
#undef PG8_WAIT_L
#undef PG8_BAR
#undef PG8_SCHED
}
}

__device__ __forceinline__ void transpose_item(const float* W, int ldw, int K, int ncols, bf16_t* WT, int row_off, LAS float* scr, int item, int lane) {
    const int nblk = ncols / 64, kb = item / nblk, nb = item % nblk, k0 = 64 * kb, n0 = 64 * nb;
    f32x4 v[16];
#pragma unroll
    for (int i = 0; i < 16; ++i) v[i] = *(const f32x4*)(W + (size_t)(k0 + 4 * i + (lane >> 4)) * ldw + n0 + (lane & 15) * 4);
#pragma unroll
    for (int i = 0; i < 16; ++i) { LAS float* d = scr + (4 * i + (lane >> 4)) * 65 + (lane & 15) * 4; d[0] = v[i].x; d[1] = v[i].y; d[2] = v[i].z; d[3] = v[i].w; }
    LDS_WAIT();
    const int c = lane & 7;
#pragma unroll
    for (int j = 0; j < 8; ++j) { const int n = (lane >> 3) + 8 * j; const LAS float* s = scr + (8 * c) * 65 + n;
        u32x4 o; o.x = pk2(s[0 * 65], s[1 * 65]); o.y = pk2(s[2 * 65], s[3 * 65]); o.z = pk2(s[4 * 65], s[5 * 65]); o.w = pk2(s[6 * 65], s[7 * 65]);
        *(u32x4*)(WT + (size_t)(row_off + n0 + n) * K + k0 + 8 * c) = o; }
    LDS_WAIT();
}
__device__ __forceinline__ void norm_phase(const Args& a) {
    const int tid = otid(); const int lane = tid & 63, gw = blockIdx.x * 8 + (tid >> 6), NGW = gridDim.x * 8;
    bf16_t* H = (bf16_t*)(a.ws + WS_H); float* rss = (float*)(a.ws + WS_RSS);
    constexpr int NROWS = NTOK + 2 * NMEM;
    for (int m0 = gw; m0 < NROWS; m0 += 4 * NGW) {
        f32x4 v[4][4]; const float* gp[4]; bf16_t* op[4]; int mm[4];
#pragma unroll
        for (int r = 0; r < 4; ++r) { int m = m0 + r * NGW; if (m >= NROWS) m = m0; mm[r] = m;
            const float* xrow; if (m < NTOK) { xrow = a.x + (size_t)m * DM; gp[r] = a.norm_g; op[r] = H + (size_t)m * DM; }
            else { const int q = (m - NTOK) & (NMEM - 1), l = (m - NTOK) >> 11; xrow = a.mem + (size_t)q * DM; gp[r] = a.mng + l * DM; op[r] = (bf16_t*)(a.ws + (l ? WS_MEMH1 : WS_MEMH)) + (size_t)q * DM; }
#pragma unroll
            for (int j = 0; j < 4; ++j) v[r][j] = ((const f32x4*)xrow + lane)[64 * j]; }
#pragma unroll
        for (int r = 0; r < 4; ++r) {
            float sacc = 0.f;
#pragma unroll
            for (int j = 0; j < 4; ++j) sacc += (v[r][j].x * v[r][j].x + v[r][j].y * v[r][j].y) + (v[r][j].z * v[r][j].z + v[r][j].w * v[r][j].w);
            const float tot = wave_sum(sacc); const bool tokrow = mm[r] < NTOK;
            const float rr = tokrow ? 1.f : 1.f / sqrtf(tot * (1.f / DM) + EPS);
            unsigned long long* o8 = (unsigned long long*)op[r] + lane;
#pragma unroll
            for (int j = 0; j < 4; ++j) { const f32x4 gg = ((const f32x4*)gp[r] + lane)[64 * j];
                o8[64 * j] = (unsigned long long)pk2(v[r][j].x * rr * gg.x, v[r][j].y * rr * gg.y) | ((unsigned long long)pk2(v[r][j].z * rr * gg.z, v[r][j].w * rr * gg.w) << 32); }
            if (tokrow && lane < 4) rss[lane * NTOK + mm[r]] = (lane == 0) ? tot : 0.f;
        }
    }
}
__device__ __forceinline__ void p0_phase(const Args& a, LAS unsigned char* lds) {
    const int tid = otid(), lane = tid & 63, wave = tid >> 6;
    LAS float* scr = (LAS float*)(lds + wave * 17408);
    const int gw = blockIdx.x * 8 + wave, NGW = gridDim.x * 8;
    bf16_t* WinT = (bf16_t*)(a.ws + WS_WIN); bf16_t* WoutT = (bf16_t*)(a.ws + WS_WOUT); bf16_t* WmemT = (bf16_t*)(a.ws + WS_WMEM);
    for (int it = gw; it < 3840; it += NGW) {
        const int l = it / 1920; int r = it % 1920;
        if (r < 1280) { const int seg = r >> 7, sub = r & 127; const int oseg = (int)((0x2154987630ULL >> (4 * seg)) & 15ULL);
            transpose_item(a.w_in + (size_t)l * DM * NIN + oseg * 512, NIN, DM, 512, WinT + (size_t)l * NIN * DM, seg * 512, scr, sub, lane); }
        else if (r < 1664) { r -= 1280; transpose_item(a.w_out + (size_t)l * DMIX * DM, DM, DMIX, DM, WoutT + (size_t)l * DM * DMIX, 0, scr, r, lane); }
        else { r -= 1664; transpose_item(a.wmem + (size_t)l * DM * DM, DM, DM, DM, WmemT + (size_t)l * DM * DM, 0, scr, r, lane); }
    }
    float* rope = (float*)(a.ws + WS_ROPE);
    for (int e = blockIdx.x * 512 + tid; e < NTOK * 8; e += gridDim.x * 512) {
        const int tok = e >> 3, i = e & 7;
        const float inv = powf(500000.0f, -(float)i * 0.125f);
        const float ang = (float)a.pos[tok] * inv;
        const double ad = (double)ang; const double n = rint(ad * 0.15915494309189535); const float rr = (float)(ad - n * 6.283185307179586);
        rope[tok * 16 + i] = __cosf(rr); rope[tok * 16 + 8 + i] = __sinf(rr);
    }
    if (blockIdx.x == 0) { float* LB = (float*)(a.ws + WS_LB); LB[tid] = 0.f; const float l0 = a.lbl[tid], l1 = a.lbl[512 + tid]; LB[512 + tid] = 1.f / (1.f + expf(l0 - l1)); }
    norm_phase(a);
}

#define BAR_LDS() do { asm volatile("s_waitcnt lgkmcnt(0)" ::: "memory"); __builtin_amdgcn_s_barrier(); asm volatile("" ::: "memory"); } while (0)
struct PrepIn { u32x4 q[4], k[4]; float cs[8], sn[8]; };
__device__ __forceinline__ void moba_prep_load(const Args& a, int tid, int u, PrepIn& r) {
    const int b = u >> 6, j = (u >> 3) & 7, h = u & 7, tok = tid >> 1, half = tid & 1;
    const size_t row = (size_t)b * SEQ + j * 256 + tok;
    const bf16_t* p = (const bf16_t*)(a.ws + WS_PROJ) + row * NCOL + h * 64 + half * 32;
    const bf16_t* pk = (const bf16_t*)(a.ws + WS_KC) + ((size_t)(b * 8 + h) * SEQ + j * 256 + tok) * 64 + half * 32;
#pragma unroll
    for (int c = 0; c < 4; ++c) { r.q[c] = *(const u32x4*)(p + CQA + c * 8); r.k[c] = *(const u32x4*)(pk + c * 8); }
    const f32x4* rope = (const f32x4*)((const float*)(a.ws + WS_ROPE) + row * 16);
    const f32x4 c0 = rope[0], c1 = rope[1], s0 = rope[2], s1 = rope[3];
    r.cs[0] = c0.x; r.cs[1] = c0.y; r.cs[2] = c0.z; r.cs[3] = c0.w; r.cs[4] = c1.x; r.cs[5] = c1.y; r.cs[6] = c1.z; r.cs[7] = c1.w;
    r.sn[0] = s0.x; r.sn[1] = s0.y; r.sn[2] = s0.z; r.sn[3] = s0.w; r.sn[4] = s1.x; r.sn[5] = s1.y; r.sn[6] = s1.z; r.sn[7] = s1.w;
}
__device__ __forceinline__ void moba_prep_unit(const Args& a, int l, LAS unsigned char* lds, int tid, int u, const PrepIn& in, PrepIn& nxt, int unext) {
    const int b = u >> 6, j = (u >> 3) & 7, h = u & 7, tok = tid >> 1, half = tid & 1;
    bf16_t* proj = (bf16_t*)(a.ws + WS_PROJ);
    const size_t row = (size_t)b * SEQ + j * 256 + tok;
    LAS float* kt = (LAS float*)lds;
    LAS float* part = (LAS float*)(lds + 66560);
    float vq[32], vk[32];
#pragma unroll
    for (int c = 0; c < 4; ++c) { const u32x4 uq = in.q[c], uk = in.k[c];
        vq[c * 8 + 0] = bflo(uq.x); vq[c * 8 + 1] = bfhi(uq.x); vq[c * 8 + 2] = bflo(uq.y); vq[c * 8 + 3] = bfhi(uq.y); vq[c * 8 + 4] = bflo(uq.z); vq[c * 8 + 5] = bfhi(uq.z); vq[c * 8 + 6] = bflo(uq.w); vq[c * 8 + 7] = bfhi(uq.w);
        vk[c * 8 + 0] = bflo(uk.x); vk[c * 8 + 1] = bfhi(uk.x); vk[c * 8 + 2] = bflo(uk.y); vk[c * 8 + 3] = bfhi(uk.y); vk[c * 8 + 4] = bflo(uk.z); vk[c * 8 + 5] = bfhi(uk.z); vk[c * 8 + 6] = bflo(uk.w); vk[c * 8 + 7] = bfhi(uk.w); }
    float cs[8], sn[8];
#pragma unroll
    for (int i = 0; i < 8; ++i) { cs[i] = in.cs[i]; sn[i] = in.sn[i]; }
    asm volatile("" ::: "memory");
    moba_prep_load(a, tid, unext, nxt);
#pragma unroll
    for (int which = 0; which < 2; ++which) {
        bf16_t* p = which ? (bf16_t*)(a.ws + WS_KC) + ((size_t)(b * 8 + h) * SEQ + j * 256 + tok) * 64 + half * 32 : proj + row * NCOL + CQA + h * 64 + half * 32;
        const float* g = (which ? a.mkn : a.mqn) + l * 64 + half * 32;
        float v[32]; float ss = 0.f;
#pragma unroll
        for (int i = 0; i < 32; ++i) { v[i] = which ? vk[i] : vq[i]; ss += v[i] * v[i]; }
        ss += __shfl_xor(ss, 1);
        const float r = frsq(ss * (1.f / 64.f) + EPS) * (which ? 1.f : 0.125f * LOG2E);
#pragma unroll
        for (int c = 0; c < 8; ++c) { const f32x4 gg = *(const f32x4*)(g + c * 4); v[c * 4] *= r * gg.x; v[c * 4 + 1] *= r * gg.y; v[c * 4 + 2] *= r * gg.z; v[c * 4 + 3] *= r * gg.w; }
        if (half == 0) {
#pragma unroll
            for (int i = 0; i < 8; ++i) { const float x1 = v[i], x2 = v[8 + i]; v[i] = x1 * cs[i] - x2 * sn[i]; v[8 + i] = x2 * cs[i] + x1 * sn[i]; }
        }
#pragma unroll
        for (int c = 0; c < 4; ++c) { u32x4 uu; uu.x = pk2(v[c * 8 + 0], v[c * 8 + 1]); uu.y = pk2(v[c * 8 + 2], v[c * 8 + 3]); uu.z = pk2(v[c * 8 + 4], v[c * 8 + 5]); uu.w = pk2(v[c * 8 + 6], v[c * 8 + 7]);
            *(u32x4*)(p + c * 8) = uu; }
        if (which == 1) {
#pragma unroll
            for (int i = 0; i < 32; ++i) kt[tok * 65 + half * 32 + i] = v[i];
        }
    }
    BAR_LDS();
    {
        const int d = tid & 63, pt = tid >> 6; float sacc = 0.f;
#pragma unroll 8
        for (int t = 0; t < 32; ++t) sacc += kt[(pt * 32 + t) * 65 + d];
        part[pt * 64 + d] = sacc;
    }
    BAR_LDS();
    if (tid < 64) { float sacc = 0.f;
#pragma unroll
        for (int p = 0; p < 8; ++p) sacc += part[p * 64 + tid];
        ((float*)(a.ws + WS_KMEAN))[((size_t)(b * 8 + h) * 8 + j) * 64 + tid] = sacc * (1.f / 256.f); }
    BAR_LDS();
}

struct HIn { u32x4 f[2], q[2], v[2]; };
template <bool NEEDQ>
__device__ __forceinline__ void hgrn_load(const Args& a, int tid, int u, HIn& r) {
    const int bh = u >> 5, c = u & 31, b = bh >> 2, hh = bh & 3; const size_t row0 = (size_t)b * SEQ + c * 64;
#pragma unroll
    for (int ii = 0; ii < 2; ++ii) { const int cid = tid + 512 * ii, t = cid >> 4, d0 = (cid & 15) * 8;
        const bf16_t* p = (const bf16_t*)(a.ws + WS_PROJ) + (row0 + t) * NCOL + hh * 128 + d0;
        r.f[ii] = *(const u32x4*)(p + CFH); r.v[ii] = *(const u32x4*)(p + CIH); if (NEEDQ) r.q[ii] = *(const u32x4*)(p + CQH); }
}
__device__ __forceinline__ void hgrn_stepA(const Args& a, int l, LAS unsigned char* lds, int tid, int hh, const HIn& in, float (&kf)[16]) {
    LAS float* LF = (LAS float*)lds;
    LAS float* PT = (LAS float*)(lds + 32768);
#pragma unroll
    for (int ii = 0; ii < 2; ++ii) {
        const int cid = tid + 512 * ii, t = cid >> 4, d0 = (cid & 15) * 8;
        const u32x4 u = in.f[ii];
        float fl[8] = {bflo(u.x), bfhi(u.x), bflo(u.y), bfhi(u.y), bflo(u.z), bfhi(u.z), bflo(u.w), bfhi(u.w)};
        float lf[8];
        const float* LB = (const float*)(a.ws + WS_LB) + l * 512 + hh * 128 + d0; const f32x4 lb0 = *(const f32x4*)LB, lb1 = *(const f32x4*)(LB + 4);
        const float lbv[8] = {lb0.x, lb0.y, lb0.z, lb0.w, lb1.x, lb1.y, lb1.z, lb1.w};
#pragma unroll
        for (int i = 0; i < 8; ++i) { const float lb = lbv[i]; const float sg = sigm(fl[i]);
            const float f = lb + (1.f - lb) * sg; lf[i] = __logf(f); kf[ii * 8 + i] = (1.f - lb) * (1.f - sg); }
        *(LAS f32x4*)(LF + t * 128 + d0) = (f32x4){lf[0], lf[1], lf[2], lf[3]}; *(LAS f32x4*)(LF + t * 128 + d0 + 4) = (f32x4){lf[4], lf[5], lf[6], lf[7]};
    }
}
__device__ __forceinline__ void hgrn_cumsum_scan(LAS unsigned char* lds, int tid) {
    LAS float* LF = (LAS float*)lds;
    LAS float* PT = (LAS float*)(lds + 32768);
    BAR_LDS();
    { const int d = tid & 127, pt = tid >> 7; float run = 0.f;
#pragma unroll
      for (int t = 0; t < 16; ++t) { run += LF[(pt * 16 + t) * 128 + d]; LF[(pt * 16 + t) * 128 + d] = run; }
      PT[pt * 128 + d] = run; }
    BAR_LDS();
    { const int d = tid & 127, pt = tid >> 7; float off = 0.f;
#pragma unroll
      for (int p = 0; p < 3; ++p) off += (p < pt) ? PT[p * 128 + d] : 0.f;
      if (pt > 0) {
#pragma unroll
        for (int t = 0; t < 16; ++t) LF[(pt * 16 + t) * 128 + d] += off; } }
    BAR_LDS();
}
__device__ __forceinline__ void hgrn_stage1_unit(const Args& a, int l, LAS unsigned char* lds, int tid, int u, const HIn& in, HIn& nxt, int unext) {
    const int lane = tid & 63, w = __builtin_amdgcn_readfirstlane(tid >> 6), fr = lane & 15, fq = lane >> 4;
    const int bh = u >> 5, c = u & 31, hh = bh & 3;
    LAS float* LF = (LAS float*)lds;
    LAS unsigned char* KN = lds + 34816;
    LAS unsigned char* VN = lds + 34816 + 18432;
    float kf[16];
    hgrn_stepA(a, l, lds, tid, hh, in, kf);
    hgrn_load<false>(a, tid, unext, nxt);
    hgrn_cumsum_scan(lds, tid);
    if (tid < 128) ((float*)(a.ws + WS_DECAY))[((size_t)bh * 32 + c) * 128 + tid] = fexp(LF[63 * 128 + tid]);
#pragma unroll
    for (int ii = 0; ii < 2; ++ii) {
        const int cid = tid + 512 * ii, t = cid >> 4, d0 = (cid & 15) * 8;
        const f32x4 ae0 = *(const LAS f32x4*)(LF + 63 * 128 + d0), ae1 = *(const LAS f32x4*)(LF + 63 * 128 + d0 + 4), at0 = *(const LAS f32x4*)(LF + t * 128 + d0), at1 = *(const LAS f32x4*)(LF + t * 128 + d0 + 4);
        const f32x4 e0 = ae0 - at0, e1 = ae1 - at1;
        u32x4 o; o.x = pk2(kf[ii * 8 + 0] * fexp(e0.x), kf[ii * 8 + 1] * fexp(e0.y)); o.y = pk2(kf[ii * 8 + 2] * fexp(e0.z), kf[ii * 8 + 3] * fexp(e0.w));
        o.z = pk2(kf[ii * 8 + 4] * fexp(e1.x), kf[ii * 8 + 5] * fexp(e1.y)); o.w = pk2(kf[ii * 8 + 6] * fexp(e1.z), kf[ii * 8 + 7] * fexp(e1.w));
        *(LAS u32x4*)(KN + t * 288 + d0 * 2) = o;
        *(LAS u32x4*)(VN + t * 288 + d0 * 2) = in.v[ii];
    }
    BAR_LDS();
    f32x4 acc[8];
#pragma unroll
    for (int n = 0; n < 8; ++n) acc[n] = (f32x4){0.f, 0.f, 0.f, 0.f};
#pragma unroll
    for (int ks = 0; ks < 2; ++ks) {
        const s16x4 alo = tr4(VN, 288, ks * 32 + fq * 4, w * 16, fr), ahi = tr4(VN, 288, ks * 32 + 16 + fq * 4, w * 16, fr);
        const bf16x8 af = __builtin_shufflevector(alo, ahi, 0, 1, 2, 3, 4, 5, 6, 7);
#pragma unroll
        for (int n = 0; n < 8; ++n) { const s16x4 blo = tr4(KN, 288, ks * 32 + fq * 4, n * 16, fr), bhi = tr4(KN, 288, ks * 32 + 16 + fq * 4, n * 16, fr);
            const bf16x8 bfr = __builtin_shufflevector(blo, bhi, 0, 1, 2, 3, 4, 5, 6, 7); acc[n] = MFMA16(bfr, af, acc[n]); }
    }
    bf16_t* ST = (bf16_t*)(a.ws + WS_H) + ((size_t)bh * 32 + c) * 16384;
#pragma unroll
    for (int n = 0; n < 8; ++n) { u32x2 o; o.x = pk2(acc[n][0], acc[n][1]); o.y = pk2(acc[n][2], acc[n][3]); *(u32x2*)(ST + (w * 16 + fr) * 128 + n * 16 + fq * 4) = o; }
    BAR_LDS();
}
__device__ __forceinline__ void hgrn_scan_phase(const Args& a) {
    const int id = blockIdx.x * 512 + otid(), NT = gridDim.x * 512;
    for (int it = id; it < 32 * 128 * 32; it += NT) {
        const int bh = it >> 12, dv = (it >> 5) & 127, dkc = it & 31;
        u32x2* st = (u32x2*)((bf16_t*)(a.ws + WS_H) + (size_t)bh * 32 * 16384 + dv * 128 + dkc * 4);
        const f32x4* dc = (const f32x4*)((const float*)(a.ws + WS_DECAY) + (size_t)bh * 32 * 128 + dkc * 4);
        float r0 = 0.f, r1 = 0.f, r2 = 0.f, r3 = 0.f;
#pragma unroll 8
        for (int c = 0; c < 32; ++c) {
            const u32x2 u = st[(size_t)c * 4096]; const f32x4 dd = dc[c * 32];
            u32x2 o; o.x = pk2(r0, r1); o.y = pk2(r2, r3); st[(size_t)c * 4096] = o;
            r0 = dd.x * r0 + bflo(u.x); r1 = dd.y * r1 + bfhi(u.x); r2 = dd.z * r2 + bflo(u.y); r3 = dd.w * r3 + bfhi(u.y);
        }
    }
}
__device__ __forceinline__ void hgrn_stage3_unit(const Args& a, int l, LAS unsigned char* lds, int tid, int u, const HIn& in, HIn& nxt, int unext) {
    const int lane = tid & 63, w = __builtin_amdgcn_readfirstlane(tid >> 6), fr = lane & 15, fq = lane >> 4;
    const int bh = u >> 5, c = u & 31, b = bh >> 2, hh = bh & 3; const size_t row0 = (size_t)b * SEQ + c * 64;
    const int tt = w & 3, vh = w >> 2;
    bf16_t* proj = (bf16_t*)(a.ws + WS_PROJ);
    LAS float* LF = (LAS float*)lds;
    LAS unsigned char* QM = lds + 34816;
    LAS unsigned char* Q0 = QM + 17408;
    LAS unsigned char* KM = Q0 + 17408;
    LAS unsigned char* VN = KM + 17408;
    LAS float* SSQ = (LAS float*)(VN + 18432);
    float kf[16];
    hgrn_stepA(a, l, lds, tid, hh, in, kf);
    const size_t row = row0 + tt * 16 + fr;
    const bf16_t* ST = (const bf16_t*)(a.ws + WS_H) + ((size_t)bh * 32 + c) * 16384;
    bf16x8 stf[4][4]; u32x2 zz[4];
#pragma unroll
    for (int ks = 0; ks < 4; ++ks)
#pragma unroll
        for (int v = 0; v < 4; ++v) stf[ks][v] = *(const bf16x8*)(ST + ((vh * 4 + v) * 16 + fr) * 128 + ks * 32 + fq * 8);
#pragma unroll
    for (int v = 0; v < 4; ++v) zz[v] = *(const u32x2*)(proj + row * NCOL + CZ + 512 + hh * 128 + (vh * 4 + v) * 16 + fq * 4);
    hgrn_load<true>(a, tid, unext, nxt);
    hgrn_cumsum_scan(lds, tid);
#pragma unroll
    for (int ii = 0; ii < 2; ++ii) {
        const int cid = tid + 512 * ii, t = cid >> 4, d0 = (cid & 15) * 8;
        const u32x4 uq = in.q[ii];
        float q[8] = {bflo(uq.x), bfhi(uq.x), bflo(uq.y), bfhi(uq.y), bflo(uq.z), bfhi(uq.z), bflo(uq.w), bfhi(uq.w)};
        float qm[8], q0[8], km[8];
        const f32x4 at0 = *(const LAS f32x4*)(LF + t * 128 + d0), at1 = *(const LAS f32x4*)(LF + t * 128 + d0 + 4), am0 = *(const LAS f32x4*)(LF + 31 * 128 + d0), am1 = *(const LAS f32x4*)(LF + 31 * 128 + d0 + 4);
        const float Atv[8] = {at0.x, at0.y, at0.z, at0.w, at1.x, at1.y, at1.z, at1.w}, Amv[8] = {am0.x, am0.y, am0.z, am0.w, am1.x, am1.y, am1.z, am1.w};
#pragma unroll
        for (int i = 0; i < 8; ++i) { const float At = Atv[i], Am = Amv[i]; const float sq = silu(q[i]);
            qm[i] = sq * fexp(At - Am); q0[i] = sq * fexp(At); km[i] = kf[ii * 8 + i] * fexp(Am - At); }
        u32x4 o;
        o.x = pk2(qm[0], qm[1]); o.y = pk2(qm[2], qm[3]); o.z = pk2(qm[4], qm[5]); o.w = pk2(qm[6], qm[7]); *(LAS u32x4*)(QM + t * 272 + d0 * 2) = o;
        o.x = pk2(q0[0], q0[1]); o.y = pk2(q0[2], q0[3]); o.z = pk2(q0[4], q0[5]); o.w = pk2(q0[6], q0[7]); *(LAS u32x4*)(Q0 + t * 272 + d0 * 2) = o;
        o.x = pk2(km[0], km[1]); o.y = pk2(km[2], km[3]); o.z = pk2(km[4], km[5]); o.w = pk2(km[6], km[7]); *(LAS u32x4*)(KM + t * 272 + d0 * 2) = o;
        *(LAS u32x4*)(VN + t * 288 + d0 * 2) = in.v[ii];
    }
    BAR_LDS();
    f32x4 sc[4];
#pragma unroll
    for (int s = 0; s < 4; ++s) sc[s] = (f32x4){0.f, 0.f, 0.f, 0.f};
#pragma unroll
    for (int ks = 0; ks < 4; ++ks) {
        const bf16x8 qf = *(const LAS bf16x8*)(QM + (tt * 16 + fr) * 272 + (ks * 32 + fq * 8) * 2);
#pragma unroll
        for (int s = 0; s < 4; ++s) if (s <= tt) { const bf16x8 kfr = *(const LAS bf16x8*)(KM + (s * 16 + fr) * 272 + (ks * 32 + fq * 8) * 2); sc[s] = MFMA16(kfr, qf, sc[s]); }
    }
#pragma unroll
    for (int s = 0; s < 4; ++s)
#pragma unroll
        for (int jj = 0; jj < 4; ++jj) { const bool ok = (s < tt) || (s == tt && (fq * 4 + jj) <= fr); sc[s][jj] = ok ? sc[s][jj] : 0.f; }
    f32x4 o[4];
#pragma unroll
    for (int v = 0; v < 4; ++v) o[v] = (f32x4){0.f, 0.f, 0.f, 0.f};
#pragma unroll
    for (int kst = 0; kst < 2; ++kst) {
        if (kst * 2 <= tt) {
            u32x4 pw; pw.x = pk2(sc[2 * kst][0], sc[2 * kst][1]); pw.y = pk2(sc[2 * kst][2], sc[2 * kst][3]); pw.z = pk2(sc[2 * kst + 1][0], sc[2 * kst + 1][1]); pw.w = pk2(sc[2 * kst + 1][2], sc[2 * kst + 1][3]);
            const bf16x8 pb = __builtin_bit_cast(bf16x8, pw);
#pragma unroll
            for (int v = 0; v < 4; ++v) { const s16x4 lo = tr4(VN, 288, kst * 32 + fq * 4, (vh * 4 + v) * 16, fr), hi = tr4(VN, 288, kst * 32 + 16 + fq * 4, (vh * 4 + v) * 16, fr);
                const bf16x8 vf = __builtin_shufflevector(lo, hi, 0, 1, 2, 3, 4, 5, 6, 7);
                o[v] = MFMA16(vf, pb, o[v]); }
        }
    }
#pragma unroll
    for (int ks = 0; ks < 4; ++ks) {
        const bf16x8 q0f = *(const LAS bf16x8*)(Q0 + (tt * 16 + fr) * 272 + (ks * 32 + fq * 8) * 2);
#pragma unroll
        for (int v = 0; v < 4; ++v) o[v] = MFMA16(stf[ks][v], q0f, o[v]);
    }
    float ss = 0.f;
#pragma unroll
    for (int v = 0; v < 4; ++v)
#pragma unroll
        for (int jj = 0; jj < 4; ++jj) ss += o[v][jj] * o[v][jj];
    ss += __shfl_xor(ss, 16); ss += __shfl_xor(ss, 32);
    if (fq == 0) SSQ[vh * 64 + tt * 16 + fr] = ss;
    BAR_LDS();
    const float tot = SSQ[tt * 16 + fr] + SSQ[64 + tt * 16 + fr];
    const float r = frsq(tot * (1.f / 128.f) + EPS);
#pragma unroll
    for (int v = 0; v < 4; ++v) { const int v0 = (vh * 4 + v) * 16 + fq * 4;
        const f32x4 g = *(const f32x4*)(a.hon + l * 128 + v0);
        const u32x2 z = zz[v];
        u32x2 y; y.x = pk2(o[v][0] * r * g.x * silu(bflo(z.x)), o[v][1] * r * g.y * silu(bfhi(z.x))); y.y = pk2(o[v][2] * r * g.z * silu(bflo(z.y)), o[v][3] * r * g.w * silu(bfhi(z.y)));
        *(u32x2*)(proj + row * NCOL + CQH + hh * 128 + v0) = y; }
    BAR_LDS();
}

template <int D, int QT0>
__device__ __forceinline__ void qk_tile(const LAS unsigned char* Ks, int KP, const bf16x8 (&qf)[2][D / 32], f32x4 (&s)[4][2], int fr, int fq, float b0, float b1) {
#pragma unroll
    for (int a = 0; a < 4; ++a) { s[a][0] = (f32x4){b0, b0, b0, b0}; s[a][1] = (f32x4){b1, b1, b1, b1}; }
#pragma unroll
    for (int a = 0; a < 4; ++a)
#pragma unroll
        for (int ks = 0; ks < D / 32; ++ks) { const bf16x8 kfr = *(const LAS bf16x8*)(Ks + (a * 16 + fr) * KP + (ks * 32 + fq * 8) * 2);
            if (QT0 == 0) s[a][0] = MFMA16(kfr, qf[0][ks], s[a][0]);
            s[a][1] = MFMA16(kfr, qf[1][ks], s[a][1]); }
}
#define ONES8 ((bf16x8){16256, 16256, 16256, 16256, 16256, 16256, 16256, 16256})
template <int D, bool DIAG, int QT0>
__device__ __forceinline__ void sm_pv_tile(f32x4 (&s)[4][2], const LAS unsigned char* Vs, int VP, f32x4 (&o)[D / 16][2], f32x4 (&ol)[2], int fr, int fq, int keyl0, int qla, int qlb) {
#pragma unroll
    for (int qt = QT0; qt < 2; ++qt) {
        if (DIAG) {
            const int ql = (qt == 0 ? qla : qlb) + fr - keyl0 - fq * 4;
#pragma unroll
            for (int a = 0; a < 4; ++a)
#pragma unroll
                for (int jj = 0; jj < 4; ++jj) s[a][qt][jj] = (a * 16 + jj > ql) ? -1e30f : s[a][qt][jj];
        }
#pragma unroll
        for (int a = 0; a < 4; ++a)
#pragma unroll
            for (int jj = 0; jj < 4; ++jj) s[a][qt][jj] = ex2(s[a][qt][jj]);
    }
#pragma unroll
    for (int kst = 0; kst < 2; ++kst) {
        bf16x8 pb[2];
#pragma unroll
        for (int qt = QT0; qt < 2; ++qt) { u32x4 pw; pw.x = pk2(s[2 * kst][qt][0], s[2 * kst][qt][1]); pw.y = pk2(s[2 * kst][qt][2], s[2 * kst][qt][3]);
            pw.z = pk2(s[2 * kst + 1][qt][0], s[2 * kst + 1][qt][1]); pw.w = pk2(s[2 * kst + 1][qt][2], s[2 * kst + 1][qt][3]); pb[qt] = __builtin_bit_cast(bf16x8, pw); }
        if (QT0 == 0) ol[0] = MFMA16(ONES8, pb[0], ol[0]);
        ol[1] = MFMA16(ONES8, pb[1], ol[1]);
#pragma unroll
        for (int dt = 0; dt < D / 16; ++dt) { const s16x4 lo = tr4(Vs, VP, kst * 32 + fq * 4, dt * 16, fr), hi = tr4(Vs, VP, kst * 32 + 16 + fq * 4, dt * 16, fr);
            const bf16x8 vf = __builtin_shufflevector(lo, hi, 0, 1, 2, 3, 4, 5, 6, 7);
            if (QT0 == 0) o[dt][0] = MFMA16(vf, pb[0], o[dt][0]);
            o[dt][1] = MFMA16(vf, pb[1], o[dt][1]); }
    }
}
__device__ __forceinline__ void sm_pv_tile128(f32x4 (&sa)[4][2], f32x4 (&sb)[4][2], const LAS unsigned char* Vs, int VP, f32x4 (&o)[4][2], f32x4 (&ol)[2], int fr, int fq) {
#pragma unroll
    for (int qt = 0; qt < 2; ++qt)
#pragma unroll
        for (int a = 0; a < 4; ++a)
#pragma unroll
            for (int jj = 0; jj < 4; ++jj) { sa[a][qt][jj] = ex2(sa[a][qt][jj]); sb[a][qt][jj] = ex2(sb[a][qt][jj]); }
#pragma unroll
    for (int half = 0; half < 2; ++half)
#pragma unroll
        for (int kst = 0; kst < 2; ++kst) {
            bf16x8 pb[2];
#pragma unroll
            for (int qt = 0; qt < 2; ++qt) { const f32x4 x0 = half ? sb[2 * kst][qt] : sa[2 * kst][qt], x1 = half ? sb[2 * kst + 1][qt] : sa[2 * kst + 1][qt];
                u32x4 pw; pw.x = pk2(x0[0], x0[1]); pw.y = pk2(x0[2], x0[3]); pw.z = pk2(x1[0], x1[1]); pw.w = pk2(x1[2], x1[3]); pb[qt] = __builtin_bit_cast(bf16x8, pw); }
            ol[0] = MFMA16(ONES8, pb[0], ol[0]); ol[1] = MFMA16(ONES8, pb[1], ol[1]);
#pragma unroll
            for (int dt = 0; dt < 4; ++dt) { const s16x4 lo = tr4(Vs, VP, half * 64 + kst * 32 + fq * 4, dt * 16, fr), hi = tr4(Vs, VP, half * 64 + kst * 32 + 16 + fq * 4, dt * 16, fr);
                const bf16x8 vf = __builtin_shufflevector(lo, hi, 0, 1, 2, 3, 4, 5, 6, 7);
                o[dt][0] = MFMA16(vf, pb[0], o[dt][0]); o[dt][1] = MFMA16(vf, pb[1], o[dt][1]); }
            __builtin_amdgcn_sched_barrier(0);
        }
}
template <int D, bool DIAG, int QT0>
__device__ __forceinline__ void attn_tile(const LAS unsigned char* Ks, int KP, const LAS unsigned char* Vs, int VP, const bf16x8 (&qf)[2][D / 32], f32x4 (&o)[D / 16][2], f32x4 (&ol)[2],
                                          int fr, int fq, int keyl0, int qla, int qlb, float b0, float b1) {
    f32x4 s[4][2];
    qk_tile<D, QT0>(Ks, KP, qf, s, fr, fq, b0, b1);
    sm_pv_tile<D, DIAG, QT0>(s, Vs, VP, o, ol, fr, fq, keyl0, qla, qlb);
}

__device__ __forceinline__ void moba_unit(const Args& a, int l, LAS unsigned char* lds, int b, int h, int qb) {
    const int tid = otid(), lane = tid & 63, w = __builtin_amdgcn_readfirstlane(tid >> 6), fr = lane & 15, fq = lane >> 4;
    bf16_t* proj = (bf16_t*)(a.ws + WS_PROJ);
    LAS float* kml = (LAS float*)(lds + 77824);
    kml[tid] = ((const float*)(a.ws + WS_KMEAN))[(size_t)(b * 8 + h) * 512 + tid];
    const size_t rowbase = (size_t)b * SEQ;
    const bf16_t* Kc = (const bf16_t*)(a.ws + WS_KC) + (size_t)(b * 8 + h) * SEQ * 64; const bf16_t* Vc = (const bf16_t*)(a.ws + WS_VC) + (size_t)(b * 8 + h) * SEQ * 64;
    const int qrow[2] = {qb * 256 + w * 16, qb * 256 + (15 - w) * 16};
    bf16x8 qf[2][2];
#pragma unroll
    for (int qt = 0; qt < 2; ++qt)
#pragma unroll
        for (int ks = 0; ks < 2; ++ks) qf[qt][ks] = *(const bf16x8*)(proj + (rowbase + qrow[qt] + fr) * NCOL + CQA + h * 64 + ks * 32 + fq * 8);
    const int NT2 = (qb + 1) * 2;
    u32x4 kreg[2], vreg[2];
#define MOBA_T128(i) ((i) < 2 ? qb * 2 + (i) : (i) - 2)
#define MOBA_LOAD(t128) do { _Pragma("unroll") for (int ii = 0; ii < 2; ++ii) { const int cid = tid + 512 * ii; \
        kreg[ii] = *(const u32x4*)(Kc + (size_t)((t128) * 128) * 64 + cid * 8); \
        vreg[ii] = *(const u32x4*)(Vc + (size_t)((t128) * 128) * 64 + cid * 8); } } while (0)
#define MOBA_STORE(buf) do { _Pragma("unroll") for (int ii = 0; ii < 2; ++ii) { const int cid = tid + 512 * ii; \
        *(LAS u32x4*)(lds + (buf) * 38912 + (cid >> 3) * 144 + (cid & 7) * 16) = kreg[ii]; \
        *(LAS u32x4*)(lds + (buf) * 38912 + 18432 + (cid >> 3) * 160 + (cid & 7) * 16) = vreg[ii]; } } while (0)
    MOBA_LOAD(MOBA_T128(0));
    __syncthreads();
    unsigned selmask[2];
    if (qb <= 3) { selmask[0] = selmask[1] = (1u << qb) - 1u; }
    else {
#pragma unroll
        for (int qt = 0; qt < 2; ++qt) {
            float g[8];
#pragma unroll
            for (int j = 0; j < 8; ++j) { float psum = 0.f;
                if (j < qb) {
#pragma unroll
                    for (int ks = 0; ks < 2; ++ks)
#pragma unroll
                        for (int i = 0; i < 8; ++i) psum += bf2f(qf[qt][ks][i]) * kml[j * 64 + ks * 32 + fq * 8 + i];
                    psum += __shfl_xor(psum, 16); psum += __shfl_xor(psum, 32);
                }
                g[j] = (j < qb) ? psum : -INFINITY; }
            unsigned msk = 0u;
#pragma unroll
            for (int j = 0; j < 8; ++j) { int rank = 0;
#pragma unroll
                for (int mth = 0; mth < 8; ++mth) if (mth != j) rank += (g[mth] > g[j] || (g[mth] == g[j] && mth < j)) ? 1 : 0;
                if (j < qb && rank < 3) msk |= (1u << j); }
            selmask[qt] = msk;
        }
    }
    f32x4 o[4][2];
#pragma unroll
    for (int dt = 0; dt < 4; ++dt) { o[dt][0] = (f32x4){0.f, 0.f, 0.f, 0.f}; o[dt][1] = (f32x4){0.f, 0.f, 0.f, 0.f}; }
    float gm; { float xq = fabsf(a.mqn[l * 64 + lane]), xk = fabsf(a.mkn[l * 64 + lane]);
#pragma unroll
      for (int ofs = 1; ofs < 64; ofs <<= 1) { xq = fmaxf(xq, __shfl_xor(xq, ofs)); xk = fmaxf(xk, __shfl_xor(xk, ofs)); }
      gm = xq * xk * (8.f * 1.03f * LOG2E); }
    f32x4 ol[2] = {(f32x4){0.f, 0.f, 0.f, 0.f}, (f32x4){0.f, 0.f, 0.f, 0.f}};
    MOBA_STORE(0);
    BAR_LDS();
    for (int i = 0; i < NT2; ++i) {
        if (i + 1 < NT2) { const int tn = MOBA_T128(i + 1); MOBA_LOAD(tn); }
        const int t128 = MOBA_T128(i), j = t128 >> 1, hb = t128 & 1; const bool diag = (j == qb);
        const LAS unsigned char* Kb = lds + (i & 1) * 38912;
        const unsigned rs0 = diag ? 1u : ((selmask[0] >> j) & 1u), rs1 = diag ? 1u : ((selmask[1] >> j) & 1u);
        if (!diag) {
            f32x4 sA[4][2], sB[4][2];
            const float b0 = rs0 ? -gm : -1e30f, b1 = rs1 ? -gm : -1e30f;
            qk_tile<64, 0>(Kb, 144, qf, sA, fr, fq, b0, b1);
            qk_tile<64, 0>(Kb + 64 * 144, 144, qf, sB, fr, fq, b0, b1);
            sm_pv_tile128(sA, sB, Kb + 18432, 160, o, ol, fr, fq);
        } else
#pragma unroll
        for (int sub = 0; sub < 2; ++sub) {
            const int ktl = hb * 2 + sub;
            if (diag) {
                if (ktl <= (w >> 2)) attn_tile<64, true, 0>(Kb + sub * 64 * 144, 144, Kb + 18432 + sub * 64 * 160, 160, qf, o, ol, fr, fq, ktl * 64, w * 16, (15 - w) * 16, -gm, -gm);
                else if (ktl <= ((15 - w) >> 2)) attn_tile<64, true, 1>(Kb + sub * 64 * 144, 144, Kb + 18432 + sub * 64 * 160, 160, qf, o, ol, fr, fq, ktl * 64, w * 16, (15 - w) * 16, -gm, -gm);
            } else attn_tile<64, false, 0>(Kb + sub * 64 * 144, 144, Kb + 18432 + sub * 64 * 160, 160, qf, o, ol, fr, fq, 0, 0, 0, rs0 ? -gm : -1e30f, rs1 ? -gm : -1e30f);
        }
        if (i + 1 < NT2) MOBA_STORE((i + 1) & 1);
        BAR_LDS();
    }
#undef MOBA_T128
#undef MOBA_LOAD
#undef MOBA_STORE
#pragma unroll
    for (int qt = 0; qt < 2; ++qt) {
        const float inv = frcp(ol[qt][0]);
        const size_t row = rowbase + qrow[qt] + fr;
#pragma unroll
        for (int dt = 0; dt < 4; ++dt) { const int d0 = dt * 16 + fq * 4;
            const u32x2 z = *(const u32x2*)(proj + row * NCOL + CZ + h * 64 + d0);
            u32x2 y; y.x = pk2(o[dt][qt][0] * inv * silu(bflo(z.x)), o[dt][qt][1] * inv * silu(bfhi(z.x))); y.y = pk2(o[dt][qt][2] * inv * silu(bflo(z.y)), o[dt][qt][3] * inv * silu(bfhi(z.y)));
            *(u32x2*)(proj + row * NCOL + CQA + h * 64 + d0) = y; }
    }
    __syncthreads();
}

__device__ __forceinline__ void mem_unit(const Args& a, int l, LAS unsigned char* lds, int b, int hm, int qb) {
    const int tid = otid(), lane = tid & 63, w = __builtin_amdgcn_readfirstlane(tid >> 6), fr = lane & 15, fq = lane >> 4;
    bf16_t* proj = (bf16_t*)(a.ws + WS_PROJ);
    const bf16_t* kvm = (const bf16_t*)(a.ws + WS_KVM) + (size_t)b * MEML * 1024;
    const size_t rowbase = (size_t)b * SEQ; const int q0 = qb * 256 + w * 32;
    u32x4 ukr[2], uvr[2];
#define MEM_LOAD(kt) do { _Pragma("unroll") for (int ii = 0; ii < 2; ++ii) { const int cid = tid + 512 * ii; \
        ukr[ii] = *(const u32x4*)(kvm + (size_t)((kt) * 64 + (cid >> 4)) * 1024 + hm * 128 + (cid & 15) * 8); \
        uvr[ii] = *(const u32x4*)(kvm + (size_t)((kt) * 64 + (cid >> 4)) * 1024 + 512 + hm * 128 + (cid & 15) * 8); } } while (0)
    MEM_LOAD(0);
    bf16x8 qf[2][4];
#pragma unroll
    for (int qt = 0; qt < 2; ++qt) {
        u32x4 u[4]; float ss = 0.f;
#pragma unroll
        for (int ks = 0; ks < 4; ++ks) { u[ks] = *(const u32x4*)(proj + (rowbase + q0 + qt * 16 + fr) * NCOL + CQM + hm * 128 + ks * 32 + fq * 8);
            ss += bflo(u[ks].x) * bflo(u[ks].x) + bfhi(u[ks].x) * bfhi(u[ks].x) + bflo(u[ks].y) * bflo(u[ks].y) + bfhi(u[ks].y) * bfhi(u[ks].y)
                + bflo(u[ks].z) * bflo(u[ks].z) + bfhi(u[ks].z) * bfhi(u[ks].z) + bflo(u[ks].w) * bflo(u[ks].w) + bfhi(u[ks].w) * bfhi(u[ks].w); }
        ss += __shfl_xor(ss, 16); ss += __shfl_xor(ss, 32);
        const float r = frsq(ss * (1.f / 128.f) + EPS) * (0.08838834764831845f * LOG2E);
#pragma unroll
        for (int ks = 0; ks < 4; ++ks) { const float* g = a.memqn + l * 128 + ks * 32 + fq * 8; const f32x4 g0 = *(const f32x4*)g, g1 = *(const f32x4*)(g + 4);
            u32x4 o; o.x = pk2(bflo(u[ks].x) * r * g0.x, bfhi(u[ks].x) * r * g0.y); o.y = pk2(bflo(u[ks].y) * r * g0.z, bfhi(u[ks].y) * r * g0.w);
            o.z = pk2(bflo(u[ks].z) * r * g1.x, bfhi(u[ks].z) * r * g1.y); o.w = pk2(bflo(u[ks].w) * r * g1.z, bfhi(u[ks].w) * r * g1.w);
            qf[qt][ks] = __builtin_bit_cast(bf16x8, o); }
    }
    f32x4 o[8][2];
#pragma unroll
    for (int dt = 0; dt < 8; ++dt) { o[dt][0] = (f32x4){0.f, 0.f, 0.f, 0.f}; o[dt][1] = (f32x4){0.f, 0.f, 0.f, 0.f}; }
    float gm; { float xq = fmaxf(fabsf(a.memqn[l * 128 + lane]), fabsf(a.memqn[l * 128 + 64 + lane])), xk = fmaxf(fabsf(a.memkn[l * 128 + lane]), fabsf(a.memkn[l * 128 + 64 + lane]));
#pragma unroll
      for (int ofs = 1; ofs < 64; ofs <<= 1) { xq = fmaxf(xq, __shfl_xor(xq, ofs)); xk = fmaxf(xk, __shfl_xor(xk, ofs)); }
      gm = xq * xk * (11.3137085f * 1.03f * LOG2E); }
    f32x4 ol[2] = {(f32x4){0.f, 0.f, 0.f, 0.f}, (f32x4){0.f, 0.f, 0.f, 0.f}};
    LAS unsigned char* Ks = lds;
    LAS unsigned char* Vs = lds + 17408;
#define MEM_STORE(buf) do { _Pragma("unroll") for (int ii = 0; ii < 2; ++ii) { \
            const int cid = tid + 512 * ii, key = cid >> 4, dc = cid & 15; \
            const u32x4 uk = ukr[ii]; \
            float kv[8] = {bflo(uk.x), bfhi(uk.x), bflo(uk.y), bfhi(uk.y), bflo(uk.z), bfhi(uk.z), bflo(uk.w), bfhi(uk.w)}; \
            float ss = 0.f; \
            _Pragma("unroll") for (int i = 0; i < 8; ++i) ss += kv[i] * kv[i]; \
            ss += __shfl_xor(ss, 1); ss += __shfl_xor(ss, 2); ss += __shfl_xor(ss, 4); ss += __shfl_xor(ss, 8); \
            const float r = frsq(ss * (1.f / 128.f) + EPS); \
            const float* g = a.memkn + l * 128 + dc * 8; const f32x4 g0 = *(const f32x4*)g, g1 = *(const f32x4*)(g + 4); \
            u32x4 ok; ok.x = pk2(kv[0] * r * g0.x, kv[1] * r * g0.y); ok.y = pk2(kv[2] * r * g0.z, kv[3] * r * g0.w); ok.z = pk2(kv[4] * r * g1.x, kv[5] * r * g1.y); ok.w = pk2(kv[6] * r * g1.z, kv[7] * r * g1.w); \
            *(LAS u32x4*)(Ks + (buf) * 35840 + key * 272 + dc * 16) = ok; \
            *(LAS u32x4*)(Vs + (buf) * 35840 + key * 288 + dc * 16) = uvr[ii]; } } while (0)
    MEM_STORE(0);
    BAR_LDS();
    for (int kt = 0; kt < 4; ++kt) {
        if (kt < 3) MEM_LOAD(kt + 1);
        attn_tile<128, false, 0>(Ks + (kt & 1) * 35840, 272, Vs + (kt & 1) * 35840, 288, qf, o, ol, fr, fq, 0, 0, 0, -gm, -gm);
        if (kt < 3) MEM_STORE((kt + 1) & 1);
        BAR_LDS();
    }
#undef MEM_STORE
#undef MEM_LOAD
#pragma unroll
    for (int qt = 0; qt < 2; ++qt) {
        const float inv = frcp(ol[qt][0]);
        const size_t row = rowbase + q0 + qt * 16 + fr;
#pragma unroll
        for (int dt = 0; dt < 8; ++dt) { const int d0 = dt * 16 + fq * 4;
            const u32x2 z = *(const u32x2*)(proj + row * NCOL + CZ + 1024 + hm * 128 + d0);
            u32x2 y; y.x = pk2(o[dt][qt][0] * inv * silu(bflo(z.x)), o[dt][qt][1] * inv * silu(bfhi(z.x))); y.y = pk2(o[dt][qt][2] * inv * silu(bflo(z.y)), o[dt][qt][3] * inv * silu(bfhi(z.y)));
            *(u32x2*)(proj + row * NCOL + CQM + hm * 128 + d0) = y; }
    }
}

#define XB_TMO      128
#define XB_XCNT(j)  (256  + 64 * (j))
#define XB_XSUB(j)  (1280 + 64 * (j))
#define XB_XGEN(j)  (2304 + 64 * (j))
#define XB_TOP      3328
#define XB_TOPGEN   3392
#define XCD_BAR_WORDS 3456
#define XB_SPIN_CAP (1u << 18)
__device__ __forceinline__ unsigned xb_ld(unsigned* p)              { return __hip_atomic_load(p, __ATOMIC_RELAXED, __HIP_MEMORY_SCOPE_AGENT); }
__device__ __forceinline__ unsigned xb_add(unsigned* p, unsigned v) { return __hip_atomic_fetch_add(p, v, __ATOMIC_RELAXED, __HIP_MEMORY_SCOPE_AGENT); }
__device__ __forceinline__ unsigned xb_xcc_id() { return (unsigned)__builtin_amdgcn_s_getreg((3 << 11) | 20) & 0xFu; }
#define XB_SPIN(cond, bar) do { unsigned _sp = 0; while (cond) { __builtin_amdgcn_s_sleep(1); \
    if ((++_sp & 255u) == 0u) { if (xb_ld(&(bar)[XB_TMO])) break; if (_sp > XB_SPIN_CAP) { atomicAdd(&(bar)[XB_TMO], 1u); break; } } } } while (0)
struct XcdBarrier { unsigned* bar; unsigned x; volatile LAS unsigned* st; };
__device__ __forceinline__ XcdBarrier xcd_barrier_post(unsigned* bar, volatile LAS unsigned* st) {
    XcdBarrier b; b.bar = bar; b.x = xb_xcc_id(); b.st = st;
    if (threadIdx.x == 0) (void)xb_add(&bar[XB_XCNT(b.x)], 1u);
    return b;
}
__device__ __forceinline__ void xcd_barrier_complete(unsigned* bar, unsigned x, unsigned& nloc, unsigned& nx) {
    const unsigned G = gridDim.x * gridDim.y * gridDim.z;
    unsigned sum, cnt, mine, sp = 0u;
    for (;;) {
        sum = 0u; cnt = 0u; mine = 0u;
#pragma unroll
        for (unsigned j = 0; j < 16; ++j) { const unsigned c = xb_ld(&bar[XB_XCNT(j)]); sum += c; cnt += (c > 0u) ? 1u : 0u; mine = (j == x) ? c : mine; }
        if (sum == G) break;
        __builtin_amdgcn_s_sleep(1);
        if ((++sp & 255u) == 0u) { if (xb_ld(&bar[XB_TMO])) break; if (sp > XB_SPIN_CAP) { atomicAdd(&bar[XB_TMO], 1u); break; } }
    }
    nloc = mine > 0u ? mine : 1u; nx = cnt > 0u ? cnt : 1u;
}
__device__ __forceinline__ void xcd_barrier(const XcdBarrier& b) {
    asm volatile("s_waitcnt vmcnt(0)" ::: "memory");
    __syncthreads();
    if (threadIdx.x == 0) {
        unsigned* bar = b.bar;
        __builtin_amdgcn_s_waitcnt(0);
        unsigned nloc = b.st[0], nx = b.st[1];
        if (nloc == 0u) { xcd_barrier_complete(bar, b.x, nloc, nx); b.st[0] = nloc; b.st[1] = nx; }
        const unsigned old = xb_add(&bar[XB_XSUB(b.x)], 1u);
        const unsigned gen = old / nloc;
        if (old + 1u == (gen + 1u) * nloc) {
            __builtin_amdgcn_fence(__ATOMIC_RELEASE, "agent");
            asm volatile("s_waitcnt vmcnt(0)" ::: "memory");
            const unsigned og = xb_add(&bar[XB_TOP], 1u);
            const unsigned tg = og / nx;
            if (og + 1u == (tg + 1u) * nx) xb_add(&bar[XB_TOPGEN], 1u);
            else XB_SPIN(xb_ld(&bar[XB_TOPGEN]) == tg, bar);
            __builtin_amdgcn_fence(__ATOMIC_ACQUIRE, "agent");
            xb_add(&bar[XB_XGEN(b.x)], 1u);
            asm volatile("s_waitcnt vmcnt(0)" ::: "memory");
        } else {
            XB_SPIN(xb_ld(&bar[XB_XGEN(b.x)]) == gen, bar);
            __builtin_amdgcn_fence(__ATOMIC_ACQUIRE, "agent");
            asm volatile("s_waitcnt vmcnt(0)" ::: "memory");
        }
    }
    __syncthreads();
}

__global__ void __launch_bounds__(512) hymba_fwd(Args a) {
    extern __shared__ __attribute__((aligned(16))) unsigned char lds_raw[];
    LAS unsigned char* lds = (LAS unsigned char*)lds_raw;
    const int G = gridDim.x, bx = blockIdx.x;
    const int lo = a.ph_lo, hi = a.ph_hi;
    bf16_t* proj = (bf16_t*)(a.ws + WS_PROJ);
#define IN(k) (lo <= (k) && (k) < hi)
#define SEAM(k) do { if (IN(k) && IN((k) + 1)) { if (a.pad == 0x5eed) cg::this_grid().sync(); xcd_barrier(xbar); } } while (0)
    volatile LAS unsigned* xst = (volatile LAS unsigned*)(lds + LDS_BYTES - 16);
    if (threadIdx.x < 2) xst[threadIdx.x] = 0u;
    __syncthreads();
    XcdBarrier xbar; xbar.bar = (unsigned*)(a.ws + WS_BAR); xbar.x = 0; xbar.st = xst;
    if (hi - lo > 1) xbar = xcd_barrier_post((unsigned*)(a.ws + WS_BAR), xst);
    if (IN(0)) { p0_phase(a, lds); __syncthreads(); }
    SEAM(0);
#pragma unroll 1
    for (int l = 0; l < 2; ++l) {
        const int base = 1 + 5 * l;
        if (IN(base)) {
            {
            pg8::Gemm g{(const bf16_t*)(a.ws + WS_H), (const bf16_t*)(a.ws + WS_WIN) + (size_t)l * NIN * DM, NTOK, NIN, DM, DM};
            pg8::StaticOrder S; S.init(NTOK, NIN, G, bx);
            pg8::EpiBf16Scale E{proj, NCOL, (bf16_t*)(a.ws + WS_KC), (bf16_t*)(a.ws + WS_VC)};
            if (G == 256) {
                pg8::Unit u0; if (S.next(0, u0) && threadIdx.x < 256) { const float* rss = (const float*)(a.ws + WS_RSS) + u0.pm * 256 + threadIdx.x;
                    ((LAS float*)(lds + 131072))[threadIdx.x] = frsq(((rss[0] + rss[NTOK]) + (rss[2 * NTOK] + rss[3 * NTOK])) * (1.f / 1024.f) + EPS); }
                __syncthreads();
                pg8::gemm_phase<pg8::EpiBf16Scale, pg8::StaticOrder>(lds, g, S, E);
            } else {
                for (int i = 0; ; ++i) { pg8::Unit u0; if (!S.next(i, u0)) break;
                    if (threadIdx.x < 256) { const float* rss = (const float*)(a.ws + WS_RSS) + u0.pm * 256 + threadIdx.x;
                        ((LAS float*)(lds + 131072))[threadIdx.x] = frsq(((rss[0] + rss[NTOK]) + (rss[2 * NTOK] + rss[3 * NTOK])) * (1.f / 1024.f) + EPS); }
                    __syncthreads();
                    pg8::StaticOrder S1; S1.init(NTOK, NIN, 1 << 30, i * G + bx);
                    pg8::gemm_phase<pg8::EpiBf16Scale, pg8::StaticOrder>(lds, g, S1, E); __syncthreads(); }
            }
            __syncthreads();
            }
        }
        SEAM(base);
        if (IN(base + 1)) {
            const int NKV = (G >= 64) ? 32 : 0;
            {
            {
                pg8::Gemm g{(const bf16_t*)(a.ws + (l ? WS_MEMH1 : WS_MEMH)), (const bf16_t*)(a.ws + WS_WMEM) + (size_t)l * DM * DM, NMEM, 1024, DM, DM};
                pg8::StaticOrder S; S.init(NMEM, 1024, G, bx);
                pg8::EpiBf16 E{(bf16_t*)(a.ws + WS_KVM), 1024};
                pg8::gemm_phase<pg8::EpiBf16, pg8::StaticOrder>(lds, g, S, E);
                __syncthreads();
            }
            if (bx >= NKV) {
                const int wb = bx - NKV, WG = G - NKV;
                const int tid = otid();
                { PrepIn cur; int u = wb; moba_prep_load(a, tid, u < 512 ? u : 0, cur);
                  for (; u < 512; u += WG) { PrepIn nxt; moba_prep_unit(a, l, lds, tid, u, cur, nxt, (u + WG < 512) ? u + WG : u); cur = nxt; } }
                { HIn cur; int u = (wb + 160) % WG;     hgrn_load<false>(a, tid, u < 1024 ? u : 0, cur);
                  for (; u < 1024; u += WG) { HIn nxt; hgrn_stage1_unit(a, l, lds, tid, u, cur, nxt, (u + WG < 1024) ? u + WG : u); cur = nxt; } }
                __syncthreads();
            }
            }
        }
        SEAM(base + 1);
        if (IN(base + 2)) {
            {
                for (int u = bx; u < 512; u += G) {
                    int bh, qb; if (G == 256) { bh = bx >> 2; const int s = bx & 3; qb = (u < 256) ? 7 - s : s; } else { bh = u >> 3; qb = 7 - (u & 7); }
                    moba_unit(a, l, lds, bh >> 3, bh & 7, qb);
                }
            }
            for (int u = bx; u < 256; u += G) mem_unit(a, l, lds, u >> 5, (u >> 3) & 3, u & 7);
            hgrn_scan_phase(a);
            __syncthreads();
        }
        SEAM(base + 2);
        if (IN(base + 3)) {
            { const int tid = otid(); HIn cur; int u = bx; hgrn_load<true>(a, tid, u < 1024 ? u : 0, cur);
                for (; u < 1024; u += G) { HIn nxt; hgrn_stage3_unit(a, l, lds, tid, u, cur, nxt, (u + G < 1024) ? u + G : u); cur = nxt; } }
            __syncthreads();
        }
        SEAM(base + 3);
        if (IN(base + 4)) {
            pg8::Gemm g{proj, (const bf16_t*)(a.ws + WS_WOUT) + (size_t)l * DM * DMIX, NTOK, DM, DMIX, NCOL};
            pg8::StaticOrder S; S.init(NTOK, DM, G, bx);
            if (l == 0) { {
                pg8::EpiResF32Norm E{a.x, a.out, DM, a.norm_g + DM, (bf16_t*)(a.ws + WS_H), (float*)(a.ws + WS_RSS)};
                pg8::gemm_phase<pg8::EpiResF32Norm, pg8::StaticOrder>(lds, g, S, E); __syncthreads(); } }
            else { pg8::EpiResF32 E{(const float*)a.out, a.out, DM};
                pg8::gemm_phase<pg8::EpiResF32, pg8::StaticOrder>(lds, g, S, E); __syncthreads(); }
        }
        if (l == 0) SEAM(base + 4);
    }
#undef IN
#undef SEAM
}

extern "C" void kernel_launch(void* const* d_in, const int* in_sizes, int n_in, void* d_out, int out_size, void* d_ws, size_t ws_size, hipStream_t stream) {
    static int grid = 0;
    if (grid == 0) {
        if (n_in != 14 || out_size != NTOK * DM || ws_size < WS_BAR + 65536) { fprintf(stderr, "kernel_launch: unexpected shapes (n_in %d out %d ws %zu)\n", n_in, out_size, ws_size); grid = -1; return; }
        int dev = 0, cus = 0, per_cu = 0;
        hipGetDevice(&dev); hipDeviceGetAttribute(&cus, hipDeviceAttributeMultiprocessorCount, dev);
        if (hipFuncSetAttribute((const void*)hymba_fwd, hipFuncAttributeMaxDynamicSharedMemorySize, LDS_BYTES) != hipSuccess) { fprintf(stderr, "kernel_launch: hipFuncSetAttribute failed\n"); grid = -1; return; }
        if (hipOccupancyMaxActiveBlocksPerMultiprocessor(&per_cu, (const void*)hymba_fwd, 512, LDS_BYTES) != hipSuccess || per_cu < 1) { fprintf(stderr, "kernel_launch: occupancy query says %d\n", per_cu); per_cu = 1; }
        (void)hipGetLastError();
        grid = cus * (per_cu > 1 ? 1 : per_cu);
    }
    if (grid < 0) return;
    if (hipMemsetAsync((char*)d_ws + WS_BAR, 0, XCD_BAR_WORDS * 4, stream) != hipSuccess) { fprintf(stderr, "kernel_launch: memset failed\n"); return; }
    Args a{};
    a.x = (const float*)d_in[0]; a.mem = (const float*)d_in[1]; a.pos = (const int*)d_in[2]; a.norm_g = (const float*)d_in[3]; a.w_in = (const float*)d_in[4]; a.w_out = (const float*)d_in[5];
    a.mqn = (const float*)d_in[6]; a.mkn = (const float*)d_in[7]; a.lbl = (const float*)d_in[8]; a.hon = (const float*)d_in[9]; a.mng = (const float*)d_in[10]; a.wmem = (const float*)d_in[11];
    a.memqn = (const float*)d_in[12]; a.memkn = (const float*)d_in[13]; a.out = (float*)d_out; a.ws = (unsigned char*)d_ws; a.rep = 0;
#if MK_ONE_LAUNCH
    a.ph_lo = 0; a.ph_hi = NPHASE;
    void* args[] = {&a};
    hipError_t e = hipLaunchCooperativeKernel((const void*)hymba_fwd, dim3(grid), dim3(512), args, LDS_BYTES, stream);
    if (e != hipSuccess) fprintf(stderr, "cooperative launch failed: %s (grid %d)\n", hipGetErrorString(e), grid);
#else
    for (int p = 0; p < NPHASE; ++p) { a.ph_lo = p; a.ph_hi = p + 1; hipLaunchKernelGGL(hymba_fwd, dim3(grid), dim3(512), LDS_BYTES, stream, a); }
#endif
}
```

```cpp
#include <hip/hip_runtime.h>
#include <hip/hip_cooperative_groups.h>
#include <cstdio>
#include <cstdint>
namespace cg = cooperative_groups;

#ifndef MK_ONE_LAUNCH
#define MK_ONE_LAUNCH 1
#endif

#define LAS __attribute__((address_space(3)))
typedef unsigned short bf16_t;
typedef short bf16x8 __attribute__((ext_vector_type(8)));
typedef short s16x4 __attribute__((ext_vector_type(4)));
typedef float f32x4 __attribute__((ext_vector_type(4)));
typedef unsigned u32x4 __attribute__((ext_vector_type(4)));
typedef unsigned u32x2 __attribute__((ext_vector_type(2)));

constexpr int NB = 8, SEQ = 2048, DM = 1024, NTOK = NB * SEQ, MEML = 256, NMEM = NB * MEML, NCOL = 4096  , NIN = 5120  , DMIX = 1536;
constexpr int CQA = 0, CQH = 512, CQM = 1024, CZ = 1536, CFH = 3072, CIH = 3584;
constexpr float EPS = 1e-6f;
constexpr float LOG2E = 1.4426950408889634f;
constexpr size_t MiB = 1u << 20;
constexpr size_t WS_WIN = 0, WS_WOUT = 20 * MiB, WS_WMEM = 26 * MiB, WS_H = 30 * MiB  , WS_MEMH = 62 * MiB, WS_KVM = 66 * MiB,
                 WS_PROJ = 70 * MiB, WS_KC = 198 * MiB, WS_VC = 214 * MiB, WS_VT = 230 * MiB, WS_KMEAN = 246 * MiB, WS_DECAY = 246 * MiB + 128 * 1024, WS_ROPE = 247 * MiB, WS_END = 248 * MiB, WS_MEMH1 = 230 * MiB  , WS_RSS = 250 * MiB  , WS_LB = 251 * MiB  , WS_BAR = 252 * MiB  ;
constexpr int LDS_BYTES = 147456;
constexpr int NPHASE = 11;

struct Args {
    const float *x, *mem; const int* pos; const float *norm_g, *w_in, *w_out, *mqn, *mkn, *lbl, *hon, *mng, *wmem, *memqn, *memkn;
    float* out; unsigned char* ws; int ph_lo, ph_hi, rep, pad;
};

typedef float f32x2_t __attribute__((ext_vector_type(2))); typedef __bf16 bf16x2_t __attribute__((ext_vector_type(2)));
__device__ __forceinline__ unsigned pk2(float lo, float hi) { f32x2_t v = {lo, hi}; bf16x2_t b = __builtin_convertvector(v, bf16x2_t); return __builtin_bit_cast(unsigned, b); }
__device__ __forceinline__ unsigned f2bf(float f) { return pk2(f, 0.f) & 0xffffu; }
__device__ __forceinline__ float bflo(unsigned u) { return __uint_as_float(u << 16); }
__device__ __forceinline__ float bfhi(unsigned u) { return __uint_as_float(u & 0xffff0000u); }
__device__ __forceinline__ float bf2f(short s) { return __uint_as_float(((unsigned)(unsigned short)s) << 16); }
__device__ __forceinline__ float wave_sum(float v) {
#pragma unroll
    for (int o = 1; o < 64; o <<= 1) v += __shfl_xor(v, o);
    return v;
}
__device__ __forceinline__ float ex2(float x) { return __builtin_amdgcn_exp2f(x); }
__device__ __forceinline__ float fexp(float x) { return __builtin_amdgcn_exp2f(x * LOG2E); }
__device__ __forceinline__ float frcp(float x) { return __builtin_amdgcn_rcpf(x); }
__device__ __forceinline__ float frsq(float x) { return __builtin_amdgcn_rsqf(x); }
__device__ __forceinline__ float sigm(float x) { return frcp(1.f + fexp(-x)); }
__device__ __forceinline__ float silu(float x) { return x * frcp(1.f + fexp(-x)); }
#define LDS_WAIT() asm volatile("s_waitcnt lgkmcnt(0)" ::: "memory")
__device__ __forceinline__ int otid() { int t = threadIdx.x; asm volatile("" : "+v"(t)); return t; }
typedef short v4i16_t __attribute__((ext_vector_type(4)));
__device__ __forceinline__ s16x4 tr4(const LAS unsigned char* base, int pitch, int r0, int c0, int lane) {
    const int q = (lane & 15) >> 2, p = lane & 3;
    return __builtin_bit_cast(s16x4, __builtin_amdgcn_ds_read_tr16_b64_v4i16((LAS v4i16_t*)(base + (r0 + q) * pitch + (c0 + 4 * p) * 2)));
}
#define MFMA16(a, b, c) __builtin_amdgcn_mfma_f32_16x16x32_bf16((a), (b), (c), 0, 0, 0)

namespace pg8 {
constexpr int BM = 256, BK = 64, HALF = 128, HTB = HALF * BK * 2, NXCD = 8, WGM = 8;
__host__ __device__ __forceinline__ int lds_byte(int r, int c) { const int st = (r >> 4) * 2 + (c >> 5), rr = r & 15, cc = c & 31, ob = rr * 64 + cc * 2; return st * 1024 + (ob ^ (((ob >> 9) & 1) << 5)); }
__host__ __device__ __forceinline__ void stage_rc(int b, int& R, int& C) { const int st = b / 1024, sb = b % 1024, swz = sb ^ (((sb >> 9) & 1) << 5); R = (st >> 1) * 16 + swz / 64; C = (st & 1) * 32 + (swz % 64) / 2; }
__host__ __device__ __forceinline__ int perm32(int rho) { const int n = rho >> 4, i = rho & 15; return 8 * (i >> 2) + 4 * n + (i & 3); }
struct Unit { int pm, pn; };
struct Gemm { const bf16_t* A; const bf16_t* Bt; int M, N, K, lda; };
struct StaticOrder {
    int nM, nN, nwg, G, c;
    __device__ void init(int M, int N, int G_, int c_) { nM = M / BM; nN = N / BM; nwg = nM * nN; G = G_; c = c_; }
    __device__ bool next(int i, Unit& u) const {
        const long L = (long)i * G + c; if (L >= nwg) return false;
        int wgid = (int)L; { const int q = nwg / NXCD, r = nwg % NXCD, xcd = wgid % NXCD, off = wgid / NXCD; wgid = (xcd < r ? xcd * (q + 1) : r * (q + 1) + (xcd - r) * q) + off; }
        const int nig = WGM * nN, gid = wgid / nig, fm = gid * WGM, gsz = (nM - fm) < WGM ? (nM - fm) : WGM;
        u.pm = fm + ((wgid % nig) % gsz); u.pn = (wgid % nig) / gsz; return true;
    }
};
__device__ __forceinline__ unsigned cvt_pk_bf16(float lo, float hi) { unsigned r; asm volatile("v_cvt_pk_bf16_f32 %0, %1, %2" : "=v"(r) : "v"(lo), "v"(hi)); return r; }
struct EpiBf16 {
    static constexpr bool PERM = true;
    bf16_t* O; int ldc;
    __device__ __forceinline__ void operator()(const f32x4 (&acc)[2][2][4][2], const Unit& u, int wr, int wc, int fr, int fq, LAS unsigned char*) const {
        const int row0 = u.pm * BM + wr * 64 + fr; const int col0 = u.pn * BM + wc * 32 + 8 * fq;
#pragma unroll
        for (int ai = 0; ai < 2; ++ai)
#pragma unroll
            for (int m = 0; m < 4; ++m) { bf16_t* rowp = O + (size_t)(row0 + ai * HALF + m * 16) * ldc + col0;
#pragma unroll
                for (int bj = 0; bj < 2; ++bj) { const f32x4 v0 = acc[ai][bj][m][0], v1 = acc[ai][bj][m][1];
                    u32x4 w; w.x = cvt_pk_bf16(v0[0], v0[1]); w.y = cvt_pk_bf16(v0[2], v0[3]); w.z = cvt_pk_bf16(v1[0], v1[1]); w.w = cvt_pk_bf16(v1[2], v1[3]);
                    *(u32x4*)(rowp + bj * HALF) = w; } }
    }
};
struct EpiBf16Scale {
    static constexpr bool PERM = true;
    bf16_t* O; int ldc; bf16_t* Kc; bf16_t* Vc;
    __device__ __forceinline__ void operator()(const f32x4 (&acc)[2][2][4][2], const Unit& u, int wr, int wc, int fr, int fq, LAS unsigned char* lds) const {
        const int row0 = u.pm * BM + wr * 64 + fr; const int col0 = u.pn * BM + wc * 32 + 8 * fq;
        const LAS float* rtab = (const LAS float*)(lds + 131072);
        const bool compact = u.pn >= 16;
#pragma unroll
        for (int ai = 0; ai < 2; ++ai)
#pragma unroll
            for (int m = 0; m < 4; ++m) { const int row = row0 + ai * HALF + m * 16;
                const float r = rtab[ai * HALF + wr * 64 + m * 16 + fr];
#pragma unroll
                for (int bj = 0; bj < 2; ++bj) { const f32x4 v0 = acc[ai][bj][m][0] * r, v1 = acc[ai][bj][m][1] * r;
                    u32x4 w; w.x = cvt_pk_bf16(v0[0], v0[1]); w.y = cvt_pk_bf16(v0[2], v0[3]); w.z = cvt_pk_bf16(v1[0], v1[1]); w.w = cvt_pk_bf16(v1[2], v1[3]);
                    bf16_t* dst;
                    if (compact) { const int cc = col0 + bj * HALF - 4096, hc = cc & 511, hh = hc >> 6, d = hc & 63;
                        dst = ((cc >> 9) ? Vc : Kc) + ((size_t)((row >> 11) * 8 + hh) * 2048 + (row & 2047)) * 64 + d; }
                    else dst = O + (size_t)row * ldc + col0 + bj * HALF;
                    *(u32x4*)dst = w; } }
    }
};
struct EpiResF32Norm {
    static constexpr bool PERM = true;
    const float* res; float* O; int ldc; const float* g; bf16_t* H; float* rss;
    __device__ __forceinline__ void operator()(const f32x4 (&acc)[2][2][4][2], const Unit& u, int wr, int wc, int fr, int fq, LAS unsigned char* lds) const {
        const int row0 = u.pm * BM + wr * 64 + fr; const int col0 = u.pn * BM + wc * 32 + 8 * fq;
        LAS float* part = (LAS float*)(lds + 131072);
        f32x4 gg[2][2];
#pragma unroll
        for (int bj = 0; bj < 2; ++bj)
#pragma unroll
            for (int n = 0; n < 2; ++n) gg[bj][n] = *(const f32x4*)(g + col0 + bj * HALF + 4 * n);
#pragma unroll
        for (int ai = 0; ai < 2; ++ai)
#pragma unroll
            for (int m = 0; m < 4; ++m) { const size_t ro = (size_t)(row0 + ai * HALF + m * 16) * ldc + col0; float ssq = 0.f;
#pragma unroll
                for (int bj = 0; bj < 2; ++bj) { const size_t o = ro + bj * HALF;
                    const f32x4 r0 = *(const f32x4*)(res + o), r1 = *(const f32x4*)(res + o + 4);
                    const f32x4 x0 = r0 + acc[ai][bj][m][0], x1 = r1 + acc[ai][bj][m][1];
                    *(f32x4*)(O + o) = x0; *(f32x4*)(O + o + 4) = x1;
                    u32x4 hb; hb.x = cvt_pk_bf16(x0[0] * gg[bj][0][0], x0[1] * gg[bj][0][1]); hb.y = cvt_pk_bf16(x0[2] * gg[bj][0][2], x0[3] * gg[bj][0][3]);
                    hb.z = cvt_pk_bf16(x1[0] * gg[bj][1][0], x1[1] * gg[bj][1][1]); hb.w = cvt_pk_bf16(x1[2] * gg[bj][1][2], x1[3] * gg[bj][1][3]);
                    *(u32x4*)(H + o) = hb;
                    ssq += ((x0[0] * x0[0] + x0[1] * x0[1]) + (x0[2] * x0[2] + x0[3] * x0[3])) + ((x1[0] * x1[0] + x1[1] * x1[1]) + (x1[2] * x1[2] + x1[3] * x1[3])); }
                ssq += __shfl_xor(ssq, 16); ssq += __shfl_xor(ssq, 32);
                if (fq == 0) part[(ai * HALF + wr * 64 + m * 16 + fr) * 4 + wc] = ssq; }
        asm volatile("s_waitcnt lgkmcnt(0)" ::: "memory"); __builtin_amdgcn_s_barrier(); asm volatile("" ::: "memory");
        const int t = threadIdx.x;
        if (t < 256) { const f32x4 p = *(const LAS f32x4*)(part + t * 4); rss[(size_t)u.pn * NTOK + u.pm * BM + t] = (p[0] + p[1]) + (p[2] + p[3]); }
    }
};
struct EpiResF32 {
    static constexpr bool PERM = true;
    const float* res; float* O; int ldc;
    __device__ __forceinline__ void operator()(const f32x4 (&acc)[2][2][4][2], const Unit& u, int wr, int wc, int fr, int fq, LAS unsigned char*) const {
        const int row0 = u.pm * BM + wr * 64 + fr; const int col0 = u.pn * BM + wc * 32 + 8 * fq;
#pragma unroll
        for (int ai = 0; ai < 2; ++ai)
#pragma unroll
            for (int m = 0; m < 4; ++m) { const size_t ro = (size_t)(row0 + ai * HALF + m * 16) * ldc + col0;
#pragma unroll
                for (int bj = 0; bj < 2; ++bj) { const size_t o = ro + bj * HALF; const f32x4 r0 = *(const f32x4*)(res + o), r1 = *(const f32x4*)(res + o + 4);
                    *(f32x4*)(O + o) = r0 + acc[ai][bj][m][0]; *(f32x4*)(O + o + 4) = r1 + acc[ai][bj][m][1]; } }
    }
};

template <class Epi, class Sched>
__device__ __forceinline__ void gemm_phase(LAS unsigned char* lds, const Gemm g, const Sched& S, const Epi& E) {
    const int tid = otid(), wid = __builtin_amdgcn_readfirstlane(tid >> 6), lane = tid & 63, wr = wid >> 2, wc = wid & 3, fr = lane & 15, fq = lane >> 4;
    const int K = g.K, nt = K / BK, lda = g.lda;
    unsigned voffA[2], voffB[2];
#pragma unroll
    for (int i = 0; i < 2; ++i) { int R, C; stage_rc(tid * 16 + i * 8192, R, C); const int Rb = Epi::PERM ? ((R & ~31) + perm32(R & 31)) : R;
        voffA[i] = (unsigned)(R * lda + C) * 2u; voffB[i] = (unsigned)(Rb * K + C) * 2u; }
    const size_t kstep = (size_t)(BK * 2);
    const size_t hstepA = (size_t)HALF * lda * 2, hstepB = (size_t)HALF * K * 2;
    const size_t tstepA = 2 * hstepA, tstepB = 2 * hstepB;
    const unsigned ldsw = (unsigned)wid * 1024u;
    const int aoff = lds_byte(wr * 64 + fr, fq * 8), boff = lds_byte(wc * 32 + fr, fq * 8);
#define PG8_SA(b, h) (((b) * 2 + (h)) * HTB)
#define PG8_SB(b, h) ((4 + (b) * 2 + (h)) * HTB)
#define PG8_STAGE(bufoff, gbase, voff) do { _Pragma("unroll") for (int _i = 0; _i < 2; ++_i) \
        __builtin_amdgcn_global_load_lds((const unsigned*)((const char*)(gbase) + (voff)[_i]), (LAS unsigned*)(lds + (bufoff) + ldsw + _i * 8192), 16, 0, 0); } while (0)
#define PG8_LDA(dst, b, h) do { _Pragma("unroll") for (int m = 0; m < 4; ++m) _Pragma("unroll") for (int k = 0; k < 2; ++k) dst[m][k] = *(const LAS bf16x8*)(lds + PG8_SA(b, h) + aoff + m * 2048 + k * 1024); } while (0)
#define PG8_LDB(dst, b, h) do { _Pragma("unroll") for (int n = 0; n < 2; ++n) _Pragma("unroll") for (int k = 0; k < 2; ++k) dst[n][k] = *(const LAS bf16x8*)(lds + PG8_SB(b, h) + boff + n * 2048 + k * 1024); } while (0)
#define PG8_MMA(ai, bj, At, Bt) do { __builtin_amdgcn_s_setprio(1); _Pragma("unroll") for (int m = 0; m < 4; ++m) _Pragma("unroll") for (int n = 0; n < 2; ++n) _Pragma("unroll") for (int k = 0; k < 2; ++k) \
        acc[ai][bj][m][n] = __builtin_amdgcn_mfma_f32_16x16x32_bf16(Bt[n][k], At[m][k], acc[ai][bj][m][n], 0, 0, 0); __builtin_amdgcn_s_setprio(0); } while (0)
#define PG8_WAIT_V(n) asm volatile("s_waitcnt vmcnt(" #n ")" ::: "memory")
#define PG8_WAIT_L(n) asm volatile("s_waitcnt lgkmcnt(" #n ")" ::: "memory")
#define PG8_BAR __builtin_amdgcn_s_barrier()
#define PG8_SCHED __builtin_amdgcn_sched_barrier(0)
    Unit cur, nxt; int ui = 0;
    if (!S.next(0, cur)) return;
    f32x4 acc[2][2][4][2];
#pragma unroll
    for (int a = 0; a < 2; ++a)
#pragma unroll
        for (int b = 0; b < 2; ++b)
#pragma unroll
            for (int m = 0; m < 4; ++m)
#pragma unroll
                for (int n = 0; n < 2; ++n) acc[a][b][m][n] = (f32x4){0.f, 0.f, 0.f, 0.f};
    bf16x8 At[4][2], B0[2][2], B1[2][2];
    const char* cA = (const char*)g.A + (size_t)cur.pm * tstepA; const char* cB = (const char*)g.Bt + (size_t)cur.pn * tstepB;
    PG8_STAGE(PG8_SB(0, 0), cB, voffB); PG8_STAGE(PG8_SB(0, 1), cB + hstepB, voffB); PG8_STAGE(PG8_SA(0, 0), cA, voffA); PG8_STAGE(PG8_SA(0, 1), cA + hstepA, voffA);
    if (wr == 1) PG8_BAR;
    PG8_WAIT_V(2); PG8_BAR;
    PG8_STAGE(PG8_SB(1, 0), cB + kstep, voffB); PG8_STAGE(PG8_SA(1, 0), cA + kstep, voffA); PG8_STAGE(PG8_SB(1, 1), cB + hstepB + kstep, voffB);
    PG8_WAIT_V(6); PG8_BAR;
    for (;;) {
        const bool has_next = S.next(ui + 1, nxt);
        const char* nA = has_next ? (const char*)g.A + (size_t)nxt.pm * tstepA : cA; const char* nB = has_next ? (const char*)g.Bt + (size_t)nxt.pn * tstepB : cB;
        for (int t = 0; t < nt; t += 2) {
            const bool last = (t == nt - 2);
            const char* a1 = cA + (size_t)(t + 1) * kstep;
            const char* a2 = last ? nA : cA + (size_t)(t + 2) * kstep; const char* b2 = last ? nB : cB + (size_t)(t + 2) * kstep;
            const char* a3 = a2 + kstep; const char* b3 = b2 + kstep;
            PG8_LDB(B0, 0, 0); PG8_LDB(B1, 0, 1); PG8_SCHED; PG8_LDA(At, 0, 0); PG8_STAGE(PG8_SA(1, 1), a1 + hstepA, voffA);
            PG8_WAIT_V(8); PG8_WAIT_L(0); PG8_BAR; PG8_MMA(0, 0, At, B0); PG8_MMA(0, 1, At, B1); PG8_BAR; PG8_SCHED;
            PG8_LDA(At, 0, 1); PG8_STAGE(PG8_SB(0, 0), b2, voffB); PG8_STAGE(PG8_SB(0, 1), b2 + hstepB, voffB); PG8_STAGE(PG8_SA(0, 0), a2, voffA);
            PG8_WAIT_V(8); PG8_WAIT_L(0); PG8_BAR; PG8_MMA(1, 0, At, B0); PG8_MMA(1, 1, At, B1); PG8_BAR; PG8_SCHED;
            PG8_LDB(B0, 1, 0); PG8_LDB(B1, 1, 1); PG8_SCHED; PG8_LDA(At, 1, 0); PG8_STAGE(PG8_SA(0, 1), a2 + hstepA, voffA);
            PG8_WAIT_V(8); PG8_WAIT_L(0); PG8_BAR; PG8_MMA(0, 0, At, B0); PG8_MMA(0, 1, At, B1); PG8_BAR; PG8_SCHED;
            PG8_LDA(At, 1, 1); PG8_STAGE(PG8_SB(1, 0), b3, voffB); PG8_STAGE(PG8_SB(1, 1), b3 + hstepB, voffB); PG8_STAGE(PG8_SA(1, 0), a3, voffA);
            PG8_WAIT_V(8); PG8_WAIT_L(0); PG8_BAR; PG8_MMA(1, 0, At, B0); PG8_MMA(1, 1, At, B1); PG8_BAR; PG8_SCHED;
        }
        if (wr == 0) PG8_BAR;
        E(acc, cur, wr, wc, fr, fq, lds);
        if (!has_next) break;
#pragma unroll
        for (int a = 0; a < 2; ++a)
#pragma unroll
            for (int b = 0; b < 2; ++b)
#pragma unroll
                for (int m = 0; m < 4; ++m)
#pragma unroll
                    for (int n = 0; n < 2; ++n) acc[a][b][m][n] = (f32x4){0.f, 0.f, 0.f, 0.f};
        cur = nxt; cA = nA; cB = nB; ++ui;
        if (wr == 1) PG8_BAR;
    }
    PG8_WAIT_V(0);
    PG8_BAR;
#undef PG8_SA
#undef PG8_SB
#undef PG8_STAGE
#undef PG8_LDA
#undef PG8_LDB
#undef PG8_MMA
#undef PG8_WAIT_V
#undef PG8_WAIT_L
#undef PG8_BAR
#undef PG8_SCHED
}
}

__device__ __forceinline__ void transpose_item(const float* W, int ldw, int K, int ncols, bf16_t* WT, int row_off, LAS float* scr, int item, int lane) {
    const int nblk = ncols / 64, kb = item / nblk, nb = item % nblk, k0 = 64 * kb, n0 = 64 * nb;
    f32x4 v[16];
#pragma unroll
    for (int i = 0; i < 16; ++i) v[i] = *(const f32x4*)(W + (size_t)(k0 + 4 * i + (lane >> 4)) * ldw + n0 + (lane & 15) * 4);
#pragma unroll
    for (int i = 0; i < 16; ++i) { LAS float* d = scr + (4 * i + (lane >> 4)) * 65 + (lane & 15) * 4; d[0] = v[i].x; d[1] = v[i].y; d[2] = v[i].z; d[3] = v[i].w; }
    LDS_WAIT();
    const int c = lane & 7;
#pragma unroll
    for (int j = 0; j < 8; ++j) { const int n = (lane >> 3) + 8 * j; const LAS float* s = scr + (8 * c) * 65 + n;
        u32x4 o; o.x = pk2(s[0 * 65], s[1 * 65]); o.y = pk2(s[2 * 65], s[3 * 65]); o.z = pk2(s[4 * 65], s[5 * 65]); o.w = pk2(s[6 * 65], s[7 * 65]);
        *(u32x4*)(WT + (size_t)(row_off + n0 + n) * K + k0 + 8 * c) = o; }
    LDS_WAIT();
}
__device__ __forceinline__ void norm_phase(const Args& a) {
    const int tid = otid(); const int lane = tid & 63, gw = blockIdx.x * 8 + (tid >> 6), NGW = gridDim.x * 8;
    bf16_t* H = (bf16_t*)(a.ws + WS_H); float* rss = (float*)(a.ws + WS_RSS);
    constexpr int NROWS = NTOK + 2 * NMEM;
    for (int m0 = gw; m0 < NROWS; m0 += 4 * NGW) {
        f32x4 v[4][4]; const float* gp[4]; bf16_t* op[4]; int mm[4];
#pragma unroll
        for (int r = 0; r < 4; ++r) { int m = m0 + r * NGW; if (m >= NROWS) m = m0; mm[r] = m;
            const float* xrow; if (m < NTOK) { xrow = a.x + (size_t)m * DM; gp[r] = a.norm_g; op[r] = H + (size_t)m * DM; }
            else { const int q = (m - NTOK) & (NMEM - 1), l = (m - NTOK) >> 11; xrow = a.mem + (size_t)q * DM; gp[r] = a.mng + l * DM; op[r] = (bf16_t*)(a.ws + (l ? WS_MEMH1 : WS_MEMH)) + (size_t)q * DM; }
#pragma unroll
            for (int j = 0; j < 4; ++j) v[r][j] = ((const f32x4*)xrow + lane)[64 * j]; }
#pragma unroll
        for (int r = 0; r < 4; ++r) {
            float sacc = 0.f;
#pragma unroll
            for (int j = 0; j < 4; ++j) sacc += (v[r][j].x * v[r][j].x + v[r][j].y * v[r][j].y) + (v[r][j].z * v[r][j].z + v[r][j].w * v[r][j].w);
            const float tot = wave_sum(sacc); const bool tokrow = mm[r] < NTOK;
            const float rr = tokrow ? 1.f : 1.f / sqrtf(tot * (1.f / DM) + EPS);
            unsigned long long* o8 = (unsigned long long*)op[r] + lane;
#pragma unroll
            for (int j = 0; j < 4; ++j) { const f32x4 gg = ((const f32x4*)gp[r] + lane)[64 * j];
                o8[64 * j] = (unsigned long long)pk2(v[r][j].x * rr * gg.x, v[r][j].y * rr * gg.y) | ((unsigned long long)pk2(v[r][j].z * rr * gg.z, v[r][j].w * rr * gg.w) << 32); }
            if (tokrow && lane < 4) rss[lane * NTOK + mm[r]] = (lane == 0) ? tot : 0.f;
        }
    }
}
__device__ __forceinline__ void p0_phase(const Args& a, LAS unsigned char* lds) {
    const int tid = otid(), lane = tid & 63, wave = tid >> 6;
    LAS float* scr = (LAS float*)(lds + wave * 17408);
    const int gw = blockIdx.x * 8 + wave, NGW = gridDim.x * 8;
    bf16_t* WinT = (bf16_t*)(a.ws + WS_WIN); bf16_t* WoutT = (bf16_t*)(a.ws + WS_WOUT); bf16_t* WmemT = (bf16_t*)(a.ws + WS_WMEM);
    for (int it = gw; it < 3840; it += NGW) {
        const int l = it / 1920; int r = it % 1920;
        if (r < 1280) { const int seg = r >> 7, sub = r & 127; const int oseg = (int)((0x2154987630ULL >> (4 * seg)) & 15ULL);
            transpose_item(a.w_in + (size_t)l * DM * NIN + oseg * 512, NIN, DM, 512, WinT + (size_t)l * NIN * DM, seg * 512, scr, sub, lane); }
        else if (r < 1664) { r -= 1280; transpose_item(a.w_out + (size_t)l * DMIX * DM, DM, DMIX, DM, WoutT + (size_t)l * DM * DMIX, 0, scr, r, lane); }
        else { r -= 1664; transpose_item(a.wmem + (size_t)l * DM * DM, DM, DM, DM, WmemT + (size_t)l * DM * DM, 0, scr, r, lane); }
    }
    float* rope = (float*)(a.ws + WS_ROPE);
    for (int e = blockIdx.x * 512 + tid; e < NTOK * 8; e += gridDim.x * 512) {
        const int tok = e >> 3, i = e & 7;
        const float inv = powf(500000.0f, -(float)i * 0.125f);
        const float ang = (float)a.pos[tok] * inv;
        const double ad = (double)ang; const double n = rint(ad * 0.15915494309189535); const float rr = (float)(ad - n * 6.283185307179586);
        rope[tok * 16 + i] = __cosf(rr); rope[tok * 16 + 8 + i] = __sinf(rr);
    }
    if (blockIdx.x == 0) { float* LB = (float*)(a.ws + WS_LB); LB[tid] = 0.f; const float l0 = a.lbl[tid], l1 = a.lbl[512 + tid]; LB[512 + tid] = 1.f / (1.f + expf(l0 - l1)); }
    norm_phase(a);
}

#define BAR_LDS() do { asm volatile("s_waitcnt lgkmcnt(0)" ::: "memory"); __builtin_amdgcn_s_barrier(); asm volatile("" ::: "memory"); } while (0)
struct PrepIn { u32x4 q[4], k[4]; float cs[8], sn[8]; };
__device__ __forceinline__ void moba_prep_load(const Args& a, int tid, int u, PrepIn& r) {
    const int b = u >> 6, j = (u >> 3) & 7, h = u & 7, tok = tid >> 1, half = tid & 1;
    const size_t row = (size_t)b * SEQ + j * 256 + tok;
    const bf16_t* p = (const bf16_t*)(a.ws + WS_PROJ) + row * NCOL + h * 64 + half * 32;
    const bf16_t* pk = (const bf16_t*)(a.ws + WS_KC) + ((size_t)(b * 8 + h) * SEQ + j * 256 + tok) * 64 + half * 32;
#pragma unroll
    for (int c = 0; c < 4; ++c) { r.q[c] = *(const u32x4*)(p + CQA + c * 8); r.k[c] = *(const u32x4*)(pk + c * 8); }
    const f32x4* rope = (const f32x4*)((const float*)(a.ws + WS_ROPE) + row * 16);
    const f32x4 c0 = rope[0], c1 = rope[1], s0 = rope[2], s1 = rope[3];
    r.cs[0] = c0.x; r.cs[1] = c0.y; r.cs[2] = c0.z; r.cs[3] = c0.w; r.cs[4] = c1.x; r.cs[5] = c1.y; r.cs[6] = c1.z; r.cs[7] = c1.w;
    r.sn[0] = s0.x; r.sn[1] = s0.y; r.sn[2] = s0.z; r.sn[3] = s0.w; r.sn[4] = s1.x; r.sn[5] = s1.y; r.sn[6] = s1.z; r.sn[7] = s1.w;
}
__device__ __forceinline__ void moba_prep_unit(const Args& a, int l, LAS unsigned char* lds, int tid, int u, const PrepIn& in, PrepIn& nxt, int unext) {
    const int b = u >> 6, j = (u >> 3) & 7, h = u & 7, tok = tid >> 1, half = tid & 1;
    bf16_t* proj = (bf16_t*)(a.ws + WS_PROJ);
    const size_t row = (size_t)b * SEQ + j * 256 + tok;
    LAS float* kt = (LAS float*)lds;
    LAS float* part = (LAS float*)(lds + 66560);
    float vq[32], vk[32];
#pragma unroll
    for (int c = 0; c < 4; ++c) { const u32x4 uq = in.q[c], uk = in.k[c];
        vq[c * 8 + 0] = bflo(uq.x); vq[c * 8 + 1] = bfhi(uq.x); vq[c * 8 + 2] = bflo(uq.y); vq[c * 8 + 3] = bfhi(uq.y); vq[c * 8 + 4] = bflo(uq.z); vq[c * 8 + 5] = bfhi(uq.z); vq[c * 8 + 6] = bflo(uq.w); vq[c * 8 + 7] = bfhi(uq.w);
        vk[c * 8 + 0] = bflo(uk.x); vk[c * 8 + 1] = bfhi(uk.x); vk[c * 8 + 2] = bflo(uk.y); vk[c * 8 + 3] = bfhi(uk.y); vk[c * 8 + 4] = bflo(uk.z); vk[c * 8 + 5] = bfhi(uk.z); vk[c * 8 + 6] = bflo(uk.w); vk[c * 8 + 7] = bfhi(uk.w); }
    float cs[8], sn[8];
#pragma unroll
    for (int i = 0; i < 8; ++i) { cs[i] = in.cs[i]; sn[i] = in.sn[i]; }
    asm volatile("" ::: "memory");
    moba_prep_load(a, tid, unext, nxt);
#pragma unroll
    for (int which = 0; which < 2; ++which) {
        bf16_t* p = which ? (bf16_t*)(a.ws + WS_KC) + ((size_t)(b * 8 + h) * SEQ + j * 256 + tok) * 64 + half * 32 : proj + row * NCOL + CQA + h * 64 + half * 32;
        const LAS float* g = (const LAS float*)(lds + 68608) + which * 64 + half * 32;
        float v[32]; float ss = 0.f;
#pragma unroll
        for (int i = 0; i < 32; ++i) { v[i] = which ? vk[i] : vq[i]; ss += v[i] * v[i]; }
        ss += __shfl_xor(ss, 1);
        const float r = frsq(ss * (1.f / 64.f) + EPS) * (which ? 1.f : 0.125f * LOG2E);
#pragma unroll
        for (int c = 0; c < 8; ++c) { const f32x4 gg = *(const LAS f32x4*)(g + c * 4); v[c * 4] *= r * gg.x; v[c * 4 + 1] *= r * gg.y; v[c * 4 + 2] *= r * gg.z; v[c * 4 + 3] *= r * gg.w; }
        if (half == 0) {
#pragma unroll
            for (int i = 0; i < 8; ++i) { const float x1 = v[i], x2 = v[8 + i]; v[i] = x1 * cs[i] - x2 * sn[i]; v[8 + i] = x2 * cs[i] + x1 * sn[i]; }
        }
#pragma unroll
        for (int c = 0; c < 4; ++c) { u32x4 uu; uu.x = pk2(v[c * 8 + 0], v[c * 8 + 1]); uu.y = pk2(v[c * 8 + 2], v[c * 8 + 3]); uu.z = pk2(v[c * 8 + 4], v[c * 8 + 5]); uu.w = pk2(v[c * 8 + 6], v[c * 8 + 7]);
            *(u32x4*)(p + c * 8) = uu; }
        if (which == 1) {
#pragma unroll
            for (int i = 0; i < 32; ++i) kt[tok * 65 + half * 32 + i] = v[i];
        }
    }
    BAR_LDS();
    {
        const int d = tid & 63, pt = tid >> 6; float sacc = 0.f;
#pragma unroll 8
        for (int t = 0; t < 32; ++t) sacc += kt[(pt * 32 + t) * 65 + d];
        part[pt * 64 + d] = sacc;
    }
    BAR_LDS();
    if (tid < 64) { float sacc = 0.f;
#pragma unroll
        for (int p = 0; p < 8; ++p) sacc += part[p * 64 + tid];
        ((float*)(a.ws + WS_KMEAN))[((size_t)(b * 8 + h) * 8 + j) * 64 + tid] = sacc * (1.f / 256.f); }
    BAR_LDS();
}

struct HIn { u32x4 f[2], q[2], v[2]; };
template <bool NEEDQ>
__device__ __forceinline__ void hgrn_load(const Args& a, int tid, int u, HIn& r) {
    const int bh = u >> 5, c = u & 31, b = bh >> 2, hh = bh & 3; const size_t row0 = (size_t)b * SEQ + c * 64;
#pragma unroll
    for (int ii = 0; ii < 2; ++ii) { const int cid = tid + 512 * ii, t = cid >> 4, d0 = (cid & 15) * 8;
        const bf16_t* p = (const bf16_t*)(a.ws + WS_PROJ) + (row0 + t) * NCOL + hh * 128 + d0;
        r.f[ii] = *(const u32x4*)(p + CFH); r.v[ii] = *(const u32x4*)(p + CIH); if (NEEDQ) r.q[ii] = *(const u32x4*)(p + CQH); }
}
__device__ __forceinline__ void hgrn_stepA(const Args& a, int l, LAS unsigned char* lds, int tid, int hh, const HIn& in, float (&kf)[16]) {
    LAS float* LF = (LAS float*)lds;
    LAS float* PT = (LAS float*)(lds + 32768);
#pragma unroll
    for (int ii = 0; ii < 2; ++ii) {
        const int cid = tid + 512 * ii, t = cid >> 4, d0 = (cid & 15) * 8;
        const u32x4 u = in.f[ii];
        float fl[8] = {bflo(u.x), bfhi(u.x), bflo(u.y), bfhi(u.y), bflo(u.z), bfhi(u.z), bflo(u.w), bfhi(u.w)};
        float lf[8];
        const LAS float* LB = (const LAS float*)(lds + 106496) + hh * 128 + d0; const f32x4 lb0 = *(const LAS f32x4*)LB, lb1 = *(const LAS f32x4*)(LB + 4);
        const float lbv[8] = {lb0.x, lb0.y, lb0.z, lb0.w, lb1.x, lb1.y, lb1.z, lb1.w};
#pragma unroll
        for (int i = 0; i < 8; ++i) { const float lb = lbv[i]; const float sg = sigm(fl[i]);
            const float f = lb + (1.f - lb) * sg; lf[i] = __logf(f); kf[ii * 8 + i] = (1.f - lb) * (1.f - sg); }
        *(LAS f32x4*)(LF + t * 128 + d0) = (f32x4){lf[0], lf[1], lf[2], lf[3]}; *(LAS f32x4*)(LF + t * 128 + d0 + 4) = (f32x4){lf[4], lf[5], lf[6], lf[7]};
    }
}
__device__ __forceinline__ void hgrn_cumsum_scan(LAS unsigned char* lds, int tid) {
    LAS float* LF = (LAS float*)lds;
    LAS float* PT = (LAS float*)(lds + 32768);
    BAR_LDS();
    { const int d = tid & 127, pt = tid >> 7; float run = 0.f;
#pragma unroll
      for (int t = 0; t < 16; ++t) { run += LF[(pt * 16 + t) * 128 + d]; LF[(pt * 16 + t) * 128 + d] = run; }
      PT[pt * 128 + d] = run; }
    BAR_LDS();
    { const int d = tid & 127, pt = tid >> 7; float off = 0.f;
#pragma unroll
      for (int p = 0; p < 3; ++p) off += (p < pt) ? PT[p * 128 + d] : 0.f;
      if (pt > 0) {
#pragma unroll
        for (int t = 0; t < 16; ++t) LF[(pt * 16 + t) * 128 + d] += off; } }
    BAR_LDS();
}
__device__ __forceinline__ void hgrn_stage1_unit(const Args& a, int l, LAS unsigned char* lds, int tid, int u, const HIn& in, HIn& nxt, int unext) {
    const int lane = tid & 63, w = __builtin_amdgcn_readfirstlane(tid >> 6), fr = lane & 15, fq = lane >> 4;
    const int bh = u >> 5, c = u & 31, hh = bh & 3;
    LAS float* LF = (LAS float*)lds;
    LAS unsigned char* KN = lds + 34816;
    LAS unsigned char* VN = lds + 34816 + 18432;
    float kf[16];
    hgrn_stepA(a, l, lds, tid, hh, in, kf);
    hgrn_load<false>(a, tid, unext, nxt);
    hgrn_cumsum_scan(lds, tid);
    if (tid < 128) ((float*)(a.ws + WS_DECAY))[((size_t)bh * 32 + c) * 128 + tid] = fexp(LF[63 * 128 + tid]);
#pragma unroll
    for (int ii = 0; ii < 2; ++ii) {
        const int cid = tid + 512 * ii, t = cid >> 4, d0 = (cid & 15) * 8;
        const f32x4 ae0 = *(const LAS f32x4*)(LF + 63 * 128 + d0), ae1 = *(const LAS f32x4*)(LF + 63 * 128 + d0 + 4), at0 = *(const LAS f32x4*)(LF + t * 128 + d0), at1 = *(const LAS f32x4*)(LF + t * 128 + d0 + 4);
        const f32x4 e0 = ae0 - at0, e1 = ae1 - at1;
        u32x4 o; o.x = pk2(kf[ii * 8 + 0] * fexp(e0.x), kf[ii * 8 + 1] * fexp(e0.y)); o.y = pk2(kf[ii * 8 + 2] * fexp(e0.z), kf[ii * 8 + 3] * fexp(e0.w));
        o.z = pk2(kf[ii * 8 + 4] * fexp(e1.x), kf[ii * 8 + 5] * fexp(e1.y)); o.w = pk2(kf[ii * 8 + 6] * fexp(e1.z), kf[ii * 8 + 7] * fexp(e1.w));
        *(LAS u32x4*)(KN + t * 288 + d0 * 2) = o;
        *(LAS u32x4*)(VN + t * 288 + d0 * 2) = in.v[ii];
    }
    BAR_LDS();
    f32x4 acc[8];
#pragma unroll
    for (int n = 0; n < 8; ++n) acc[n] = (f32x4){0.f, 0.f, 0.f, 0.f};
#pragma unroll
    for (int ks = 0; ks < 2; ++ks) {
        const s16x4 alo = tr4(VN, 288, ks * 32 + fq * 4, w * 16, fr), ahi = tr4(VN, 288, ks * 32 + 16 + fq * 4, w * 16, fr);
        const bf16x8 af = __builtin_shufflevector(alo, ahi, 0, 1, 2, 3, 4, 5, 6, 7);
#pragma unroll
        for (int n = 0; n < 8; ++n) { const s16x4 blo = tr4(KN, 288, ks * 32 + fq * 4, n * 16, fr), bhi = tr4(KN, 288, ks * 32 + 16 + fq * 4, n * 16, fr);
            const bf16x8 bfr = __builtin_shufflevector(blo, bhi, 0, 1, 2, 3, 4, 5, 6, 7); acc[n] = MFMA16(bfr, af, acc[n]); }
    }
    bf16_t* ST = (bf16_t*)(a.ws + WS_H) + ((size_t)bh * 32 + c) * 16384;
#pragma unroll
    for (int n = 0; n < 8; ++n) { u32x2 o; o.x = pk2(acc[n][0], acc[n][1]); o.y = pk2(acc[n][2], acc[n][3]); *(u32x2*)(ST + (w * 16 + fr) * 128 + n * 16 + fq * 4) = o; }
    BAR_LDS();
}
__device__ __forceinline__ void hgrn_scan_phase(const Args& a) {
    const int id = blockIdx.x * 512 + otid(), NT = gridDim.x * 512;
    for (int it = id; it < 32 * 128 * 32; it += NT) {
        const int bh = it >> 12, dv = (it >> 5) & 127, dkc = it & 31;
        u32x2* st = (u32x2*)((bf16_t*)(a.ws + WS_H) + (size_t)bh * 32 * 16384 + dv * 128 + dkc * 4);
        const f32x4* dc = (const f32x4*)((const float*)(a.ws + WS_DECAY) + (size_t)bh * 32 * 128 + dkc * 4);
        float r0 = 0.f, r1 = 0.f, r2 = 0.f, r3 = 0.f;
#pragma unroll 8
        for (int c = 0; c < 32; ++c) {
            const u32x2 u = st[(size_t)c * 4096]; const f32x4 dd = dc[c * 32];
            u32x2 o; o.x = pk2(r0, r1); o.y = pk2(r2, r3); st[(size_t)c * 4096] = o;
            r0 = dd.x * r0 + bflo(u.x); r1 = dd.y * r1 + bfhi(u.x); r2 = dd.z * r2 + bflo(u.y); r3 = dd.w * r3 + bfhi(u.y);
        }
    }
}
__device__ __forceinline__ void hgrn_stage3_unit(const Args& a, int l, LAS unsigned char* lds, int tid, int u, const HIn& in, HIn& nxt, int unext) {
    const int lane = tid & 63, w = __builtin_amdgcn_readfirstlane(tid >> 6), fr = lane & 15, fq = lane >> 4;
    const int bh = u >> 5, c = u & 31, b = bh >> 2, hh = bh & 3; const size_t row0 = (size_t)b * SEQ + c * 64;
    const int tt = w & 3, vh = w >> 2;
    bf16_t* proj = (bf16_t*)(a.ws + WS_PROJ);
    LAS float* LF = (LAS float*)lds;
    LAS unsigned char* QM = lds + 34816;
    LAS unsigned char* Q0 = QM + 17408;
    LAS unsigned char* KM = Q0 + 17408;
    LAS unsigned char* VN = KM + 17408;
    LAS float* SSQ = (LAS float*)(VN + 18432);
    float kf[16];
    hgrn_stepA(a, l, lds, tid, hh, in, kf);
    const size_t row = row0 + tt * 16 + fr;
    const bf16_t* ST = (const bf16_t*)(a.ws + WS_H) + ((size_t)bh * 32 + c) * 16384;
    bf16x8 stf[4][4]; u32x2 zz[4];
#pragma unroll
    for (int ks = 0; ks < 4; ++ks)
#pragma unroll
        for (int v = 0; v < 4; ++v) stf[ks][v] = *(const bf16x8*)(ST + ((vh * 4 + v) * 16 + fr) * 128 + ks * 32 + fq * 8);
#pragma unroll
    for (int v = 0; v < 4; ++v) zz[v] = *(const u32x2*)(proj + row * NCOL + CZ + 512 + hh * 128 + (vh * 4 + v) * 16 + fq * 4);
    hgrn_load<true>(a, tid, unext, nxt);
    hgrn_cumsum_scan(lds, tid);
#pragma unroll
    for (int ii = 0; ii < 2; ++ii) {
        const int cid = tid + 512 * ii, t = cid >> 4, d0 = (cid & 15) * 8;
        const u32x4 uq = in.q[ii];
        float q[8] = {bflo(uq.x), bfhi(uq.x), bflo(uq.y), bfhi(uq.y), bflo(uq.z), bfhi(uq.z), bflo(uq.w), bfhi(uq.w)};
        float qm[8], q0[8], km[8];
        const f32x4 at0 = *(const LAS f32x4*)(LF + t * 128 + d0), at1 = *(const LAS f32x4*)(LF + t * 128 + d0 + 4), am0 = *(const LAS f32x4*)(LF + 31 * 128 + d0), am1 = *(const LAS f32x4*)(LF + 31 * 128 + d0 + 4);
        const float Atv[8] = {at0.x, at0.y, at0.z, at0.w, at1.x, at1.y, at1.z, at1.w}, Amv[8] = {am0.x, am0.y, am0.z, am0.w, am1.x, am1.y, am1.z, am1.w};
#pragma unroll
        for (int i = 0; i < 8; ++i) { const float At = Atv[i], Am = Amv[i]; const float sq = silu(q[i]);
            qm[i] = sq * fexp(At - Am); q0[i] = sq * fexp(At); km[i] = kf[ii * 8 + i] * fexp(Am - At); }
        u32x4 o;
        o.x = pk2(qm[0], qm[1]); o.y = pk2(qm[2], qm[3]); o.z = pk2(qm[4], qm[5]); o.w = pk2(qm[6], qm[7]); *(LAS u32x4*)(QM + t * 272 + d0 * 2) = o;
        o.x = pk2(q0[0], q0[1]); o.y = pk2(q0[2], q0[3]); o.z = pk2(q0[4], q0[5]); o.w = pk2(q0[6], q0[7]); *(LAS u32x4*)(Q0 + t * 272 + d0 * 2) = o;
        o.x = pk2(km[0], km[1]); o.y = pk2(km[2], km[3]); o.z = pk2(km[4], km[5]); o.w = pk2(km[6], km[7]); *(LAS u32x4*)(KM + t * 272 + d0 * 2) = o;
        *(LAS u32x4*)(VN + t * 288 + d0 * 2) = in.v[ii];
    }
    BAR_LDS();
    f32x4 sc[4];
#pragma unroll
    for (int s = 0; s < 4; ++s) sc[s] = (f32x4){0.f, 0.f, 0.f, 0.f};
#pragma unroll
    for (int ks = 0; ks < 4; ++ks) {
        const bf16x8 qf = *(const LAS bf16x8*)(QM + (tt * 16 + fr) * 272 + (ks * 32 + fq * 8) * 2);
#pragma unroll
        for (int s = 0; s < 4; ++s) if (s <= tt) { const bf16x8 kfr = *(const LAS bf16x8*)(KM + (s * 16 + fr) * 272 + (ks * 32 + fq * 8) * 2); sc[s] = MFMA16(kfr, qf, sc[s]); }
    }
#pragma unroll
    for (int s = 0; s < 4; ++s)
#pragma unroll
        for (int jj = 0; jj < 4; ++jj) { const bool ok = (s < tt) || (s == tt && (fq * 4 + jj) <= fr); sc[s][jj] = ok ? sc[s][jj] : 0.f; }
    f32x4 o[4];
#pragma unroll
    for (int v = 0; v < 4; ++v) o[v] = (f32x4){0.f, 0.f, 0.f, 0.f};
#pragma unroll
    for (int kst = 0; kst < 2; ++kst) {
        if (kst * 2 <= tt) {
            u32x4 pw; pw.x = pk2(sc[2 * kst][0], sc[2 * kst][1]); pw.y = pk2(sc[2 * kst][2], sc[2 * kst][3]); pw.z = pk2(sc[2 * kst + 1][0], sc[2 * kst + 1][1]); pw.w = pk2(sc[2 * kst + 1][2], sc[2 * kst + 1][3]);
            const bf16x8 pb = __builtin_bit_cast(bf16x8, pw);
#pragma unroll
            for (int v = 0; v < 4; ++v) { const s16x4 lo = tr4(VN, 288, kst * 32 + fq * 4, (vh * 4 + v) * 16, fr), hi = tr4(VN, 288, kst * 32 + 16 + fq * 4, (vh * 4 + v) * 16, fr);
                const bf16x8 vf = __builtin_shufflevector(lo, hi, 0, 1, 2, 3, 4, 5, 6, 7);
                o[v] = MFMA16(vf, pb, o[v]); }
        }
    }
#pragma unroll
    for (int ks = 0; ks < 4; ++ks) {
        const bf16x8 q0f = *(const LAS bf16x8*)(Q0 + (tt * 16 + fr) * 272 + (ks * 32 + fq * 8) * 2);
#pragma unroll
        for (int v = 0; v < 4; ++v) o[v] = MFMA16(stf[ks][v], q0f, o[v]);
    }
    float ss = 0.f;
#pragma unroll
    for (int v = 0; v < 4; ++v)
#pragma unroll
        for (int jj = 0; jj < 4; ++jj) ss += o[v][jj] * o[v][jj];
    ss += __shfl_xor(ss, 16); ss += __shfl_xor(ss, 32);
    if (fq == 0) SSQ[vh * 64 + tt * 16 + fr] = ss;
    BAR_LDS();
    const float tot = SSQ[tt * 16 + fr] + SSQ[64 + tt * 16 + fr];
    const float r = frsq(tot * (1.f / 128.f) + EPS);
#pragma unroll
    for (int v = 0; v < 4; ++v) { const int v0 = (vh * 4 + v) * 16 + fq * 4;
        const f32x4 g = *(const LAS f32x4*)((const LAS float*)(lds + 106496 + 2048) + v0);
        const u32x2 z = zz[v];
        u32x2 y; y.x = pk2(o[v][0] * r * g.x * silu(bflo(z.x)), o[v][1] * r * g.y * silu(bfhi(z.x))); y.y = pk2(o[v][2] * r * g.z * silu(bflo(z.y)), o[v][3] * r * g.w * silu(bfhi(z.y)));
        *(u32x2*)(proj + row * NCOL + CQH + hh * 128 + v0) = y; }
    BAR_LDS();
}

template <int D, int QT0>
__device__ __forceinline__ void qk_tile(const LAS unsigned char* Ks, int KP, const bf16x8 (&qf)[2][D / 32], f32x4 (&s)[4][2], int fr, int fq, float b0, float b1) {
#pragma unroll
    for (int a = 0; a < 4; ++a) { s[a][0] = (f32x4){b0, b0, b0, b0}; s[a][1] = (f32x4){b1, b1, b1, b1}; }
#pragma unroll
    for (int a = 0; a < 4; ++a)
#pragma unroll
        for (int ks = 0; ks < D / 32; ++ks) { const bf16x8 kfr = *(const LAS bf16x8*)(Ks + (a * 16 + fr) * KP + (ks * 32 + fq * 8) * 2);
            if (QT0 == 0) s[a][0] = MFMA16(kfr, qf[0][ks], s[a][0]);
            s[a][1] = MFMA16(kfr, qf[1][ks], s[a][1]); }
}
#define ONES8 ((bf16x8){16256, 16256, 16256, 16256, 16256, 16256, 16256, 16256})
template <int D, bool DIAG, int QT0>
__device__ __forceinline__ void sm_pv_tile(f32x4 (&s)[4][2], const LAS unsigned char* Vs, int VP, f32x4 (&o)[D / 16][2], f32x4 (&ol)[2], int fr, int fq, int keyl0, int qla, int qlb) {
#pragma unroll
    for (int qt = QT0; qt < 2; ++qt) {
        if (DIAG) {
            const int ql = (qt == 0 ? qla : qlb) + fr - keyl0 - fq * 4;
#pragma unroll
            for (int a = 0; a < 4; ++a)
#pragma unroll
                for (int jj = 0; jj < 4; ++jj) s[a][qt][jj] = (a * 16 + jj > ql) ? -1e30f : s[a][qt][jj];
        }
#pragma unroll
        for (int a = 0; a < 4; ++a)
#pragma unroll
            for (int jj = 0; jj < 4; ++jj) s[a][qt][jj] = ex2(s[a][qt][jj]);
    }
#pragma unroll
    for (int kst = 0; kst < 2; ++kst) {
        bf16x8 pb[2];
#pragma unroll
        for (int qt = QT0; qt < 2; ++qt) { u32x4 pw; pw.x = pk2(s[2 * kst][qt][0], s[2 * kst][qt][1]); pw.y = pk2(s[2 * kst][qt][2], s[2 * kst][qt][3]);
            pw.z = pk2(s[2 * kst + 1][qt][0], s[2 * kst + 1][qt][1]); pw.w = pk2(s[2 * kst + 1][qt][2], s[2 * kst + 1][qt][3]); pb[qt] = __builtin_bit_cast(bf16x8, pw); }
        if (QT0 == 0) ol[0] = MFMA16(ONES8, pb[0], ol[0]);
        ol[1] = MFMA16(ONES8, pb[1], ol[1]);
#pragma unroll
        for (int dt = 0; dt < D / 16; ++dt) { const s16x4 lo = tr4(Vs, VP, kst * 32 + fq * 4, dt * 16, fr), hi = tr4(Vs, VP, kst * 32 + 16 + fq * 4, dt * 16, fr);
            const bf16x8 vf = __builtin_shufflevector(lo, hi, 0, 1, 2, 3, 4, 5, 6, 7);
            if (QT0 == 0) o[dt][0] = MFMA16(vf, pb[0], o[dt][0]);
            o[dt][1] = MFMA16(vf, pb[1], o[dt][1]); }
    }
}
__device__ __forceinline__ void sm_pv_tile128(f32x4 (&sa)[4][2], f32x4 (&sb)[4][2], const LAS unsigned char* Vs, int VP, f32x4 (&o)[4][2], f32x4 (&ol)[2], int fr, int fq) {
#pragma unroll
    for (int qt = 0; qt < 2; ++qt)
#pragma unroll
        for (int a = 0; a < 4; ++a)
#pragma unroll
            for (int jj = 0; jj < 4; ++jj) { sa[a][qt][jj] = ex2(sa[a][qt][jj]); sb[a][qt][jj] = ex2(sb[a][qt][jj]); }
#pragma unroll
    for (int half = 0; half < 2; ++half)
#pragma unroll
        for (int kst = 0; kst < 2; ++kst) {
            bf16x8 pb[2];
#pragma unroll
            for (int qt = 0; qt < 2; ++qt) { const f32x4 x0 = half ? sb[2 * kst][qt] : sa[2 * kst][qt], x1 = half ? sb[2 * kst + 1][qt] : sa[2 * kst + 1][qt];
                u32x4 pw; pw.x = pk2(x0[0], x0[1]); pw.y = pk2(x0[2], x0[3]); pw.z = pk2(x1[0], x1[1]); pw.w = pk2(x1[2], x1[3]); pb[qt] = __builtin_bit_cast(bf16x8, pw); }
            ol[0] = MFMA16(ONES8, pb[0], ol[0]); ol[1] = MFMA16(ONES8, pb[1], ol[1]);
#pragma unroll
            for (int dt = 0; dt < 4; ++dt) { const s16x4 lo = tr4(Vs, VP, half * 64 + kst * 32 + fq * 4, dt * 16, fr), hi = tr4(Vs, VP, half * 64 + kst * 32 + 16 + fq * 4, dt * 16, fr);
                const bf16x8 vf = __builtin_shufflevector(lo, hi, 0, 1, 2, 3, 4, 5, 6, 7);
                o[dt][0] = MFMA16(vf, pb[0], o[dt][0]); o[dt][1] = MFMA16(vf, pb[1], o[dt][1]); }
            __builtin_amdgcn_sched_barrier(0);
        }
}
template <int D, bool DIAG, int QT0>
__device__ __forceinline__ void attn_tile(const LAS unsigned char* Ks, int KP, const LAS unsigned char* Vs, int VP, const bf16x8 (&qf)[2][D / 32], f32x4 (&o)[D / 16][2], f32x4 (&ol)[2],
                                          int fr, int fq, int keyl0, int qla, int qlb, float b0, float b1) {
    f32x4 s[4][2];
    qk_tile<D, QT0>(Ks, KP, qf, s, fr, fq, b0, b1);
    sm_pv_tile<D, DIAG, QT0>(s, Vs, VP, o, ol, fr, fq, keyl0, qla, qlb);
}

__device__ __forceinline__ void moba_unit(const Args& a, int l, LAS unsigned char* lds, int b, int h, int qb) {
    const int tid = otid(), lane = tid & 63, w = __builtin_amdgcn_readfirstlane(tid >> 6), fr = lane & 15, fq = lane >> 4;
    bf16_t* proj = (bf16_t*)(a.ws + WS_PROJ);
    LAS float* kml = (LAS float*)(lds + 77824);
    kml[tid] = ((const float*)(a.ws + WS_KMEAN))[(size_t)(b * 8 + h) * 512 + tid];
    const size_t rowbase = (size_t)b * SEQ;
    const bf16_t* Kc = (const bf16_t*)(a.ws + WS_KC) + (size_t)(b * 8 + h) * SEQ * 64; const bf16_t* Vc = (const bf16_t*)(a.ws + WS_VC) + (size_t)(b * 8 + h) * SEQ * 64;
    const int qrow[2] = {qb * 256 + w * 16, qb * 256 + (15 - w) * 16};
    bf16x8 qf[2][2];
#pragma unroll
    for (int qt = 0; qt < 2; ++qt)
#pragma unroll
        for (int ks = 0; ks < 2; ++ks) qf[qt][ks] = *(const bf16x8*)(proj + (rowbase + qrow[qt] + fr) * NCOL + CQA + h * 64 + ks * 32 + fq * 8);
    const int NT2 = (qb + 1) * 2;
    u32x4 kreg[2], vreg[2];
#define MOBA_T128(i) ((i) < 2 ? qb * 2 + (i) : (i) - 2)
#define MOBA_LOAD(t128) do { _Pragma("unroll") for (int ii = 0; ii < 2; ++ii) { const int cid = tid + 512 * ii; \
        kreg[ii] = *(const u32x4*)(Kc + (size_t)((t128) * 128) * 64 + cid * 8); \
        vreg[ii] = *(const u32x4*)(Vc + (size_t)((t128) * 128) * 64 + cid * 8); } } while (0)
#define MOBA_STORE(buf) do { _Pragma("unroll") for (int ii = 0; ii < 2; ++ii) { const int cid = tid + 512 * ii; \
        *(LAS u32x4*)(lds + (buf) * 38912 + (cid >> 3) * 144 + (cid & 7) * 16) = kreg[ii]; \
        *(LAS u32x4*)(lds + (buf) * 38912 + 18432 + (cid >> 3) * 160 + (cid & 7) * 16) = vreg[ii]; } } while (0)
    MOBA_LOAD(MOBA_T128(0));
    __syncthreads();
    unsigned selmask[2];
    if (qb <= 3) { selmask[0] = selmask[1] = (1u << qb) - 1u; }
    else {
#pragma unroll
        for (int qt = 0; qt < 2; ++qt) {
            float g[8];
#pragma unroll
            for (int j = 0; j < 8; ++j) { float psum = 0.f;
                if (j < qb) {
#pragma unroll
                    for (int ks = 0; ks < 2; ++ks)
#pragma unroll
                        for (int i = 0; i < 8; ++i) psum += bf2f(qf[qt][ks][i]) * kml[j * 64 + ks * 32 + fq * 8 + i];
                    psum += __shfl_xor(psum, 16); psum += __shfl_xor(psum, 32);
                }
                g[j] = (j < qb) ? psum : -INFINITY; }
            unsigned msk = 0u;
#pragma unroll
            for (int j = 0; j < 8; ++j) { int rank = 0;
#pragma unroll
                for (int mth = 0; mth < 8; ++mth) if (mth != j) rank += (g[mth] > g[j] || (g[mth] == g[j] && mth < j)) ? 1 : 0;
                if (j < qb && rank < 3) msk |= (1u << j); }
            selmask[qt] = msk;
        }
    }
    f32x4 o[4][2];
#pragma unroll
    for (int dt = 0; dt < 4; ++dt) { o[dt][0] = (f32x4){0.f, 0.f, 0.f, 0.f}; o[dt][1] = (f32x4){0.f, 0.f, 0.f, 0.f}; }
    float gm; { float xq = fabsf(a.mqn[l * 64 + lane]), xk = fabsf(a.mkn[l * 64 + lane]);
#pragma unroll
      for (int ofs = 1; ofs < 64; ofs <<= 1) { xq = fmaxf(xq, __shfl_xor(xq, ofs)); xk = fmaxf(xk, __shfl_xor(xk, ofs)); }
      gm = xq * xk * (8.f * 1.03f * LOG2E); }
    f32x4 ol[2] = {(f32x4){0.f, 0.f, 0.f, 0.f}, (f32x4){0.f, 0.f, 0.f, 0.f}};
    MOBA_STORE(0);
    BAR_LDS();
    for (int i = 0; i < NT2; ++i) {
        if (i + 1 < NT2) { const int tn = MOBA_T128(i + 1); MOBA_LOAD(tn); }
        const int t128 = MOBA_T128(i), j = t128 >> 1, hb = t128 & 1; const bool diag = (j == qb);
        const LAS unsigned char* Kb = lds + (i & 1) * 38912;
        const unsigned rs0 = diag ? 1u : ((selmask[0] >> j) & 1u), rs1 = diag ? 1u : ((selmask[1] >> j) & 1u);
        if (!diag) {
            f32x4 sA[4][2], sB[4][2];
            const float b0 = rs0 ? -gm : -1e30f, b1 = rs1 ? -gm : -1e30f;
            qk_tile<64, 0>(Kb, 144, qf, sA, fr, fq, b0, b1);
            qk_tile<64, 0>(Kb + 64 * 144, 144, qf, sB, fr, fq, b0, b1);
            sm_pv_tile128(sA, sB, Kb + 18432, 160, o, ol, fr, fq);
        } else
#pragma unroll
        for (int sub = 0; sub < 2; ++sub) {
            const int ktl = hb * 2 + sub;
            if (diag) {
                if (ktl <= (w >> 2)) attn_tile<64, true, 0>(Kb + sub * 64 * 144, 144, Kb + 18432 + sub * 64 * 160, 160, qf, o, ol, fr, fq, ktl * 64, w * 16, (15 - w) * 16, -gm, -gm);
                else if (ktl <= ((15 - w) >> 2)) attn_tile<64, true, 1>(Kb + sub * 64 * 144, 144, Kb + 18432 + sub * 64 * 160, 160, qf, o, ol, fr, fq, ktl * 64, w * 16, (15 - w) * 16, -gm, -gm);
            } else attn_tile<64, false, 0>(Kb + sub * 64 * 144, 144, Kb + 18432 + sub * 64 * 160, 160, qf, o, ol, fr, fq, 0, 0, 0, rs0 ? -gm : -1e30f, rs1 ? -gm : -1e30f);
        }
        if (i + 1 < NT2) MOBA_STORE((i + 1) & 1);
        BAR_LDS();
    }
#undef MOBA_T128
#undef MOBA_LOAD
#undef MOBA_STORE
#pragma unroll
    for (int qt = 0; qt < 2; ++qt) {
        const float inv = frcp(ol[qt][0]);
        const size_t row = rowbase + qrow[qt] + fr;
#pragma unroll
        for (int dt = 0; dt < 4; ++dt) { const int d0 = dt * 16 + fq * 4;
            const u32x2 z = *(const u32x2*)(proj + row * NCOL + CZ + h * 64 + d0);
            u32x2 y; y.x = pk2(o[dt][qt][0] * inv * silu(bflo(z.x)), o[dt][qt][1] * inv * silu(bfhi(z.x))); y.y = pk2(o[dt][qt][2] * inv * silu(bflo(z.y)), o[dt][qt][3] * inv * silu(bfhi(z.y)));
            *(u32x2*)(proj + row * NCOL + CQA + h * 64 + d0) = y; }
    }
    __syncthreads();
}

__device__ __forceinline__ void mem_unit(const Args& a, int l, LAS unsigned char* lds, int b, int hm, int qb) {
    const int tid = otid(), lane = tid & 63, w = __builtin_amdgcn_readfirstlane(tid >> 6), fr = lane & 15, fq = lane >> 4;
    bf16_t* proj = (bf16_t*)(a.ws + WS_PROJ);
    const bf16_t* kvm = (const bf16_t*)(a.ws + WS_KVM) + (size_t)b * MEML * 1024;
    const size_t rowbase = (size_t)b * SEQ; const int q0 = qb * 256 + w * 32;
    u32x4 ukr[2], uvr[2];
#define MEM_LOAD(kt) do { _Pragma("unroll") for (int ii = 0; ii < 2; ++ii) { const int cid = tid + 512 * ii; \
        ukr[ii] = *(const u32x4*)(kvm + (size_t)((kt) * 64 + (cid >> 4)) * 1024 + hm * 128 + (cid & 15) * 8); \
        uvr[ii] = *(const u32x4*)(kvm + (size_t)((kt) * 64 + (cid >> 4)) * 1024 + 512 + hm * 128 + (cid & 15) * 8); } } while (0)
    const f32x4 g0 = *(const f32x4*)(a.memkn + l * 128 + (tid & 15) * 8), g1 = *(const f32x4*)(a.memkn + l * 128 + (tid & 15) * 8 + 4);
    MEM_LOAD(0);
    bf16x8 qf[2][4];
#pragma unroll
    for (int qt = 0; qt < 2; ++qt) {
        u32x4 u[4]; float ss = 0.f;
#pragma unroll
        for (int ks = 0; ks < 4; ++ks) { u[ks] = *(const u32x4*)(proj + (rowbase + q0 + qt * 16 + fr) * NCOL + CQM + hm * 128 + ks * 32 + fq * 8);
            ss += bflo(u[ks].x) * bflo(u[ks].x) + bfhi(u[ks].x) * bfhi(u[ks].x) + bflo(u[ks].y) * bflo(u[ks].y) + bfhi(u[ks].y) * bfhi(u[ks].y)
                + bflo(u[ks].z) * bflo(u[ks].z) + bfhi(u[ks].z) * bfhi(u[ks].z) + bflo(u[ks].w) * bflo(u[ks].w) + bfhi(u[ks].w) * bfhi(u[ks].w); }
        ss += __shfl_xor(ss, 16); ss += __shfl_xor(ss, 32);
        const float r = frsq(ss * (1.f / 128.f) + EPS) * (0.08838834764831845f * LOG2E);
#pragma unroll
        for (int ks = 0; ks < 4; ++ks) { const float* g = a.memqn + l * 128 + ks * 32 + fq * 8; const f32x4 g0 = *(const f32x4*)g, g1 = *(const f32x4*)(g + 4);
            u32x4 o; o.x = pk2(bflo(u[ks].x) * r * g0.x, bfhi(u[ks].x) * r * g0.y); o.y = pk2(bflo(u[ks].y) * r * g0.z, bfhi(u[ks].y) * r * g0.w);
            o.z = pk2(bflo(u[ks].z) * r * g1.x, bfhi(u[ks].z) * r * g1.y); o.w = pk2(bflo(u[ks].w) * r * g1.z, bfhi(u[ks].w) * r * g1.w);
            qf[qt][ks] = __builtin_bit_cast(bf16x8, o); }
    }
    f32x4 o[8][2];
#pragma unroll
    for (int dt = 0; dt < 8; ++dt) { o[dt][0] = (f32x4){0.f, 0.f, 0.f, 0.f}; o[dt][1] = (f32x4){0.f, 0.f, 0.f, 0.f}; }
    float gm; { float xq = fmaxf(fabsf(a.memqn[l * 128 + lane]), fabsf(a.memqn[l * 128 + 64 + lane])), xk = fmaxf(fabsf(a.memkn[l * 128 + lane]), fabsf(a.memkn[l * 128 + 64 + lane]));
#pragma unroll
      for (int ofs = 1; ofs < 64; ofs <<= 1) { xq = fmaxf(xq, __shfl_xor(xq, ofs)); xk = fmaxf(xk, __shfl_xor(xk, ofs)); }
      gm = xq * xk * (11.3137085f * 1.03f * LOG2E); }
    f32x4 ol[2] = {(f32x4){0.f, 0.f, 0.f, 0.f}, (f32x4){0.f, 0.f, 0.f, 0.f}};
    LAS unsigned char* Ks = lds;
    LAS unsigned char* Vs = lds + 17408;
#define MEM_STORE(buf) do { _Pragma("unroll") for (int ii = 0; ii < 2; ++ii) { \
            const int cid = tid + 512 * ii, key = cid >> 4, dc = cid & 15; \
            const u32x4 uk = ukr[ii]; \
            float kv[8] = {bflo(uk.x), bfhi(uk.x), bflo(uk.y), bfhi(uk.y), bflo(uk.z), bfhi(uk.z), bflo(uk.w), bfhi(uk.w)}; \
            float ss = 0.f; \
            _Pragma("unroll") for (int i = 0; i < 8; ++i) ss += kv[i] * kv[i]; \
            ss += __shfl_xor(ss, 1); ss += __shfl_xor(ss, 2); ss += __shfl_xor(ss, 4); ss += __shfl_xor(ss, 8); \
            const float r = frsq(ss * (1.f / 128.f) + EPS); \
            u32x4 ok; ok.x = pk2(kv[0] * r * g0.x, kv[1] * r * g0.y); ok.y = pk2(kv[2] * r * g0.z, kv[3] * r * g0.w); ok.z = pk2(kv[4] * r * g1.x, kv[5] * r * g1.y); ok.w = pk2(kv[6] * r * g1.z, kv[7] * r * g1.w); \
            *(LAS u32x4*)(Ks + (buf) * 35840 + key * 272 + dc * 16) = ok; \
            *(LAS u32x4*)(Vs + (buf) * 35840 + key * 288 + dc * 16) = uvr[ii]; } } while (0)
    MEM_STORE(0);
    BAR_LDS();
    for (int kt = 0; kt < 4; ++kt) {
        if (kt < 3) MEM_LOAD(kt + 1);
        attn_tile<128, false, 0>(Ks + (kt & 1) * 35840, 272, Vs + (kt & 1) * 35840, 288, qf, o, ol, fr, fq, 0, 0, 0, -gm, -gm);
        if (kt < 3) MEM_STORE((kt + 1) & 1);
        BAR_LDS();
    }
#undef MEM_STORE
#undef MEM_LOAD
#pragma unroll
    for (int qt = 0; qt < 2; ++qt) {
        const float inv = frcp(ol[qt][0]);
        const size_t row = rowbase + q0 + qt * 16 + fr;
#pragma unroll
        for (int dt = 0; dt < 8; ++dt) { const int d0 = dt * 16 + fq * 4;
            const u32x2 z = *(const u32x2*)(proj + row * NCOL + CZ + 1024 + hm * 128 + d0);
            u32x2 y; y.x = pk2(o[dt][qt][0] * inv * silu(bflo(z.x)), o[dt][qt][1] * inv * silu(bfhi(z.x))); y.y = pk2(o[dt][qt][2] * inv * silu(bflo(z.y)), o[dt][qt][3] * inv * silu(bfhi(z.y)));
            *(u32x2*)(proj + row * NCOL + CQM + hm * 128 + d0) = y; }
    }
}

#define XB_TMO      128
#define XB_XCNT(j)  (256  + 64 * (j))
#define XB_XSUB(j)  (1280 + 64 * (j))
#define XB_XGEN(j)  (2304 + 64 * (j))
#define XB_TOP      3328
#define XB_TOPGEN   3392
#define XCD_BAR_WORDS 3456
#define XB_SPIN_CAP (1u << 18)
__device__ __forceinline__ unsigned xb_ld(unsigned* p)              { return __hip_atomic_load(p, __ATOMIC_RELAXED, __HIP_MEMORY_SCOPE_AGENT); }
__device__ __forceinline__ unsigned xb_add(unsigned* p, unsigned v) { return __hip_atomic_fetch_add(p, v, __ATOMIC_RELAXED, __HIP_MEMORY_SCOPE_AGENT); }
__device__ __forceinline__ unsigned xb_xcc_id() { return (unsigned)__builtin_amdgcn_s_getreg((3 << 11) | 20) & 0xFu; }
#define XB_SPIN(cond, bar) do { unsigned _sp = 0; while (cond) { __builtin_amdgcn_s_sleep(1); \
    if ((++_sp & 255u) == 0u) { if (xb_ld(&(bar)[XB_TMO])) break; if (_sp > XB_SPIN_CAP) { atomicAdd(&(bar)[XB_TMO], 1u); break; } } } } while (0)
struct XcdBarrier { unsigned* bar; unsigned x; volatile LAS unsigned* st; };
__device__ __forceinline__ XcdBarrier xcd_barrier_post(unsigned* bar, volatile LAS unsigned* st) {
    XcdBarrier b; b.bar = bar; b.x = xb_xcc_id(); b.st = st;
    if (threadIdx.x == 0) (void)xb_add(&bar[XB_XCNT(b.x)], 1u);
    return b;
}
__device__ __forceinline__ void xcd_barrier_complete(unsigned* bar, unsigned x, unsigned& nloc, unsigned& nx) {
    const unsigned G = gridDim.x * gridDim.y * gridDim.z;
    unsigned sum, cnt, mine, sp = 0u;
    for (;;) {
        sum = 0u; cnt = 0u; mine = 0u;
#pragma unroll
        for (unsigned j = 0; j < 16; ++j) { const unsigned c = xb_ld(&bar[XB_XCNT(j)]); sum += c; cnt += (c > 0u) ? 1u : 0u; mine = (j == x) ? c : mine; }
        if (sum == G) break;
        __builtin_amdgcn_s_sleep(1);
        if ((++sp & 255u) == 0u) { if (xb_ld(&bar[XB_TMO])) break; if (sp > XB_SPIN_CAP) { atomicAdd(&bar[XB_TMO], 1u); break; } }
    }
    nloc = mine > 0u ? mine : 1u; nx = cnt > 0u ? cnt : 1u;
}
__device__ __forceinline__ void xcd_barrier(const XcdBarrier& b) {
    asm volatile("s_waitcnt vmcnt(0)" ::: "memory");
    __syncthreads();
    if (threadIdx.x == 0) {
        unsigned* bar = b.bar;
        __builtin_amdgcn_s_waitcnt(0);
        unsigned nloc = b.st[0], nx = b.st[1];
        if (nloc == 0u) { xcd_barrier_complete(bar, b.x, nloc, nx); b.st[0] = nloc; b.st[1] = nx; }
        const unsigned old = xb_add(&bar[XB_XSUB(b.x)], 1u);
        const unsigned gen = old / nloc;
        if (old + 1u == (gen + 1u) * nloc) {
            __builtin_amdgcn_fence(__ATOMIC_RELEASE, "agent");
            asm volatile("s_waitcnt vmcnt(0)" ::: "memory");
            const unsigned og = xb_add(&bar[XB_TOP], 1u);
            const unsigned tg = og / nx;
            if (og + 1u == (tg + 1u) * nx) xb_add(&bar[XB_TOPGEN], 1u);
            else XB_SPIN(xb_ld(&bar[XB_TOPGEN]) == tg, bar);
            __builtin_amdgcn_fence(__ATOMIC_ACQUIRE, "agent");
            xb_add(&bar[XB_XGEN(b.x)], 1u);
            asm volatile("s_waitcnt vmcnt(0)" ::: "memory");
        } else {
            XB_SPIN(xb_ld(&bar[XB_XGEN(b.x)]) == gen, bar);
            __builtin_amdgcn_fence(__ATOMIC_ACQUIRE, "agent");
            asm volatile("s_waitcnt vmcnt(0)" ::: "memory");
        }
    }
    __syncthreads();
}

__global__ void __launch_bounds__(512) hymba_fwd(Args a) {
    extern __shared__ __attribute__((aligned(16))) unsigned char lds_raw[];
    LAS unsigned char* lds = (LAS unsigned char*)lds_raw;
    const int G = gridDim.x, bx = blockIdx.x;
    const int lo = a.ph_lo, hi = a.ph_hi;
    bf16_t* proj = (bf16_t*)(a.ws + WS_PROJ);
#define IN(k) (lo <= (k) && (k) < hi)
#define SEAM(k) do { if (IN(k) && IN((k) + 1)) { if (a.pad == 0x5eed) cg::this_grid().sync(); xcd_barrier(xbar); } } while (0)
    volatile LAS unsigned* xst = (volatile LAS unsigned*)(lds + LDS_BYTES - 16);
    if (threadIdx.x < 2) xst[threadIdx.x] = 0u;
    __syncthreads();
    XcdBarrier xbar; xbar.bar = (unsigned*)(a.ws + WS_BAR); xbar.x = 0; xbar.st = xst;
    if (hi - lo > 1) xbar = xcd_barrier_post((unsigned*)(a.ws + WS_BAR), xst);
    if (IN(0)) { p0_phase(a, lds); __syncthreads(); }
    SEAM(0);
#pragma unroll 1
    for (int l = 0; l < 2; ++l) {
        const int base = 1 + 5 * l;
        if (IN(base)) {
            {
            pg8::Gemm g{(const bf16_t*)(a.ws + WS_H), (const bf16_t*)(a.ws + WS_WIN) + (size_t)l * NIN * DM, NTOK, NIN, DM, DM};
            pg8::StaticOrder S; S.init(NTOK, NIN, G, bx);
            pg8::EpiBf16Scale E{proj, NCOL, (bf16_t*)(a.ws + WS_KC), (bf16_t*)(a.ws + WS_VC)};
            if (G == 256) {
                pg8::Unit u0; if (S.next(0, u0) && threadIdx.x < 256) { const float* rss = (const float*)(a.ws + WS_RSS) + u0.pm * 256 + threadIdx.x;
                    ((LAS float*)(lds + 131072))[threadIdx.x] = frsq(((rss[0] + rss[NTOK]) + (rss[2 * NTOK] + rss[3 * NTOK])) * (1.f / 1024.f) + EPS); }
                __syncthreads();
                pg8::gemm_phase<pg8::EpiBf16Scale, pg8::StaticOrder>(lds, g, S, E);
            } else {
                for (int i = 0; ; ++i) { pg8::Unit u0; if (!S.next(i, u0)) break;
                    if (threadIdx.x < 256) { const float* rss = (const float*)(a.ws + WS_RSS) + u0.pm * 256 + threadIdx.x;
                        ((LAS float*)(lds + 131072))[threadIdx.x] = frsq(((rss[0] + rss[NTOK]) + (rss[2 * NTOK] + rss[3 * NTOK])) * (1.f / 1024.f) + EPS); }
                    __syncthreads();
                    pg8::StaticOrder S1; S1.init(NTOK, NIN, 1 << 30, i * G + bx);
                    pg8::gemm_phase<pg8::EpiBf16Scale, pg8::StaticOrder>(lds, g, S1, E); __syncthreads(); }
            }
            __syncthreads();
            }
        }
        SEAM(base);
        if (IN(base + 1)) {
            const int NKV = (G >= 64) ? 32 : 0;
            {
            {
                pg8::Gemm g{(const bf16_t*)(a.ws + (l ? WS_MEMH1 : WS_MEMH)), (const bf16_t*)(a.ws + WS_WMEM) + (size_t)l * DM * DM, NMEM, 1024, DM, DM};
                pg8::StaticOrder S; S.init(NMEM, 1024, G, bx);
                pg8::EpiBf16 E{(bf16_t*)(a.ws + WS_KVM), 1024};
                pg8::gemm_phase<pg8::EpiBf16, pg8::StaticOrder>(lds, g, S, E);
                __syncthreads();
            }
            if (bx >= NKV) {
                const int wb = bx - NKV, WG = G - NKV;
                const int tid = otid();
                if (tid < 128) ((LAS float*)(lds + 68608))[tid] = (tid < 64) ? a.mqn[l * 64 + tid] : a.mkn[l * 64 + tid - 64];
                if (tid < 512) ((LAS float*)(lds + 106496))[tid] = ((const float*)(a.ws + WS_LB))[l * 512 + tid];
                __syncthreads();
                { PrepIn cur; int u = wb; moba_prep_load(a, tid, u < 512 ? u : 0, cur);
                  for (; u < 512; u += WG) { PrepIn nxt; moba_prep_unit(a, l, lds, tid, u, cur, nxt, (u + WG < 512) ? u + WG : u); cur = nxt; } }
                { HIn cur; int u = (wb + 160) % WG;     hgrn_load<false>(a, tid, u < 1024 ? u : 0, cur);
                  for (; u < 1024; u += WG) { HIn nxt; hgrn_stage1_unit(a, l, lds, tid, u, cur, nxt, (u + WG < 1024) ? u + WG : u); cur = nxt; } }
                __syncthreads();
            }
            }
        }
        SEAM(base + 1);
        if (IN(base + 2)) {
            {
                for (int u = bx; u < 512; u += G) {
                    int bh, qb; if (G == 256) { bh = bx >> 2; const int s = bx & 3; qb = (u < 256) ? 7 - s : s; } else { bh = u >> 3; qb = 7 - (u & 7); }
                    moba_unit(a, l, lds, bh >> 3, bh & 7, qb);
                }
            }
            for (int u = bx; u < 256; u += G) mem_unit(a, l, lds, u >> 5, (u >> 3) & 3, u & 7);
            hgrn_scan_phase(a);
            __syncthreads();
        }
        SEAM(base + 2);
        if (IN(base + 3)) {
            { const int tid = otid();
              if (tid < 512) ((LAS float*)(lds + 106496))[tid] = ((const float*)(a.ws + WS_LB))[l * 512 + tid];
              if (tid < 128) ((LAS float*)(lds + 106496 + 2048))[tid] = a.hon[l * 128 + tid];
              __syncthreads();
              HIn cur; int u = bx; hgrn_load<true>(a, tid, u < 1024 ? u : 0, cur);
                for (; u < 1024; u += G) { HIn nxt; hgrn_stage3_unit(a, l, lds, tid, u, cur, nxt, (u + G < 1024) ? u + G : u); cur = nxt; } }
            __syncthreads();
        }
        SEAM(base + 3);
        if (IN(base + 4)) {
            pg8::Gemm g{proj, (const bf16_t*)(a.ws + WS_WOUT) + (size_t)l * DM * DMIX, NTOK, DM, DMIX, NCOL};
            pg8::StaticOrder S; S.init(NTOK, DM, G, bx);
            if (l == 0) { {
                pg8::EpiResF32Norm E{a.x, a.out, DM, a.norm_g + DM, (bf16_t*)(a.ws + WS_H), (float*)(a.ws + WS_RSS)};
                pg8::gemm_phase<pg8::EpiResF32Norm, pg8::StaticOrder>(lds, g, S, E); __syncthreads(); } }
            else { pg8::EpiResF32 E{(const float*)a.out, a.out, DM};
                pg8::gemm_phase<pg8::EpiResF32, pg8::StaticOrder>(lds, g, S, E); __syncthreads(); }
        }
        if (l == 0) SEAM(base + 4);
    }
#undef IN
#undef SEAM
}

extern "C" void kernel_launch(void* const* d_in, const int* in_sizes, int n_in, void* d_out, int out_size, void* d_ws, size_t ws_size, hipStream_t stream) {
    static int grid = 0;
    if (grid == 0) {
        if (n_in != 14 || out_size != NTOK * DM || ws_size < WS_BAR + 65536) { fprintf(stderr, "kernel_launch: unexpected shapes (n_in %d out %d ws %zu)\n", n_in, out_size, ws_size); grid = -1; return; }
        int dev = 0, cus = 0, per_cu = 0;
        hipGetDevice(&dev); hipDeviceGetAttribute(&cus, hipDeviceAttributeMultiprocessorCount, dev);
        if (hipFuncSetAttribute((const void*)hymba_fwd, hipFuncAttributeMaxDynamicSharedMemorySize, LDS_BYTES) != hipSuccess) { fprintf(stderr, "kernel_launch: hipFuncSetAttribute failed\n"); grid = -1; return; }
        if (hipOccupancyMaxActiveBlocksPerMultiprocessor(&per_cu, (const void*)hymba_fwd, 512, LDS_BYTES) != hipSuccess || per_cu < 1) { fprintf(stderr, "kernel_launch: occupancy query says %d\n", per_cu); per_cu = 1; }
        (void)hipGetLastError();
        grid = cus * (per_cu > 1 ? 1 : per_cu);
    }
    if (grid < 0) return;
    if (hipMemsetAsync((char*)d_ws + WS_BAR, 0, XCD_BAR_WORDS * 4, stream) != hipSuccess) { fprintf(stderr, "kernel_launch: memset failed\n"); return; }
    Args a{};
    a.x = (const float*)d_in[0]; a.mem = (const float*)d_in[1]; a.pos = (const int*)d_in[2]; a.norm_g = (const float*)d_in[3]; a.w_in = (const float*)d_in[4]; a.w_out = (const float*)d_in[5];
    a.mqn = (const float*)d_in[6]; a.mkn = (const float*)d_in[7]; a.lbl = (const float*)d_in[8]; a.hon = (const float*)d_in[9]; a.mng = (const float*)d_in[10]; a.wmem = (const float*)d_in[11];
    a.memqn = (const float*)d_in[12]; a.memkn = (const float*)d_in[13]; a.out = (float*)d_out; a.ws = (unsigned char*)d_ws; a.rep = 0;
#if MK_ONE_LAUNCH
    a.ph_lo = 0; a.ph_hi = NPHASE;
    void* args[] = {&a};
    hipError_t e = hipLaunchCooperativeKernel((const void*)hymba_fwd, dim3(grid), dim3(512), args, LDS_BYTES, stream);
    if (e != hipSuccess) fprintf(stderr, "cooperative launch failed: %s (grid %d)\n", hipGetErrorString(e), grid);
#else
    for (int p = 0; p < NPHASE; ++p) { a.ph_lo = p; a.ph_hi = p + 1; hipLaunchKernelGGL(hymba_fwd, dim3(grid), dim3(512), LDS_BYTES, stream, a); }
#endif
}
```

```cpp
#include <hip/hip_runtime.h>
#include <hip/hip_cooperative_groups.h>
#include <cstdio>
#include <cstdint>
namespace cg = cooperative_groups;

#ifndef MK_ONE_LAUNCH
#define MK_ONE_LAUNCH 1
#endif

#define LAS __attribute__((address_space(3)))
typedef unsigned short bf16_t;
typedef short bf16x8 __attribute__((ext_vector_type(8)));
typedef short s16x4 __attribute__((ext_vector_type(4)));
typedef float f32x4 __attribute__((ext_vector_type(4)));
typedef unsigned u32x4 __attribute__((ext_vector_type(4)));
typedef unsigned u32x2 __attribute__((ext_vector_type(2)));

constexpr int NB = 8, SEQ = 2048, DM = 1024, NTOK = NB * SEQ, MEML = 256, NMEM = NB * MEML, NCOL = 4096  , NIN = 5120  , DMIX = 1536;
constexpr int CQA = 0, CQH = 512, CQM = 1024, CZ = 1536, CFH = 3072, CIH = 3584;
constexpr float EPS = 1e-6f;
constexpr float LOG2E = 1.4426950408889634f;
constexpr size_t MiB = 1u << 20;
constexpr size_t WS_WIN = 0, WS_WOUT = 20 * MiB, WS_WMEM = 26 * MiB, WS_H = 30 * MiB  , WS_MEMH = 62 * MiB, WS_KVM = 66 * MiB,
                 WS_PROJ = 70 * MiB, WS_KC = 198 * MiB, WS_VC = 214 * MiB, WS_VT = 230 * MiB, WS_KMEAN = 246 * MiB, WS_DECAY = 246 * MiB + 128 * 1024, WS_ROPE = 247 * MiB, WS_END = 248 * MiB, WS_MEMH1 = 230 * MiB  , WS_RSS = 250 * MiB  , WS_LB = 251 * MiB  , WS_BAR = 252 * MiB  ;
constexpr int LDS_BYTES = 147456;
constexpr int NPHASE = 11;

struct Args {
    const float *x, *mem; const int* pos; const float *norm_g, *w_in, *w_out, *mqn, *mkn, *lbl, *hon, *mng, *wmem, *memqn, *memkn;
    float* out; unsigned char* ws; int ph_lo, ph_hi, rep, pad;
};

typedef float f32x2_t __attribute__((ext_vector_type(2))); typedef __bf16 bf16x2_t __attribute__((ext_vector_type(2)));
__device__ __forceinline__ unsigned pk2(float lo, float hi) { f32x2_t v = {lo, hi}; bf16x2_t b = __builtin_convertvector(v, bf16x2_t); return __builtin_bit_cast(unsigned, b); }
__device__ __forceinline__ unsigned f2bf(float f) { return pk2(f, 0.f) & 0xffffu; }
__device__ __forceinline__ float bflo(unsigned u) { return __uint_as_float(u << 16); }
__device__ __forceinline__ float bfhi(unsigned u) { return __uint_as_float(u & 0xffff0000u); }
__device__ __forceinline__ float bf2f(short s) { return __uint_as_float(((unsigned)(unsigned short)s) << 16); }
__device__ __forceinline__ float wave_sum(float v) {
#pragma unroll
    for (int o = 1; o < 64; o <<= 1) v += __shfl_xor(v, o);
    return v;
}
__device__ __forceinline__ float ex2(float x) { return __builtin_amdgcn_exp2f(x); }
__device__ __forceinline__ float fexp(float x) { return __builtin_amdgcn_exp2f(x * LOG2E); }
__device__ __forceinline__ float frcp(float x) { return __builtin_amdgcn_rcpf(x); }
__device__ __forceinline__ float frsq(float x) { return __builtin_amdgcn_rsqf(x); }
__device__ __forceinline__ float sigm(float x) { return frcp(1.f + fexp(-x)); }
__device__ __forceinline__ float silu(float x) { return x * frcp(1.f + fexp(-x)); }
#define LDS_WAIT() asm volatile("s_waitcnt lgkmcnt(0)" ::: "memory")
__device__ __forceinline__ int otid() { int t = threadIdx.x; asm volatile("" : "+v"(t)); return t; }
typedef short v4i16_t __attribute__((ext_vector_type(4)));
__device__ __forceinline__ s16x4 tr4(const LAS unsigned char* base, int pitch, int r0, int c0, int lane) {
    const int q = (lane & 15) >> 2, p = lane & 3;
    return __builtin_bit_cast(s16x4, __builtin_amdgcn_ds_read_tr16_b64_v4i16((LAS v4i16_t*)(base + (r0 + q) * pitch + (c0 + 4 * p) * 2)));
}
#define MFMA16(a, b, c) __builtin_amdgcn_mfma_f32_16x16x32_bf16((a), (b), (c), 0, 0, 0)

namespace pg8 {
constexpr int BM = 256, BK = 64, HALF = 128, HTB = HALF * BK * 2, NXCD = 8, WGM = 8;
__host__ __device__ __forceinline__ int lds_byte(int r, int c) { const int st = (r >> 4) * 2 + (c >> 5), rr = r & 15, cc = c & 31, ob = rr * 64 + cc * 2; return st * 1024 + (ob ^ (((ob >> 9) & 1) << 5)); }
__host__ __device__ __forceinline__ void stage_rc(int b, int& R, int& C) { const int st = b / 1024, sb = b % 1024, swz = sb ^ (((sb >> 9) & 1) << 5); R = (st >> 1) * 16 + swz / 64; C = (st & 1) * 32 + (swz % 64) / 2; }
__host__ __device__ __forceinline__ int perm32(int rho) { const int n = rho >> 4, i = rho & 15; return 8 * (i >> 2) + 4 * n + (i & 3); }
struct Unit { int pm, pn; };
struct Gemm { const bf16_t* A; const bf16_t* Bt; int M, N, K, lda; };
struct StaticOrder {
    int nM, nN, nwg, G, c;
    __device__ void init(int M, int N, int G_, int c_) { nM = M / BM; nN = N / BM; nwg = nM * nN; G = G_; c = c_; }
    __device__ bool next(int i, Unit& u) const {
        const long L = (long)i * G + c; if (L >= nwg) return false;
        int wgid = (int)L; { const int q = nwg / NXCD, r = nwg % NXCD, xcd = wgid % NXCD, off = wgid / NXCD; wgid = (xcd < r ? xcd * (q + 1) : r * (q + 1) + (xcd - r) * q) + off; }
        const int nig = WGM * nN, gid = wgid / nig, fm = gid * WGM, gsz = (nM - fm) < WGM ? (nM - fm) : WGM;
        u.pm = fm + ((wgid % nig) % gsz); u.pn = (wgid % nig) / gsz; return true;
    }
};
__device__ __forceinline__ unsigned cvt_pk_bf16(float lo, float hi) { unsigned r; asm volatile("v_cvt_pk_bf16_f32 %0, %1, %2" : "=v"(r) : "v"(lo), "v"(hi)); return r; }
struct EpiBf16 {
    static constexpr bool PERM = true;
    bf16_t* O; int ldc;
    __device__ __forceinline__ void operator()(const f32x4 (&acc)[2][2][4][2], const Unit& u, int wr, int wc, int fr, int fq, LAS unsigned char*) const {
        const int row0 = u.pm * BM + wr * 64 + fr; const int col0 = u.pn * BM + wc * 32 + 8 * fq;
#pragma unroll
        for (int ai = 0; ai < 2; ++ai)
#pragma unroll
            for (int m = 0; m < 4; ++m) { bf16_t* rowp = O + (size_t)(row0 + ai * HALF + m * 16) * ldc + col0;
#pragma unroll
                for (int bj = 0; bj < 2; ++bj) { const f32x4 v0 = acc[ai][bj][m][0], v1 = acc[ai][bj][m][1];
                    u32x4 w; w.x = cvt_pk_bf16(v0[0], v0[1]); w.y = cvt_pk_bf16(v0[2], v0[3]); w.z = cvt_pk_bf16(v1[0], v1[1]); w.w = cvt_pk_bf16(v1[2], v1[3]);
                    *(u32x4*)(rowp + bj * HALF) = w; } }
    }
};
struct EpiBf16Scale {
    static constexpr bool PERM = true;
    bf16_t* O; int ldc; bf16_t* Kc; bf16_t* Vc;
    __device__ __forceinline__ void operator()(const f32x4 (&acc)[2][2][4][2], const Unit& u, int wr, int wc, int fr, int fq, LAS unsigned char* lds) const {
        const int row0 = u.pm * BM + wr * 64 + fr; const int col0 = u.pn * BM + wc * 32 + 8 * fq;
        const LAS float* rtab = (const LAS float*)(lds + 131072);
        const bool compact = u.pn >= 16;
#pragma unroll
        for (int ai = 0; ai < 2; ++ai)
#pragma unroll
            for (int m = 0; m < 4; ++m) { const int row = row0 + ai * HALF + m * 16;
                const float r = rtab[ai * HALF + wr * 64 + m * 16 + fr];
#pragma unroll
                for (int bj = 0; bj < 2; ++bj) { const f32x4 v0 = acc[ai][bj][m][0] * r, v1 = acc[ai][bj][m][1] * r;
                    u32x4 w; w.x = cvt_pk_bf16(v0[0], v0[1]); w.y = cvt_pk_bf16(v0[2], v0[3]); w.z = cvt_pk_bf16(v1[0], v1[1]); w.w = cvt_pk_bf16(v1[2], v1[3]);
                    bf16_t* dst;
                    if (compact) { const int cc = col0 + bj * HALF - 4096, hc = cc & 511, hh = hc >> 6, d = hc & 63;
                        dst = ((cc >> 9) ? Vc : Kc) + ((size_t)((row >> 11) * 8 + hh) * 2048 + (row & 2047)) * 64 + d; }
                    else dst = O + (size_t)row * ldc + col0 + bj * HALF;
                    *(u32x4*)dst = w; } }
    }
};
struct EpiResF32Norm {
    static constexpr bool PERM = true;
    const float* res; float* O; int ldc; const float* g; bf16_t* H; float* rss;
    __device__ __forceinline__ void operator()(const f32x4 (&acc)[2][2][4][2], const Unit& u, int wr, int wc, int fr, int fq, LAS unsigned char* lds) const {
        const int row0 = u.pm * BM + wr * 64 + fr; const int col0 = u.pn * BM + wc * 32 + 8 * fq;
        LAS float* part = (LAS float*)(lds + 131072);
        f32x4 gg[2][2];
#pragma unroll
        for (int bj = 0; bj < 2; ++bj)
#pragma unroll
            for (int n = 0; n < 2; ++n) gg[bj][n] = *(const f32x4*)(g + col0 + bj * HALF + 4 * n);
#pragma unroll
        for (int ai = 0; ai < 2; ++ai)
#pragma unroll
            for (int m = 0; m < 4; ++m) { const size_t ro = (size_t)(row0 + ai * HALF + m * 16) * ldc + col0; float ssq = 0.f;
#pragma unroll
                for (int bj = 0; bj < 2; ++bj) { const size_t o = ro + bj * HALF;
                    const f32x4 r0 = *(const f32x4*)(res + o), r1 = *(const f32x4*)(res + o + 4);
                    const f32x4 x0 = r0 + acc[ai][bj][m][0], x1 = r1 + acc[ai][bj][m][1];
                    *(f32x4*)(O + o) = x0; *(f32x4*)(O + o + 4) = x1;
                    u32x4 hb; hb.x = cvt_pk_bf16(x0[0] * gg[bj][0][0], x0[1] * gg[bj][0][1]); hb.y = cvt_pk_bf16(x0[2] * gg[bj][0][2], x0[3] * gg[bj][0][3]);
                    hb.z = cvt_pk_bf16(x1[0] * gg[bj][1][0], x1[1] * gg[bj][1][1]); hb.w = cvt_pk_bf16(x1[2] * gg[bj][1][2], x1[3] * gg[bj][1][3]);
                    *(u32x4*)(H + o) = hb;
                    ssq += ((x0[0] * x0[0] + x0[1] * x0[1]) + (x0[2] * x0[2] + x0[3] * x0[3])) + ((x1[0] * x1[0] + x1[1] * x1[1]) + (x1[2] * x1[2] + x1[3] * x1[3])); }
                ssq += __shfl_xor(ssq, 16); ssq += __shfl_xor(ssq, 32);
                if (fq == 0) part[(ai * HALF + wr * 64 + m * 16 + fr) * 4 + wc] = ssq; }
        asm volatile("s_waitcnt lgkmcnt(0)" ::: "memory"); __builtin_amdgcn_s_barrier(); asm volatile("" ::: "memory");
        const int t = threadIdx.x;
        if (t < 256) { const f32x4 p = *(const LAS f32x4*)(part + t * 4); rss[(size_t)u.pn * NTOK + u.pm * BM + t] = (p[0] + p[1]) + (p[2] + p[3]); }
    }
};
struct EpiResF32 {
    static constexpr bool PERM = true;
    const float* res; float* O; int ldc;
    __device__ __forceinline__ void operator()(const f32x4 (&acc)[2][2][4][2], const Unit& u, int wr, int wc, int fr, int fq, LAS unsigned char*) const {
        const int row0 = u.pm * BM + wr * 64 + fr; const int col0 = u.pn * BM + wc * 32 + 8 * fq;
#pragma unroll
        for (int ai = 0; ai < 2; ++ai)
#pragma unroll
            for (int m = 0; m < 4; ++m) { const size_t ro = (size_t)(row0 + ai * HALF + m * 16) * ldc + col0;
#pragma unroll
                for (int bj = 0; bj < 2; ++bj) { const size_t o = ro + bj * HALF; const f32x4 r0 = *(const f32x4*)(res + o), r1 = *(const f32x4*)(res + o + 4);
                    *(f32x4*)(O + o) = r0 + acc[ai][bj][m][0]; *(f32x4*)(O + o + 4) = r1 + acc[ai][bj][m][1]; } }
    }
};

template <class Epi, class Sched>
__device__ __forceinline__ void gemm_phase(LAS unsigned char* lds, const Gemm g, const Sched& S, const Epi& E) {
    const int tid = otid(), wid = __builtin_amdgcn_readfirstlane(tid >> 6), lane = tid & 63, wr = wid >> 2, wc = wid & 3, fr = lane & 15, fq = lane >> 4;
    const int K = g.K, nt = K / BK, lda = g.lda;
    unsigned voffA[2], voffB[2];
#pragma unroll
    for (int i = 0; i < 2; ++i) { int R, C; stage_rc(tid * 16 + i * 8192, R, C); const int Rb = Epi::PERM ? ((R & ~31) + perm32(R & 31)) : R;
        voffA[i] = (unsigned)(R * lda + C) * 2u; voffB[i] = (unsigned)(Rb * K + C) * 2u; }
    const size_t kstep = (size_t)(BK * 2);
    const size_t hstepA = (size_t)HALF * lda * 2, hstepB = (size_t)HALF * K * 2;
    const size_t tstepA = 2 * hstepA, tstepB = 2 * hstepB;
    const unsigned ldsw = (unsigned)wid * 1024u;
    const int aoff = lds_byte(wr * 64 + fr, fq * 8), boff = lds_byte(wc * 32 + fr, fq * 8);
#define PG8_SA(b, h) (((b) * 2 + (h)) * HTB)
#define PG8_SB(b, h) ((4 + (b) * 2 + (h)) * HTB)
#define PG8_STAGE(bufoff, gbase, voff) do { _Pragma("unroll") for (int _i = 0; _i < 2; ++_i) \
        __builtin_amdgcn_global_load_lds((const unsigned*)((const char*)(gbase) + (voff)[_i]), (LAS unsigned*)(lds + (bufoff) + ldsw + _i * 8192), 16, 0, 0); } while (0)
#define PG8_LDA(dst, b, h) do { _Pragma("unroll") for (int m = 0; m < 4; ++m) _Pragma("unroll") for (int k = 0; k < 2; ++k) dst[m][k] = *(const LAS bf16x8*)(lds + PG8_SA(b, h) + aoff + m * 2048 + k * 1024); } while (0)
#define PG8_LDB(dst, b, h) do { _Pragma("unroll") for (int n = 0; n < 2; ++n) _Pragma("unroll") for (int k = 0; k < 2; ++k) dst[n][k] = *(const LAS bf16x8*)(lds + PG8_SB(b, h) + boff + n * 2048 + k * 1024); } while (0)
#define PG8_MMA(ai, bj, At, Bt) do { __builtin_amdgcn_s_setprio(1); _Pragma("unroll") for (int m = 0; m < 4; ++m) _Pragma("unroll") for (int n = 0; n < 2; ++n) _Pragma("unroll") for (int k = 0; k < 2; ++k) \
        acc[ai][bj][m][n] = __builtin_amdgcn_mfma_f32_16x16x32_bf16(Bt[n][k], At[m][k], acc[ai][bj][m][n], 0, 0, 0); __builtin_amdgcn_s_setprio(0); } while (0)
#define PG8_WAIT_V(n) asm volatile("s_waitcnt vmcnt(" #n ")" ::: "memory")
#define PG8_WAIT_L(n) asm volatile("s_waitcnt lgkmcnt(" #n ")" ::: "memory")
#define PG8_BAR __builtin_amdgcn_s_barrier()
#define PG8_SCHED __builtin_amdgcn_sched_barrier(0)
    Unit cur, nxt; int ui = 0;
    if (!S.next(0, cur)) return;
    f32x4 acc[2][2][4][2];
#pragma unroll
    for (int a = 0; a < 2; ++a)
#pragma unroll
        for (int b = 0; b < 2; ++b)
#pragma unroll
            for (int m = 0; m < 4; ++m)
#pragma unroll
                for (int n = 0; n < 2; ++n) acc[a][b][m][n] = (f32x4){0.f, 0.f, 0.f, 0.f};
    bf16x8 At[4][2], B0[2][2], B1[2][2];
    const char* cA = (const char*)g.A + (size_t)cur.pm * tstepA; const char* cB = (const char*)g.Bt + (size_t)cur.pn * tstepB;
    PG8_STAGE(PG8_SB(0, 0), cB, voffB); PG8_STAGE(PG8_SB(0, 1), cB + hstepB, voffB); PG8_STAGE(PG8_SA(0, 0), cA, voffA); PG8_STAGE(PG8_SA(0, 1), cA + hstepA, voffA);
    if (wr == 1) PG8_BAR;
    PG8_WAIT_V(2); PG8_BAR;
    PG8_STAGE(PG8_SB(1, 0), cB + kstep, voffB); PG8_STAGE(PG8_SA(1, 0), cA + kstep, voffA); PG8_STAGE(PG8_SB(1, 1), cB + hstepB + kstep, voffB);
    PG8_WAIT_V(6); PG8_BAR;
    for (;;) {
        const bool has_next = S.next(ui + 1, nxt);
        const char* nA = has_next ? (const char*)g.A + (size_t)nxt.pm * tstepA : cA; const char* nB = has_next ? (const char*)g.Bt + (size_t)nxt.pn * tstepB : cB;
        for (int t = 0; t < nt; t += 2) {
            const bool last = (t == nt - 2);
            const char* a1 = cA + (size_t)(t + 1) * kstep;
            const char* a2 = last ? nA : cA + (size_t)(t + 2) * kstep; const char* b2 = last ? nB : cB + (size_t)(t + 2) * kstep;
            const char* a3 = a2 + kstep; const char* b3 = b2 + kstep;
            PG8_LDB(B0, 0, 0); PG8_LDB(B1, 0, 1); PG8_SCHED; PG8_LDA(At, 0, 0); PG8_STAGE(PG8_SA(1, 1), a1 + hstepA, voffA);
            PG8_WAIT_V(8); PG8_WAIT_L(0); PG8_BAR; PG8_MMA(0, 0, At, B0); PG8_MMA(0, 1, At, B1); PG8_BAR; PG8_SCHED;
            PG8_LDA(At, 0, 1); PG8_STAGE(PG8_SB(0, 0), b2, voffB); PG8_STAGE(PG8_SB(0, 1), b2 + hstepB, voffB); PG8_STAGE(PG8_SA(0, 0), a2, voffA);
            PG8_WAIT_V(8); PG8_WAIT_L(0); PG8_BAR; PG8_MMA(1, 0, At, B0); PG8_MMA(1, 1, At, B1); PG8_BAR; PG8_SCHED;
            PG8_LDB(B0, 1, 0); PG8_LDB(B1, 1, 1); PG8_SCHED; PG8_LDA(At, 1, 0); PG8_STAGE(PG8_SA(0, 1), a2 + hstepA, voffA);
            PG8_WAIT_V(8); PG8_WAIT_L(0); PG8_BAR; PG8_MMA(0, 0, At, B0); PG8_MMA(0, 1, At, B1); PG8_BAR; PG8_SCHED;
            PG8_LDA(At, 1, 1); PG8_STAGE(PG8_SB(1, 0), b3, voffB); PG8_STAGE(PG8_SB(1, 1), b3 + hstepB, voffB); PG8_STAGE(PG8_SA(1, 0), a3, voffA);
            PG8_WAIT_V(8); PG8_WAIT_L(0); PG8_BAR; PG8_MMA(1, 0, At, B0); PG8_MMA(1, 1, At, B1); PG8_BAR; PG8_SCHED;
        }
        if (wr == 0) PG8_BAR;
        E(acc, cur, wr, wc, fr, fq, lds);
        if (!has_next) break;
#pragma unroll
        for (int a = 0; a < 2; ++a)
#pragma unroll
            for (int b = 0; b < 2; ++b)
#pragma unroll
                for (int m = 0; m < 4; ++m)
#pragma unroll
                    for (int n = 0; n < 2; ++n) acc[a][b][m][n] = (f32x4){0.f, 0.f, 0.f, 0.f};
        cur = nxt; cA = nA; cB = nB; ++ui;
        if (wr == 1) PG8_BAR;
    }
    PG8_WAIT_V(0);
    PG8_BAR;
#undef PG8_SA
#undef PG8_SB
#undef PG8_STAGE
#undef PG8_LDA
#undef PG8_LDB
#undef PG8_MMA
#undef PG8_WAIT_V
#undef PG8_WAIT_L
#undef PG8_BAR
#undef PG8_SCHED
}
}

__device__ __forceinline__ void transpose_item(const float* W, int ldw, int K, int ncols, bf16_t* WT, int row_off, LAS float* scr, int item, int lane) {
    const int nblk = ncols / 64, kb = item / nblk, nb = item % nblk, k0 = 64 * kb, n0 = 64 * nb;
    f32x4 v[16];
#pragma unroll
    for (int i = 0; i < 16; ++i) v[i] = *(const f32x4*)(W + (size_t)(k0 + 4 * i + (lane >> 4)) * ldw + n0 + (lane & 15) * 4);
#pragma unroll
    for (int i = 0; i < 16; ++i) { LAS float* d = scr + (4 * i + (lane >> 4)) * 65 + (lane & 15) * 4; d[0] = v[i].x; d[1] = v[i].y; d[2] = v[i].z; d[3] = v[i].w; }
    LDS_WAIT();
    const int c = lane & 7;
#pragma unroll
    for (int j = 0; j < 8; ++j) { const int n = (lane >> 3) + 8 * j; const LAS float* s = scr + (8 * c) * 65 + n;
        u32x4 o; o.x = pk2(s[0 * 65], s[1 * 65]); o.y = pk2(s[2 * 65], s[3 * 65]); o.z = pk2(s[4 * 65], s[5 * 65]); o.w = pk2(s[6 * 65], s[7 * 65]);
        *(u32x4*)(WT + (size_t)(row_off + n0 + n) * K + k0 + 8 * c) = o; }
    LDS_WAIT();
}
struct RowSet { f32x4 v[4][4]; };
__device__ __forceinline__ void norm_rows_load(const Args& a, int m0, int NGW, int lane, RowSet& r) {
    constexpr int NROWS = NTOK + 2 * NMEM;
#pragma unroll
    for (int q = 0; q < 4; ++q) { int m = m0 + q * NGW; if (m >= NROWS) m = m0;
        const float* xrow = (m < NTOK) ? a.x + (size_t)m * DM : a.mem + (size_t)((m - NTOK) & (NMEM - 1)) * DM;
#pragma unroll
        for (int j = 0; j < 4; ++j) r.v[q][j] = ((const f32x4*)xrow + lane)[64 * j]; }
}
__device__ __forceinline__ void norm_phase(const Args& a) {
    const int tid = otid(); const int lane = tid & 63, gw = blockIdx.x * 8 + (tid >> 6), NGW = gridDim.x * 8;
    bf16_t* H = (bf16_t*)(a.ws + WS_H); float* rss = (float*)(a.ws + WS_RSS);
    constexpr int NROWS = NTOK + 2 * NMEM;
    f32x4 gx[4], gm0[4], gm1[4];
#pragma unroll
    for (int j = 0; j < 4; ++j) { gx[j] = ((const f32x4*)a.norm_g + lane)[64 * j]; gm0[j] = ((const f32x4*)a.mng + lane)[64 * j]; gm1[j] = ((const f32x4*)(a.mng + DM) + lane)[64 * j]; }
    RowSet cur; norm_rows_load(a, gw < NROWS ? gw : 0, NGW, lane, cur);
    for (int m0 = gw; m0 < NROWS; m0 += 4 * NGW) {
        float sacc[4];
#pragma unroll
        for (int q = 0; q < 4; ++q) { sacc[q] = 0.f;
#pragma unroll
            for (int j = 0; j < 4; ++j) sacc[q] += (cur.v[q][j].x * cur.v[q][j].x + cur.v[q][j].y * cur.v[q][j].y) + (cur.v[q][j].z * cur.v[q][j].z + cur.v[q][j].w * cur.v[q][j].w); }
        asm volatile("" ::: "memory");
        RowSet nxt; norm_rows_load(a, (m0 + 4 * NGW < NROWS) ? m0 + 4 * NGW : m0, NGW, lane, nxt);
#pragma unroll
        for (int q = 0; q < 4; ++q) {
            int m = m0 + q * NGW; if (m >= NROWS) m = m0;
            const bool tokrow = m < NTOK; const int qq = (m - NTOK) & (NMEM - 1), l = (m - NTOK) >> 11;
            bf16_t* op = tokrow ? H + (size_t)m * DM : (bf16_t*)(a.ws + (l ? WS_MEMH1 : WS_MEMH)) + (size_t)qq * DM;
            const float tot = wave_sum(sacc[q]);
            const float rr = tokrow ? 1.f : 1.f / sqrtf(tot * (1.f / DM) + EPS);
            unsigned long long* o8 = (unsigned long long*)op + lane;
#pragma unroll
            for (int j = 0; j < 4; ++j) { const f32x4 gg = tokrow ? gx[j] : (l ? gm1[j] : gm0[j]); const f32x4 v = cur.v[q][j];
                o8[64 * j] = (unsigned long long)pk2(v.x * rr * gg.x, v.y * rr * gg.y) | ((unsigned long long)pk2(v.z * rr * gg.z, v.w * rr * gg.w) << 32); }
            if (tokrow && lane < 4) rss[lane * NTOK + m] = (lane == 0) ? tot : 0.f;
        }
        cur = nxt;
    }
}
__device__ __forceinline__ void p0_phase(const Args& a, LAS unsigned char* lds) {
    const int tid = otid(), lane = tid & 63, wave = tid >> 6;
    LAS float* scr = (LAS float*)(lds + wave * 17408);
    const int gw = blockIdx.x * 8 + wave, NGW = gridDim.x * 8;
    bf16_t* WinT = (bf16_t*)(a.ws + WS_WIN); bf16_t* WoutT = (bf16_t*)(a.ws + WS_WOUT); bf16_t* WmemT = (bf16_t*)(a.ws + WS_WMEM);
    for (int it = gw; it < 3840; it += NGW) {
        const int l = it / 1920; int r = it % 1920;
        if (r < 1280) { const int seg = r >> 7, sub = r & 127; const int oseg = (int)((0x2154987630ULL >> (4 * seg)) & 15ULL);
            transpose_item(a.w_in + (size_t)l * DM * NIN + oseg * 512, NIN, DM, 512, WinT + (size_t)l * NIN * DM, seg * 512, scr, sub, lane); }
        else if (r < 1664) { r -= 1280; transpose_item(a.w_out + (size_t)l * DMIX * DM, DM, DMIX, DM, WoutT + (size_t)l * DM * DMIX, 0, scr, r, lane); }
        else { r -= 1664; transpose_item(a.wmem + (size_t)l * DM * DM, DM, DM, DM, WmemT + (size_t)l * DM * DM, 0, scr, r, lane); }
    }
    float* rope = (float*)(a.ws + WS_ROPE);
    for (int e = blockIdx.x * 512 + tid; e < NTOK * 8; e += gridDim.x * 512) {
        const int tok = e >> 3, i = e & 7;
        const float inv = powf(500000.0f, -(float)i * 0.125f);
        const float ang = (float)a.pos[tok] * inv;
        const double ad = (double)ang; const double n = rint(ad * 0.15915494309189535); const float rr = (float)(ad - n * 6.283185307179586);
        rope[tok * 16 + i] = __cosf(rr); rope[tok * 16 + 8 + i] = __sinf(rr);
    }
    if (blockIdx.x == 0) { float* LB = (float*)(a.ws + WS_LB); LB[tid] = 0.f; const float l0 = a.lbl[tid], l1 = a.lbl[512 + tid]; LB[512 + tid] = 1.f / (1.f + expf(l0 - l1)); }
    norm_phase(a);
}

#define BAR_LDS() do { asm volatile("s_waitcnt lgkmcnt(0)" ::: "memory"); __builtin_amdgcn_s_barrier(); asm volatile("" ::: "memory"); } while (0)
struct PrepIn { u32x4 q[4], k[4]; float cs[8], sn[8]; };
__device__ __forceinline__ void moba_prep_load(const Args& a, int tid, int u, PrepIn& r) {
    const int b = u >> 6, j = (u >> 3) & 7, h = u & 7, tok = tid >> 1, half = tid & 1;
    const size_t row = (size_t)b * SEQ + j * 256 + tok;
    const bf16_t* p = (const bf16_t*)(a.ws + WS_PROJ) + row * NCOL + h * 64 + half * 32;
    const bf16_t* pk = (const bf16_t*)(a.ws + WS_KC) + ((size_t)(b * 8 + h) * SEQ + j * 256 + tok) * 64 + half * 32;
#pragma unroll
    for (int c = 0; c < 4; ++c) { r.q[c] = *(const u32x4*)(p + CQA + c * 8); r.k[c] = *(const u32x4*)(pk + c * 8); }
    const f32x4* rope = (const f32x4*)((const float*)(a.ws + WS_ROPE) + row * 16);
    const f32x4 c0 = rope[0], c1 = rope[1], s0 = rope[2], s1 = rope[3];
    r.cs[0] = c0.x; r.cs[1] = c0.y; r.cs[2] = c0.z; r.cs[3] = c0.w; r.cs[4] = c1.x; r.cs[5] = c1.y; r.cs[6] = c1.z; r.cs[7] = c1.w;
    r.sn[0] = s0.x; r.sn[1] = s0.y; r.sn[2] = s0.z; r.sn[3] = s0.w; r.sn[4] = s1.x; r.sn[5] = s1.y; r.sn[6] = s1.z; r.sn[7] = s1.w;
}
__device__ __forceinline__ void moba_prep_unit(const Args& a, int l, LAS unsigned char* lds, int tid, int u, const PrepIn& in, PrepIn& nxt, int unext) {
    const int b = u >> 6, j = (u >> 3) & 7, h = u & 7, tok = tid >> 1, half = tid & 1;
    bf16_t* proj = (bf16_t*)(a.ws + WS_PROJ);
    const size_t row = (size_t)b * SEQ + j * 256 + tok;
    LAS float* kt = (LAS float*)lds;
    LAS float* part = (LAS float*)(lds + 66560);
    float vq[32], vk[32];
#pragma unroll
    for (int c = 0; c < 4; ++c) { const u32x4 uq = in.q[c], uk = in.k[c];
        vq[c * 8 + 0] = bflo(uq.x); vq[c * 8 + 1] = bfhi(uq.x); vq[c * 8 + 2] = bflo(uq.y); vq[c * 8 + 3] = bfhi(uq.y); vq[c * 8 + 4] = bflo(uq.z); vq[c * 8 + 5] = bfhi(uq.z); vq[c * 8 + 6] = bflo(uq.w); vq[c * 8 + 7] = bfhi(uq.w);
        vk[c * 8 + 0] = bflo(uk.x); vk[c * 8 + 1] = bfhi(uk.x); vk[c * 8 + 2] = bflo(uk.y); vk[c * 8 + 3] = bfhi(uk.y); vk[c * 8 + 4] = bflo(uk.z); vk[c * 8 + 5] = bfhi(uk.z); vk[c * 8 + 6] = bflo(uk.w); vk[c * 8 + 7] = bfhi(uk.w); }
    float cs[8], sn[8];
#pragma unroll
    for (int i = 0; i < 8; ++i) { cs[i] = in.cs[i]; sn[i] = in.sn[i]; }
    asm volatile("" ::: "memory");
    moba_prep_load(a, tid, unext, nxt);
#pragma unroll
    for (int which = 0; which < 2; ++which) {
        bf16_t* p = which ? (bf16_t*)(a.ws + WS_KC) + ((size_t)(b * 8 + h) * SEQ + j * 256 + tok) * 64 + half * 32 : proj + row * NCOL + CQA + h * 64 + half * 32;
        const LAS float* g = (const LAS float*)(lds + 68608) + which * 64 + half * 32;
        float v[32]; float ss = 0.f;
#pragma unroll
        for (int i = 0; i < 32; ++i) { v[i] = which ? vk[i] : vq[i]; ss += v[i] * v[i]; }
        ss += __shfl_xor(ss, 1);
        const float r = frsq(ss * (1.f / 64.f) + EPS) * (which ? 1.f : 0.125f * LOG2E);
#pragma unroll
        for (int c = 0; c < 8; ++c) { const f32x4 gg = *(const LAS f32x4*)(g + c * 4); v[c * 4] *= r * gg.x; v[c * 4 + 1] *= r * gg.y; v[c * 4 + 2] *= r * gg.z; v[c * 4 + 3] *= r * gg.w; }
        if (half == 0) {
#pragma unroll
            for (int i = 0; i < 8; ++i) { const float x1 = v[i], x2 = v[8 + i]; v[i] = x1 * cs[i] - x2 * sn[i]; v[8 + i] = x2 * cs[i] + x1 * sn[i]; }
        }
#pragma unroll
        for (int c = 0; c < 4; ++c) { u32x4 uu; uu.x = pk2(v[c * 8 + 0], v[c * 8 + 1]); uu.y = pk2(v[c * 8 + 2], v[c * 8 + 3]); uu.z = pk2(v[c * 8 + 4], v[c * 8 + 5]); uu.w = pk2(v[c * 8 + 6], v[c * 8 + 7]);
            *(u32x4*)(p + c * 8) = uu; }
        if (which == 1) {
#pragma unroll
            for (int i = 0; i < 32; ++i) kt[tok * 65 + half * 32 + i] = v[i];
        }
    }
    BAR_LDS();
    {
        const int d = tid & 63, pt = tid >> 6; float sacc = 0.f;
#pragma unroll 8
        for (int t = 0; t < 32; ++t) sacc += kt[(pt * 32 + t) * 65 + d];
        part[pt * 64 + d] = sacc;
    }
    BAR_LDS();
    if (tid < 64) { float sacc = 0.f;
#pragma unroll
        for (int p = 0; p < 8; ++p) sacc += part[p * 64 + tid];
        ((float*)(a.ws + WS_KMEAN))[((size_t)(b * 8 + h) * 8 + j) * 64 + tid] = sacc * (1.f / 256.f); }
    BAR_LDS();
}

struct HIn { u32x4 f[2], q[2], v[2]; };
template <bool NEEDQ>
__device__ __forceinline__ void hgrn_load(const Args& a, int tid, int u, HIn& r) {
    const int bh = u >> 5, c = u & 31, b = bh >> 2, hh = bh & 3; const size_t row0 = (size_t)b * SEQ + c * 64;
#pragma unroll
    for (int ii = 0; ii < 2; ++ii) { const int cid = tid + 512 * ii, t = cid >> 4, d0 = (cid & 15) * 8;
        const bf16_t* p = (const bf16_t*)(a.ws + WS_PROJ) + (row0 + t) * NCOL + hh * 128 + d0;
        r.f[ii] = *(const u32x4*)(p + CFH); r.v[ii] = *(const u32x4*)(p + CIH); if (NEEDQ) r.q[ii] = *(const u32x4*)(p + CQH); }
}
__device__ __forceinline__ void hgrn_stepA(const Args& a, int l, LAS unsigned char* lds, int tid, int hh, const HIn& in, float (&kf)[16]) {
    LAS float* LF = (LAS float*)lds;
    LAS float* PT = (LAS float*)(lds + 32768);
#pragma unroll
    for (int ii = 0; ii < 2; ++ii) {
        const int cid = tid + 512 * ii, t = cid >> 4, d0 = (cid & 15) * 8;
        const u32x4 u = in.f[ii];
        float fl[8] = {bflo(u.x), bfhi(u.x), bflo(u.y), bfhi(u.y), bflo(u.z), bfhi(u.z), bflo(u.w), bfhi(u.w)};
        float lf[8];
        const LAS float* LB = (const LAS float*)(lds + 106496) + hh * 128 + d0; const f32x4 lb0 = *(const LAS f32x4*)LB, lb1 = *(const LAS f32x4*)(LB + 4);
        const float lbv[8] = {lb0.x, lb0.y, lb0.z, lb0.w, lb1.x, lb1.y, lb1.z, lb1.w};
#pragma unroll
        for (int i = 0; i < 8; ++i) { const float lb = lbv[i]; const float sg = sigm(fl[i]);
            const float f = lb + (1.f - lb) * sg; lf[i] = __logf(f); kf[ii * 8 + i] = (1.f - lb) * (1.f - sg); }
        *(LAS f32x4*)(LF + t * 128 + d0) = (f32x4){lf[0], lf[1], lf[2], lf[3]}; *(LAS f32x4*)(LF + t * 128 + d0 + 4) = (f32x4){lf[4], lf[5], lf[6], lf[7]};
    }
}
__device__ __forceinline__ void hgrn_cumsum_scan(LAS unsigned char* lds, int tid) {
    LAS float* LF = (LAS float*)lds;
    LAS float* PT = (LAS float*)(lds + 32768);
    BAR_LDS();
    { const int d = tid & 127, pt = tid >> 7; float run = 0.f;
#pragma unroll
      for (int t = 0; t < 16; ++t) { run += LF[(pt * 16 + t) * 128 + d]; LF[(pt * 16 + t) * 128 + d] = run; }
      PT[pt * 128 + d] = run; }
    BAR_LDS();
    { const int d = tid & 127, pt = tid >> 7; float off = 0.f;
#pragma unroll
      for (int p = 0; p < 3; ++p) off += (p < pt) ? PT[p * 128 + d] : 0.f;
      if (pt > 0) {
#pragma unroll
        for (int t = 0; t < 16; ++t) LF[(pt * 16 + t) * 128 + d] += off; } }
    BAR_LDS();
}
__device__ __forceinline__ void hgrn_stage1_unit(const Args& a, int l, LAS unsigned char* lds, int tid, int u, const HIn& in, HIn& nxt, int unext) {
    const int lane = tid & 63, w = __builtin_amdgcn_readfirstlane(tid >> 6), fr = lane & 15, fq = lane >> 4;
    const int bh = u >> 5, c = u & 31, hh = bh & 3;
    LAS float* LF = (LAS float*)lds;
    LAS unsigned char* KN = lds + 34816;
    LAS unsigned char* VN = lds + 34816 + 18432;
    float kf[16];
    hgrn_stepA(a, l, lds, tid, hh, in, kf);
    hgrn_load<false>(a, tid, unext, nxt);
    hgrn_cumsum_scan(lds, tid);
    if (tid < 128) ((float*)(a.ws + WS_DECAY))[((size_t)bh * 32 + c) * 128 + tid] = fexp(LF[63 * 128 + tid]);
#pragma unroll
    for (int ii = 0; ii < 2; ++ii) {
        const int cid = tid + 512 * ii, t = cid >> 4, d0 = (cid & 15) * 8;
        const f32x4 ae0 = *(const LAS f32x4*)(LF + 63 * 128 + d0), ae1 = *(const LAS f32x4*)(LF + 63 * 128 + d0 + 4), at0 = *(const LAS f32x4*)(LF + t * 128 + d0), at1 = *(const LAS f32x4*)(LF + t * 128 + d0 + 4);
        const f32x4 e0 = ae0 - at0, e1 = ae1 - at1;
        u32x4 o; o.x = pk2(kf[ii * 8 + 0] * fexp(e0.x), kf[ii * 8 + 1] * fexp(e0.y)); o.y = pk2(kf[ii * 8 + 2] * fexp(e0.z), kf[ii * 8 + 3] * fexp(e0.w));
        o.z = pk2(kf[ii * 8 + 4] * fexp(e1.x), kf[ii * 8 + 5] * fexp(e1.y)); o.w = pk2(kf[ii * 8 + 6] * fexp(e1.z), kf[ii * 8 + 7] * fexp(e1.w));
        *(LAS u32x4*)(KN + t * 288 + d0 * 2) = o;
        *(LAS u32x4*)(VN + t * 288 + d0 * 2) = in.v[ii];
    }
    BAR_LDS();
    f32x4 acc[8];
#pragma unroll
    for (int n = 0; n < 8; ++n) acc[n] = (f32x4){0.f, 0.f, 0.f, 0.f};
#pragma unroll
    for (int ks = 0; ks < 2; ++ks) {
        const s16x4 alo = tr4(VN, 288, ks * 32 + fq * 4, w * 16, fr), ahi = tr4(VN, 288, ks * 32 + 16 + fq * 4, w * 16, fr);
        const bf16x8 af = __builtin_shufflevector(alo, ahi, 0, 1, 2, 3, 4, 5, 6, 7);
#pragma unroll
        for (int n = 0; n < 8; ++n) { const s16x4 blo = tr4(KN, 288, ks * 32 + fq * 4, n * 16, fr), bhi = tr4(KN, 288, ks * 32 + 16 + fq * 4, n * 16, fr);
            const bf16x8 bfr = __builtin_shufflevector(blo, bhi, 0, 1, 2, 3, 4, 5, 6, 7); acc[n] = MFMA16(bfr, af, acc[n]); }
    }
    bf16_t* ST = (bf16_t*)(a.ws + WS_H) + ((size_t)bh * 32 + c) * 16384;
#pragma unroll
    for (int n = 0; n < 8; ++n) { u32x2 o; o.x = pk2(acc[n][0], acc[n][1]); o.y = pk2(acc[n][2], acc[n][3]); *(u32x2*)(ST + (w * 16 + fr) * 128 + n * 16 + fq * 4) = o; }
    BAR_LDS();
}
__device__ __forceinline__ void hgrn_scan_phase(const Args& a) {
    const int id = blockIdx.x * 512 + otid(), NT = gridDim.x * 512;
    for (int it = id; it < 32 * 128 * 32; it += NT) {
        const int bh = it >> 12, dv = (it >> 5) & 127, dkc = it & 31;
        u32x2* st = (u32x2*)((bf16_t*)(a.ws + WS_H) + (size_t)bh * 32 * 16384 + dv * 128 + dkc * 4);
        const f32x4* dc = (const f32x4*)((const float*)(a.ws + WS_DECAY) + (size_t)bh * 32 * 128 + dkc * 4);
        float r0 = 0.f, r1 = 0.f, r2 = 0.f, r3 = 0.f;
#pragma unroll 8
        for (int c = 0; c < 32; ++c) {
            const u32x2 u = st[(size_t)c * 4096]; const f32x4 dd = dc[c * 32];
            u32x2 o; o.x = pk2(r0, r1); o.y = pk2(r2, r3); st[(size_t)c * 4096] = o;
            r0 = dd.x * r0 + bflo(u.x); r1 = dd.y * r1 + bfhi(u.x); r2 = dd.z * r2 + bflo(u.y); r3 = dd.w * r3 + bfhi(u.y);
        }
    }
}
__device__ __forceinline__ void hgrn_stage3_unit(const Args& a, int l, LAS unsigned char* lds, int tid, int u, const HIn& in, HIn& nxt, int unext) {
    const int lane = tid & 63, w = __builtin_amdgcn_readfirstlane(tid >> 6), fr = lane & 15, fq = lane >> 4;
    const int bh = u >> 5, c = u & 31, b = bh >> 2, hh = bh & 3; const size_t row0 = (size_t)b * SEQ + c * 64;
    const int tt = w & 3, vh = w >> 2;
    bf16_t* proj = (bf16_t*)(a.ws + WS_PROJ);
    LAS float* LF = (LAS float*)lds;
    LAS unsigned char* QM = lds + 34816;
    LAS unsigned char* Q0 = QM + 17408;
    LAS unsigned char* KM = Q0 + 17408;
    LAS unsigned char* VN = KM + 17408;
    LAS float* SSQ = (LAS float*)(VN + 18432);
    float kf[16];
    hgrn_stepA(a, l, lds, tid, hh, in, kf);
    const size_t row = row0 + tt * 16 + fr;
    const bf16_t* ST = (const bf16_t*)(a.ws + WS_H) + ((size_t)bh * 32 + c) * 16384;
    bf16x8 stf[4][4]; u32x2 zz[4];
#pragma unroll
    for (int ks = 0; ks < 4; ++ks)
#pragma unroll
        for (int v = 0; v < 4; ++v) stf[ks][v] = *(const bf16x8*)(ST + ((vh * 4 + v) * 16 + fr) * 128 + ks * 32 + fq * 8);
#pragma unroll
    for (int v = 0; v < 4; ++v) zz[v] = *(const u32x2*)(proj + row * NCOL + CZ + 512 + hh * 128 + (vh * 4 + v) * 16 + fq * 4);
    hgrn_load<true>(a, tid, unext, nxt);
    hgrn_cumsum_scan(lds, tid);
#pragma unroll
    for (int ii = 0; ii < 2; ++ii) {
        const int cid = tid + 512 * ii, t = cid >> 4, d0 = (cid & 15) * 8;
        const u32x4 uq = in.q[ii];
        float q[8] = {bflo(uq.x), bfhi(uq.x), bflo(uq.y), bfhi(uq.y), bflo(uq.z), bfhi(uq.z), bflo(uq.w), bfhi(uq.w)};
        float qm[8], q0[8], km[8];
        const f32x4 at0 = *(const LAS f32x4*)(LF + t * 128 + d0), at1 = *(const LAS f32x4*)(LF + t * 128 + d0 + 4), am0 = *(const LAS f32x4*)(LF + 31 * 128 + d0), am1 = *(const LAS f32x4*)(LF + 31 * 128 + d0 + 4);
        const float Atv[8] = {at0.x, at0.y, at0.z, at0.w, at1.x, at1.y, at1.z, at1.w}, Amv[8] = {am0.x, am0.y, am0.z, am0.w, am1.x, am1.y, am1.z, am1.w};
#pragma unroll
        for (int i = 0; i < 8; ++i) { const float At = Atv[i], Am = Amv[i]; const float sq = silu(q[i]);
            qm[i] = sq * fexp(At - Am); q0[i] = sq * fexp(At); km[i] = kf[ii * 8 + i] * fexp(Am - At); }
        u32x4 o;
        o.x = pk2(qm[0], qm[1]); o.y = pk2(qm[2], qm[3]); o.z = pk2(qm[4], qm[5]); o.w = pk2(qm[6], qm[7]); *(LAS u32x4*)(QM + t * 272 + d0 * 2) = o;
        o.x = pk2(q0[0], q0[1]); o.y = pk2(q0[2], q0[3]); o.z = pk2(q0[4], q0[5]); o.w = pk2(q0[6], q0[7]); *(LAS u32x4*)(Q0 + t * 272 + d0 * 2) = o;
        o.x = pk2(km[0], km[1]); o.y = pk2(km[2], km[3]); o.z = pk2(km[4], km[5]); o.w = pk2(km[6], km[7]); *(LAS u32x4*)(KM + t * 272 + d0 * 2) = o;
        *(LAS u32x4*)(VN + t * 288 + d0 * 2) = in.v[ii];
    }
    BAR_LDS();
    f32x4 sc[4];
#pragma unroll
    for (int s = 0; s < 4; ++s) sc[s] = (f32x4){0.f, 0.f, 0.f, 0.f};
#pragma unroll
    for (int ks = 0; ks < 4; ++ks) {
        const bf16x8 qf = *(const LAS bf16x8*)(QM + (tt * 16 + fr) * 272 + (ks * 32 + fq * 8) * 2);
#pragma unroll
        for (int s = 0; s < 4; ++s) if (s <= tt) { const bf16x8 kfr = *(const LAS bf16x8*)(KM + (s * 16 + fr) * 272 + (ks * 32 + fq * 8) * 2); sc[s] = MFMA16(kfr, qf, sc[s]); }
    }
#pragma unroll
    for (int s = 0; s < 4; ++s)
#pragma unroll
        for (int jj = 0; jj < 4; ++jj) { const bool ok = (s < tt) || (s == tt && (fq * 4 + jj) <= fr); sc[s][jj] = ok ? sc[s][jj] : 0.f; }
    f32x4 o[4];
#pragma unroll
    for (int v = 0; v < 4; ++v) o[v] = (f32x4){0.f, 0.f, 0.f, 0.f};
#pragma unroll
    for (int kst = 0; kst < 2; ++kst) {
        if (kst * 2 <= tt) {
            u32x4 pw; pw.x = pk2(sc[2 * kst][0], sc[2 * kst][1]); pw.y = pk2(sc[2 * kst][2], sc[2 * kst][3]); pw.z = pk2(sc[2 * kst + 1][0], sc[2 * kst + 1][1]); pw.w = pk2(sc[2 * kst + 1][2], sc[2 * kst + 1][3]);
            const bf16x8 pb = __builtin_bit_cast(bf16x8, pw);
#pragma unroll
            for (int v = 0; v < 4; ++v) { const s16x4 lo = tr4(VN, 288, kst * 32 + fq * 4, (vh * 4 + v) * 16, fr), hi = tr4(VN, 288, kst * 32 + 16 + fq * 4, (vh * 4 + v) * 16, fr);
                const bf16x8 vf = __builtin_shufflevector(lo, hi, 0, 1, 2, 3, 4, 5, 6, 7);
                o[v] = MFMA16(vf, pb, o[v]); }
        }
    }
#pragma unroll
    for (int ks = 0; ks < 4; ++ks) {
        const bf16x8 q0f = *(const LAS bf16x8*)(Q0 + (tt * 16 + fr) * 272 + (ks * 32 + fq * 8) * 2);
#pragma unroll
        for (int v = 0; v < 4; ++v) o[v] = MFMA16(stf[ks][v], q0f, o[v]);
    }
    float ss = 0.f;
#pragma unroll
    for (int v = 0; v < 4; ++v)
#pragma unroll
        for (int jj = 0; jj < 4; ++jj) ss += o[v][jj] * o[v][jj];
    ss += __shfl_xor(ss, 16); ss += __shfl_xor(ss, 32);
    if (fq == 0) SSQ[vh * 64 + tt * 16 + fr] = ss;
    BAR_LDS();
    const float tot = SSQ[tt * 16 + fr] + SSQ[64 + tt * 16 + fr];
    const float r = frsq(tot * (1.f / 128.f) + EPS);
#pragma unroll
    for (int v = 0; v < 4; ++v) { const int v0 = (vh * 4 + v) * 16 + fq * 4;
        const f32x4 g = *(const LAS f32x4*)((const LAS float*)(lds + 106496 + 2048) + v0);
        const u32x2 z = zz[v];
        u32x2 y; y.x = pk2(o[v][0] * r * g.x * silu(bflo(z.x)), o[v][1] * r * g.y * silu(bfhi(z.x))); y.y = pk2(o[v][2] * r * g.z * silu(bflo(z.y)), o[v][3] * r * g.w * silu(bfhi(z.y)));
        *(u32x2*)(proj + row * NCOL + CQH + hh * 128 + v0) = y; }
    BAR_LDS();
}

template <int D, int QT0>
__device__ __forceinline__ void qk_tile(const LAS unsigned char* Ks, int KP, const bf16x8 (&qf)[2][D / 32], f32x4 (&s)[4][2], int fr, int fq, float b0, float b1) {
#pragma unroll
    for (int a = 0; a < 4; ++a) { s[a][0] = (f32x4){b0, b0, b0, b0}; s[a][1] = (f32x4){b1, b1, b1, b1}; }
#pragma unroll
    for (int a = 0; a < 4; ++a)
#pragma unroll
        for (int ks = 0; ks < D / 32; ++ks) { const bf16x8 kfr = *(const LAS bf16x8*)(Ks + (a * 16 + fr) * KP + (ks * 32 + fq * 8) * 2);
            if (QT0 == 0) s[a][0] = MFMA16(kfr, qf[0][ks], s[a][0]);
            s[a][1] = MFMA16(kfr, qf[1][ks], s[a][1]); }
}
#define ONES8 ((bf16x8){16256, 16256, 16256, 16256, 16256, 16256, 16256, 16256})
template <int D, bool DIAG, int QT0>
__device__ __forceinline__ void sm_pv_tile(f32x4 (&s)[4][2], const LAS unsigned char* Vs, int VP, f32x4 (&o)[D / 16][2], f32x4 (&ol)[2], int fr, int fq, int keyl0, int qla, int qlb) {
#pragma unroll
    for (int qt = QT0; qt < 2; ++qt) {
        if (DIAG) {
            const int ql = (qt == 0 ? qla : qlb) + fr - keyl0 - fq * 4;
#pragma unroll
            for (int a = 0; a < 4; ++a)
#pragma unroll
                for (int jj = 0; jj < 4; ++jj) s[a][qt][jj] = (a * 16 + jj > ql) ? -1e30f : s[a][qt][jj];
        }
#pragma unroll
        for (int a = 0; a < 4; ++a)
#pragma unroll
            for (int jj = 0; jj < 4; ++jj) s[a][qt][jj] = ex2(s[a][qt][jj]);
    }
#pragma unroll
    for (int kst = 0; kst < 2; ++kst) {
        bf16x8 pb[2];
#pragma unroll
        for (int qt = QT0; qt < 2; ++qt) { u32x4 pw; pw.x = pk2(s[2 * kst][qt][0], s[2 * kst][qt][1]); pw.y = pk2(s[2 * kst][qt][2], s[2 * kst][qt][3]);
            pw.z = pk2(s[2 * kst + 1][qt][0], s[2 * kst + 1][qt][1]); pw.w = pk2(s[2 * kst + 1][qt][2], s[2 * kst + 1][qt][3]); pb[qt] = __builtin_bit_cast(bf16x8, pw); }
        if (QT0 == 0) ol[0] = MFMA16(ONES8, pb[0], ol[0]);
        ol[1] = MFMA16(ONES8, pb[1], ol[1]);
#pragma unroll
        for (int dt = 0; dt < D / 16; ++dt) { const s16x4 lo = tr4(Vs, VP, kst * 32 + fq * 4, dt * 16, fr), hi = tr4(Vs, VP, kst * 32 + 16 + fq * 4, dt * 16, fr);
            const bf16x8 vf = __builtin_shufflevector(lo, hi, 0, 1, 2, 3, 4, 5, 6, 7);
            if (QT0 == 0) o[dt][0] = MFMA16(vf, pb[0], o[dt][0]);
            o[dt][1] = MFMA16(vf, pb[1], o[dt][1]); }
    }
}
__device__ __forceinline__ void sm_pv_tile128(f32x4 (&sa)[4][2], f32x4 (&sb)[4][2], const LAS unsigned char* Vs, int VP, f32x4 (&o)[4][2], f32x4 (&ol)[2], int fr, int fq) {
#pragma unroll
    for (int qt = 0; qt < 2; ++qt)
#pragma unroll
        for (int a = 0; a < 4; ++a)
#pragma unroll
            for (int jj = 0; jj < 4; ++jj) { sa[a][qt][jj] = ex2(sa[a][qt][jj]); sb[a][qt][jj] = ex2(sb[a][qt][jj]); }
#pragma unroll
    for (int half = 0; half < 2; ++half)
#pragma unroll
        for (int kst = 0; kst < 2; ++kst) {
            bf16x8 pb[2];
#pragma unroll
            for (int qt = 0; qt < 2; ++qt) { const f32x4 x0 = half ? sb[2 * kst][qt] : sa[2 * kst][qt], x1 = half ? sb[2 * kst + 1][qt] : sa[2 * kst + 1][qt];
                u32x4 pw; pw.x = pk2(x0[0], x0[1]); pw.y = pk2(x0[2], x0[3]); pw.z = pk2(x1[0], x1[1]); pw.w = pk2(x1[2], x1[3]); pb[qt] = __builtin_bit_cast(bf16x8, pw); }
            ol[0] = MFMA16(ONES8, pb[0], ol[0]); ol[1] = MFMA16(ONES8, pb[1], ol[1]);
#pragma unroll
            for (int dt = 0; dt < 4; ++dt) { const s16x4 lo = tr4(Vs, VP, half * 64 + kst * 32 + fq * 4, dt * 16, fr), hi = tr4(Vs, VP, half * 64 + kst * 32 + 16 + fq * 4, dt * 16, fr);
                const bf16x8 vf = __builtin_shufflevector(lo, hi, 0, 1, 2, 3, 4, 5, 6, 7);
                o[dt][0] = MFMA16(vf, pb[0], o[dt][0]); o[dt][1] = MFMA16(vf, pb[1], o[dt][1]); }
            __builtin_amdgcn_sched_barrier(0);
        }
}
template <int D, bool DIAG, int QT0>
__device__ __forceinline__ void attn_tile(const LAS unsigned char* Ks, int KP, const LAS unsigned char* Vs, int VP, const bf16x8 (&qf)[2][D / 32], f32x4 (&o)[D / 16][2], f32x4 (&ol)[2],
                                          int fr, int fq, int keyl0, int qla, int qlb, float b0, float b1) {
    f32x4 s[4][2];
    qk_tile<D, QT0>(Ks, KP, qf, s, fr, fq, b0, b1);
    sm_pv_tile<D, DIAG, QT0>(s, Vs, VP, o, ol, fr, fq, keyl0, qla, qlb);
}

__device__ __forceinline__ void moba_unit(const Args& a, int l, LAS unsigned char* lds, int b, int h, int qb) {
    const int tid = otid(), lane = tid & 63, w = __builtin_amdgcn_readfirstlane(tid >> 6), fr = lane & 15, fq = lane >> 4;
    bf16_t* proj = (bf16_t*)(a.ws + WS_PROJ);
    LAS float* kml = (LAS float*)(lds + 77824);
    kml[tid] = ((const float*)(a.ws + WS_KMEAN))[(size_t)(b * 8 + h) * 512 + tid];
    const size_t rowbase = (size_t)b * SEQ;
    const bf16_t* Kc = (const bf16_t*)(a.ws + WS_KC) + (size_t)(b * 8 + h) * SEQ * 64; const bf16_t* Vc = (const bf16_t*)(a.ws + WS_VC) + (size_t)(b * 8 + h) * SEQ * 64;
    const int qrow[2] = {qb * 256 + w * 16, qb * 256 + (15 - w) * 16};
    bf16x8 qf[2][2];
#pragma unroll
    for (int qt = 0; qt < 2; ++qt)
#pragma unroll
        for (int ks = 0; ks < 2; ++ks) qf[qt][ks] = *(const bf16x8*)(proj + (rowbase + qrow[qt] + fr) * NCOL + CQA + h * 64 + ks * 32 + fq * 8);
    const int NT2 = (qb + 1) * 2;
    u32x4 kreg[2], vreg[2];
#define MOBA_T128(i) ((i) < 2 ? qb * 2 + (i) : (i) - 2)
#define MOBA_LOAD(t128) do { _Pragma("unroll") for (int ii = 0; ii < 2; ++ii) { const int cid = tid + 512 * ii; \
        kreg[ii] = *(const u32x4*)(Kc + (size_t)((t128) * 128) * 64 + cid * 8); \
        vreg[ii] = *(const u32x4*)(Vc + (size_t)((t128) * 128) * 64 + cid * 8); } } while (0)
#define MOBA_STORE(buf) do { _Pragma("unroll") for (int ii = 0; ii < 2; ++ii) { const int cid = tid + 512 * ii; \
        *(LAS u32x4*)(lds + (buf) * 38912 + (cid >> 3) * 144 + (cid & 7) * 16) = kreg[ii]; \
        *(LAS u32x4*)(lds + (buf) * 38912 + 18432 + (cid >> 3) * 160 + (cid & 7) * 16) = vreg[ii]; } } while (0)
    MOBA_LOAD(MOBA_T128(0));
    __syncthreads();
    unsigned selmask[2];
    if (qb <= 3) { selmask[0] = selmask[1] = (1u << qb) - 1u; }
    else {
#pragma unroll
        for (int qt = 0; qt < 2; ++qt) {
            float g[8];
#pragma unroll
            for (int j = 0; j < 8; ++j) { float psum = 0.f;
                if (j < qb) {
#pragma unroll
                    for (int ks = 0; ks < 2; ++ks)
#pragma unroll
                        for (int i = 0; i < 8; ++i) psum += bf2f(qf[qt][ks][i]) * kml[j * 64 + ks * 32 + fq * 8 + i];
                    psum += __shfl_xor(psum, 16); psum += __shfl_xor(psum, 32);
                }
                g[j] = (j < qb) ? psum : -INFINITY; }
            unsigned msk = 0u;
#pragma unroll
            for (int j = 0; j < 8; ++j) { int rank = 0;
#pragma unroll
                for (int mth = 0; mth < 8; ++mth) if (mth != j) rank += (g[mth] > g[j] || (g[mth] == g[j] && mth < j)) ? 1 : 0;
                if (j < qb && rank < 3) msk |= (1u << j); }
            selmask[qt] = msk;
        }
    }
    f32x4 o[4][2];
#pragma unroll
    for (int dt = 0; dt < 4; ++dt) { o[dt][0] = (f32x4){0.f, 0.f, 0.f, 0.f}; o[dt][1] = (f32x4){0.f, 0.f, 0.f, 0.f}; }
    float gm; { float xq = fabsf(a.mqn[l * 64 + lane]), xk = fabsf(a.mkn[l * 64 + lane]);
#pragma unroll
      for (int ofs = 1; ofs < 64; ofs <<= 1) { xq = fmaxf(xq, __shfl_xor(xq, ofs)); xk = fmaxf(xk, __shfl_xor(xk, ofs)); }
      gm = xq * xk * (8.f * 1.03f * LOG2E); }
    f32x4 ol[2] = {(f32x4){0.f, 0.f, 0.f, 0.f}, (f32x4){0.f, 0.f, 0.f, 0.f}};
    MOBA_STORE(0);
    BAR_LDS();
    for (int i = 0; i < NT2; ++i) {
        if (i + 1 < NT2) { const int tn = MOBA_T128(i + 1); MOBA_LOAD(tn); }
        const int t128 = MOBA_T128(i), j = t128 >> 1, hb = t128 & 1; const bool diag = (j == qb);
        const LAS unsigned char* Kb = lds + (i & 1) * 38912;
        const unsigned rs0 = diag ? 1u : ((selmask[0] >> j) & 1u), rs1 = diag ? 1u : ((selmask[1] >> j) & 1u);
        if (!diag) {
            f32x4 sA[4][2], sB[4][2];
            const float b0 = rs0 ? -gm : -1e30f, b1 = rs1 ? -gm : -1e30f;
            qk_tile<64, 0>(Kb, 144, qf, sA, fr, fq, b0, b1);
            qk_tile<64, 0>(Kb + 64 * 144, 144, qf, sB, fr, fq, b0, b1);
            sm_pv_tile128(sA, sB, Kb + 18432, 160, o, ol, fr, fq);
        } else
#pragma unroll
        for (int sub = 0; sub < 2; ++sub) {
            const int ktl = hb * 2 + sub;
            if (diag) {
                if (ktl <= (w >> 2)) attn_tile<64, true, 0>(Kb + sub * 64 * 144, 144, Kb + 18432 + sub * 64 * 160, 160, qf, o, ol, fr, fq, ktl * 64, w * 16, (15 - w) * 16, -gm, -gm);
                else if (ktl <= ((15 - w) >> 2)) attn_tile<64, true, 1>(Kb + sub * 64 * 144, 144, Kb + 18432 + sub * 64 * 160, 160, qf, o, ol, fr, fq, ktl * 64, w * 16, (15 - w) * 16, -gm, -gm);
            } else attn_tile<64, false, 0>(Kb + sub * 64 * 144, 144, Kb + 18432 + sub * 64 * 160, 160, qf, o, ol, fr, fq, 0, 0, 0, rs0 ? -gm : -1e30f, rs1 ? -gm : -1e30f);
        }
        if (i + 1 < NT2) MOBA_STORE((i + 1) & 1);
        BAR_LDS();
    }
#undef MOBA_T128
#undef MOBA_LOAD
#undef MOBA_STORE
#pragma unroll
    for (int qt = 0; qt < 2; ++qt) {
        const float inv = frcp(ol[qt][0]);
        const size_t row = rowbase + qrow[qt] + fr;
#pragma unroll
        for (int dt = 0; dt < 4; ++dt) { const int d0 = dt * 16 + fq * 4;
            const u32x2 z = *(const u32x2*)(proj + row * NCOL + CZ + h * 64 + d0);
            u32x2 y; y.x = pk2(o[dt][qt][0] * inv * silu(bflo(z.x)), o[dt][qt][1] * inv * silu(bfhi(z.x))); y.y = pk2(o[dt][qt][2] * inv * silu(bflo(z.y)), o[dt][qt][3] * inv * silu(bfhi(z.y)));
            *(u32x2*)(proj + row * NCOL + CQA + h * 64 + d0) = y; }
    }
    __syncthreads();
}

__device__ __forceinline__ void mem_unit(const Args& a, int l, LAS unsigned char* lds, int b, int hm, int qb) {
    const int tid = otid(), lane = tid & 63, w = __builtin_amdgcn_readfirstlane(tid >> 6), fr = lane & 15, fq = lane >> 4;
    bf16_t* proj = (bf16_t*)(a.ws + WS_PROJ);
    const bf16_t* kvm = (const bf16_t*)(a.ws + WS_KVM) + (size_t)b * MEML * 1024;
    const size_t rowbase = (size_t)b * SEQ; const int q0 = qb * 256 + w * 32;
    u32x4 ukr[2], uvr[2];
#define MEM_LOAD(kt) do { _Pragma("unroll") for (int ii = 0; ii < 2; ++ii) { const int cid = tid + 512 * ii; \
        ukr[ii] = *(const u32x4*)(kvm + (size_t)((kt) * 64 + (cid >> 4)) * 1024 + hm * 128 + (cid & 15) * 8); \
        uvr[ii] = *(const u32x4*)(kvm + (size_t)((kt) * 64 + (cid >> 4)) * 1024 + 512 + hm * 128 + (cid & 15) * 8); } } while (0)
    const f32x4 g0 = *(const f32x4*)(a.memkn + l * 128 + (tid & 15) * 8), g1 = *(const f32x4*)(a.memkn + l * 128 + (tid & 15) * 8 + 4);
    MEM_LOAD(0);
    bf16x8 qf[2][4];
#pragma unroll
    for (int qt = 0; qt < 2; ++qt) {
        u32x4 u[4]; float ss = 0.f;
#pragma unroll
        for (int ks = 0; ks < 4; ++ks) { u[ks] = *(const u32x4*)(proj + (rowbase + q0 + qt * 16 + fr) * NCOL + CQM + hm * 128 + ks * 32 + fq * 8);
            ss += bflo(u[ks].x) * bflo(u[ks].x) + bfhi(u[ks].x) * bfhi(u[ks].x) + bflo(u[ks].y) * bflo(u[ks].y) + bfhi(u[ks].y) * bfhi(u[ks].y)
                + bflo(u[ks].z) * bflo(u[ks].z) + bfhi(u[ks].z) * bfhi(u[ks].z) + bflo(u[ks].w) * bflo(u[ks].w) + bfhi(u[ks].w) * bfhi(u[ks].w); }
        ss += __shfl_xor(ss, 16); ss += __shfl_xor(ss, 32);
        const float r = frsq(ss * (1.f / 128.f) + EPS) * (0.08838834764831845f * LOG2E);
#pragma unroll
        for (int ks = 0; ks < 4; ++ks) { const float* g = a.memqn + l * 128 + ks * 32 + fq * 8; const f32x4 g0 = *(const f32x4*)g, g1 = *(const f32x4*)(g + 4);
            u32x4 o; o.x = pk2(bflo(u[ks].x) * r * g0.x, bfhi(u[ks].x) * r * g0.y); o.y = pk2(bflo(u[ks].y) * r * g0.z, bfhi(u[ks].y) * r * g0.w);
            o.z = pk2(bflo(u[ks].z) * r * g1.x, bfhi(u[ks].z) * r * g1.y); o.w = pk2(bflo(u[ks].w) * r * g1.z, bfhi(u[ks].w) * r * g1.w);
            qf[qt][ks] = __builtin_bit_cast(bf16x8, o); }
    }
    f32x4 o[8][2];
#pragma unroll
    for (int dt = 0; dt < 8; ++dt) { o[dt][0] = (f32x4){0.f, 0.f, 0.f, 0.f}; o[dt][1] = (f32x4){0.f, 0.f, 0.f, 0.f}; }
    float gm; { float xq = fmaxf(fabsf(a.memqn[l * 128 + lane]), fabsf(a.memqn[l * 128 + 64 + lane])), xk = fmaxf(fabsf(a.memkn[l * 128 + lane]), fabsf(a.memkn[l * 128 + 64 + lane]));
#pragma unroll
      for (int ofs = 1; ofs < 64; ofs <<= 1) { xq = fmaxf(xq, __shfl_xor(xq, ofs)); xk = fmaxf(xk, __shfl_xor(xk, ofs)); }
      gm = xq * xk * (11.3137085f * 1.03f * LOG2E); }
    f32x4 ol[2] = {(f32x4){0.f, 0.f, 0.f, 0.f}, (f32x4){0.f, 0.f, 0.f, 0.f}};
    LAS unsigned char* Ks = lds;
    LAS unsigned char* Vs = lds + 17408;
#define MEM_STORE(buf) do { _Pragma("unroll") for (int ii = 0; ii < 2; ++ii) { \
            const int cid = tid + 512 * ii, key = cid >> 4, dc = cid & 15; \
            const u32x4 uk = ukr[ii]; \
            float kv[8] = {bflo(uk.x), bfhi(uk.x), bflo(uk.y), bfhi(uk.y), bflo(uk.z), bfhi(uk.z), bflo(uk.w), bfhi(uk.w)}; \
            float ss = 0.f; \
            _Pragma("unroll") for (int i = 0; i < 8; ++i) ss += kv[i] * kv[i]; \
            ss += __shfl_xor(ss, 1); ss += __shfl_xor(ss, 2); ss += __shfl_xor(ss, 4); ss += __shfl_xor(ss, 8); \
            const float r = frsq(ss * (1.f / 128.f) + EPS); \
            u32x4 ok; ok.x = pk2(kv[0] * r * g0.x, kv[1] * r * g0.y); ok.y = pk2(kv[2] * r * g0.z, kv[3] * r * g0.w); ok.z = pk2(kv[4] * r * g1.x, kv[5] * r * g1.y); ok.w = pk2(kv[6] * r * g1.z, kv[7] * r * g1.w); \
            *(LAS u32x4*)(Ks + (buf) * 35840 + key * 272 + dc * 16) = ok; \
            *(LAS u32x4*)(Vs + (buf) * 35840 + key * 288 + dc * 16) = uvr[ii]; } } while (0)
    MEM_STORE(0);
    BAR_LDS();
    for (int kt = 0; kt < 4; ++kt) {
        if (kt < 3) MEM_LOAD(kt + 1);
        attn_tile<128, false, 0>(Ks + (kt & 1) * 35840, 272, Vs + (kt & 1) * 35840, 288, qf, o, ol, fr, fq, 0, 0, 0, -gm, -gm);
        if (kt < 3) MEM_STORE((kt + 1) & 1);
        BAR_LDS();
    }
#undef MEM_STORE
#undef MEM_LOAD
#pragma unroll
    for (int qt = 0; qt < 2; ++qt) {
        const float inv = frcp(ol[qt][0]);
        const size_t row = rowbase + q0 + qt * 16 + fr;
#pragma unroll
        for (int dt = 0; dt < 8; ++dt) { const int d0 = dt * 16 + fq * 4;
            const u32x2 z = *(const u32x2*)(proj + row * NCOL + CZ + 1024 + hm * 128 + d0);
            u32x2 y; y.x = pk2(o[dt][qt][0] * inv * silu(bflo(z.x)), o[dt][qt][1] * inv * silu(bfhi(z.x))); y.y = pk2(o[dt][qt][2] * inv * silu(bflo(z.y)), o[dt][qt][3] * inv * silu(bfhi(z.y)));
            *(u32x2*)(proj + row * NCOL + CQM + hm * 128 + d0) = y; }
    }
}

#define XB_TMO      128
#define XB_XCNT(j)  (256  + 64 * (j))
#define XB_XSUB(j)  (1280 + 64 * (j))
#define XB_XGEN(j)  (2304 + 64 * (j))
#define XB_TOP      3328
#define XB_TOPGEN   3392
#define XCD_BAR_WORDS 3456
#define XB_SPIN_CAP (1u << 18)
__device__ __forceinline__ unsigned xb_ld(unsigned* p)              { return __hip_atomic_load(p, __ATOMIC_RELAXED, __HIP_MEMORY_SCOPE_AGENT); }
__device__ __forceinline__ unsigned xb_add(unsigned* p, unsigned v) { return __hip_atomic_fetch_add(p, v, __ATOMIC_RELAXED, __HIP_MEMORY_SCOPE_AGENT); }
__device__ __forceinline__ unsigned xb_xcc_id() { return (unsigned)__builtin_amdgcn_s_getreg((3 << 11) | 20) & 0xFu; }
#define XB_SPIN(cond, bar) do { unsigned _sp = 0; while (cond) { __builtin_amdgcn_s_sleep(1); \
    if ((++_sp & 255u) == 0u) { if (xb_ld(&(bar)[XB_TMO])) break; if (_sp > XB_SPIN_CAP) { atomicAdd(&(bar)[XB_TMO], 1u); break; } } } } while (0)
struct XcdBarrier { unsigned* bar; unsigned x; volatile LAS unsigned* st; };
__device__ __forceinline__ XcdBarrier xcd_barrier_post(unsigned* bar, volatile LAS unsigned* st) {
    XcdBarrier b; b.bar = bar; b.x = xb_xcc_id(); b.st = st;
    if (threadIdx.x == 0) (void)xb_add(&bar[XB_XCNT(b.x)], 1u);
    return b;
}
__device__ __forceinline__ void xcd_barrier_complete(unsigned* bar, unsigned x, unsigned& nloc, unsigned& nx) {
    const unsigned G = gridDim.x * gridDim.y * gridDim.z;
    unsigned sum, cnt, mine, sp = 0u;
    for (;;) {
        sum = 0u; cnt = 0u; mine = 0u;
#pragma unroll
        for (unsigned j = 0; j < 16; ++j) { const unsigned c = xb_ld(&bar[XB_XCNT(j)]); sum += c; cnt += (c > 0u) ? 1u : 0u; mine = (j == x) ? c : mine; }
        if (sum == G) break;
        __builtin_amdgcn_s_sleep(1);
        if ((++sp & 255u) == 0u) { if (xb_ld(&bar[XB_TMO])) break; if (sp > XB_SPIN_CAP) { atomicAdd(&bar[XB_TMO], 1u); break; } }
    }
    nloc = mine > 0u ? mine : 1u; nx = cnt > 0u ? cnt : 1u;
}
__device__ __forceinline__ void xcd_barrier(const XcdBarrier& b) {
    asm volatile("s_waitcnt vmcnt(0)" ::: "memory");
    __syncthreads();
    if (threadIdx.x == 0) {
        unsigned* bar = b.bar;
        __builtin_amdgcn_s_waitcnt(0);
        unsigned nloc = b.st[0], nx = b.st[1];
        if (nloc == 0u) { xcd_barrier_complete(bar, b.x, nloc, nx); b.st[0] = nloc; b.st[1] = nx; }
        const unsigned old = xb_add(&bar[XB_XSUB(b.x)], 1u);
        const unsigned gen = old / nloc;
        if (old + 1u == (gen + 1u) * nloc) {
            __builtin_amdgcn_fence(__ATOMIC_RELEASE, "agent");
            asm volatile("s_waitcnt vmcnt(0)" ::: "memory");
            const unsigned og = xb_add(&bar[XB_TOP], 1u);
            const unsigned tg = og / nx;
            if (og + 1u == (tg + 1u) * nx) xb_add(&bar[XB_TOPGEN], 1u);
            else XB_SPIN(xb_ld(&bar[XB_TOPGEN]) == tg, bar);
            __builtin_amdgcn_fence(__ATOMIC_ACQUIRE, "agent");
            xb_add(&bar[XB_XGEN(b.x)], 1u);
            asm volatile("s_waitcnt vmcnt(0)" ::: "memory");
        } else {
            XB_SPIN(xb_ld(&bar[XB_XGEN(b.x)]) == gen, bar);
            __builtin_amdgcn_fence(__ATOMIC_ACQUIRE, "agent");
            asm volatile("s_waitcnt vmcnt(0)" ::: "memory");
        }
    }
    __syncthreads();
}

__global__ void __launch_bounds__(512) hymba_fwd(Args a) {
    extern __shared__ __attribute__((aligned(16))) unsigned char lds_raw[];
    LAS unsigned char* lds = (LAS unsigned char*)lds_raw;
    const int G = gridDim.x, bx = blockIdx.x;
    const int lo = a.ph_lo, hi = a.ph_hi;
    bf16_t* proj = (bf16_t*)(a.ws + WS_PROJ);
#define IN(k) (lo <= (k) && (k) < hi)
#define SEAM(k) do { if (IN(k) && IN((k) + 1)) { if (a.pad == 0x5eed) cg::this_grid().sync(); xcd_barrier(xbar); } } while (0)
    volatile LAS unsigned* xst = (volatile LAS unsigned*)(lds + LDS_BYTES - 16);
    if (threadIdx.x < 2) xst[threadIdx.x] = 0u;
    __syncthreads();
    XcdBarrier xbar; xbar.bar = (unsigned*)(a.ws + WS_BAR); xbar.x = 0; xbar.st = xst;
    if (hi - lo > 1) xbar = xcd_barrier_post((unsigned*)(a.ws + WS_BAR), xst);
    if (IN(0)) { p0_phase(a, lds); __syncthreads(); }
    SEAM(0);
#pragma unroll 1
    for (int l = 0; l < 2; ++l) {
        const int base = 1 + 5 * l;
        if (IN(base)) {
            {
            pg8::Gemm g{(const bf16_t*)(a.ws + WS_H), (const bf16_t*)(a.ws + WS_WIN) + (size_t)l * NIN * DM, NTOK, NIN, DM, DM};
            pg8::StaticOrder S; S.init(NTOK, NIN, G, bx);
            pg8::EpiBf16Scale E{proj, NCOL, (bf16_t*)(a.ws + WS_KC), (bf16_t*)(a.ws + WS_VC)};
            if (G == 256) {
                pg8::Unit u0; if (S.next(0, u0) && threadIdx.x < 256) { const float* rss = (const float*)(a.ws + WS_RSS) + u0.pm * 256 + threadIdx.x;
                    ((LAS float*)(lds + 131072))[threadIdx.x] = frsq(((rss[0] + rss[NTOK]) + (rss[2 * NTOK] + rss[3 * NTOK])) * (1.f / 1024.f) + EPS); }
                __syncthreads();
                pg8::gemm_phase<pg8::EpiBf16Scale, pg8::StaticOrder>(lds, g, S, E);
            } else {
                for (int i = 0; ; ++i) { pg8::Unit u0; if (!S.next(i, u0)) break;
                    if (threadIdx.x < 256) { const float* rss = (const float*)(a.ws + WS_RSS) + u0.pm * 256 + threadIdx.x;
                        ((LAS float*)(lds + 131072))[threadIdx.x] = frsq(((rss[0] + rss[NTOK]) + (rss[2 * NTOK] + rss[3 * NTOK])) * (1.f / 1024.f) + EPS); }
                    __syncthreads();
                    pg8::StaticOrder S1; S1.init(NTOK, NIN, 1 << 30, i * G + bx);
                    pg8::gemm_phase<pg8::EpiBf16Scale, pg8::StaticOrder>(lds, g, S1, E); __syncthreads(); }
            }
            __syncthreads();
            }
        }
        SEAM(base);
        if (IN(base + 1)) {
            const int NKV = (G >= 64) ? 32 : 0;
            {
            {
                pg8::Gemm g{(const bf16_t*)(a.ws + (l ? WS_MEMH1 : WS_MEMH)), (const bf16_t*)(a.ws + WS_WMEM) + (size_t)l * DM * DM, NMEM, 1024, DM, DM};
                pg8::StaticOrder S; S.init(NMEM, 1024, G, bx);
                pg8::EpiBf16 E{(bf16_t*)(a.ws + WS_KVM), 1024};
                pg8::gemm_phase<pg8::EpiBf16, pg8::StaticOrder>(lds, g, S, E);
                __syncthreads();
            }
            if (bx >= NKV) {
                const int wb = bx - NKV, WG = G - NKV;
                const int tid = otid();
                if (tid < 128) ((LAS float*)(lds + 68608))[tid] = (tid < 64) ? a.mqn[l * 64 + tid] : a.mkn[l * 64 + tid - 64];
                if (tid < 512) ((LAS float*)(lds + 106496))[tid] = ((const float*)(a.ws + WS_LB))[l * 512 + tid];
                __syncthreads();
                { PrepIn cur; int u = wb; moba_prep_load(a, tid, u < 512 ? u : 0, cur);
                  for (; u < 512; u += WG) { PrepIn nxt; moba_prep_unit(a, l, lds, tid, u, cur, nxt, (u + WG < 512) ? u + WG : u); cur = nxt; } }
                { HIn cur; int u = (wb + 160) % WG;     hgrn_load<false>(a, tid, u < 1024 ? u : 0, cur);
                  for (; u < 1024; u += WG) { HIn nxt; hgrn_stage1_unit(a, l, lds, tid, u, cur, nxt, (u + WG < 1024) ? u + WG : u); cur = nxt; } }
                __syncthreads();
            }
            }
        }
        SEAM(base + 1);
        if (IN(base + 2)) {
            {
                for (int u = bx; u < 512; u += G) {
                    int bh, qb; if (G == 256) { bh = bx >> 2; const int s = bx & 3; qb = (u < 256) ? 7 - s : s; } else { bh = u >> 3; qb = 7 - (u & 7); }
                    moba_unit(a, l, lds, bh >> 3, bh & 7, qb);
                }
            }
            for (int u = bx; u < 256; u += G) mem_unit(a, l, lds, u >> 5, (u >> 3) & 3, u & 7);
            hgrn_scan_phase(a);
            __syncthreads();
        }
        SEAM(base + 2);
        if (IN(base + 3)) {
            { const int tid = otid();
              if (tid < 512) ((LAS float*)(lds + 106496))[tid] = ((const float*)(a.ws + WS_LB))[l * 512 + tid];
              if (tid < 128) ((LAS float*)(lds + 106496 + 2048))[tid] = a.hon[l * 128 + tid];
              __syncthreads();
              HIn cur; int u = bx; hgrn_load<true>(a, tid, u < 1024 ? u : 0, cur);
                for (; u < 1024; u += G) { HIn nxt; hgrn_stage3_unit(a, l, lds, tid, u, cur, nxt, (u + G < 1024) ? u + G : u); cur = nxt; } }
            __syncthreads();
        }
        SEAM(base + 3);
        if (IN(base + 4)) {
            pg8::Gemm g{proj, (const bf16_t*)(a.ws + WS_WOUT) + (size_t)l * DM * DMIX, NTOK, DM, DMIX, NCOL};
            pg8::StaticOrder S; S.init(NTOK, DM, G, bx);
            if (l == 0) { {
                pg8::EpiResF32Norm E{a.x, a.out, DM, a.norm_g + DM, (bf16_t*)(a.ws + WS_H), (float*)(a.ws + WS_RSS)};
                pg8::gemm_phase<pg8::EpiResF32Norm, pg8::StaticOrder>(lds, g, S, E); __syncthreads(); } }
            else { pg8::EpiResF32 E{(const float*)a.out, a.out, DM};
                pg8::gemm_phase<pg8::EpiResF32, pg8::StaticOrder>(lds, g, S, E); __syncthreads(); }
        }
        if (l == 0) SEAM(base + 4);
    }
#undef IN
#undef SEAM
}

extern "C" void kernel_launch(void* const* d_in, const int* in_sizes, int n_in, void* d_out, int out_size, void* d_ws, size_t ws_size, hipStream_t stream) {
    static int grid = 0;
    if (grid == 0) {
        if (n_in != 14 || out_size != NTOK * DM || ws_size < WS_BAR + 65536) { fprintf(stderr, "kernel_launch: unexpected shapes (n_in %d out %d ws %zu)\n", n_in, out_size, ws_size); grid = -1; return; }
        int dev = 0, cus = 0, per_cu = 0;
        hipGetDevice(&dev); hipDeviceGetAttribute(&cus, hipDeviceAttributeMultiprocessorCount, dev);
        if (hipFuncSetAttribute((const void*)hymba_fwd, hipFuncAttributeMaxDynamicSharedMemorySize, LDS_BYTES) != hipSuccess) { fprintf(stderr, "kernel_launch: hipFuncSetAttribute failed\n"); grid = -1; return; }
        if (hipOccupancyMaxActiveBlocksPerMultiprocessor(&per_cu, (const void*)hymba_fwd, 512, LDS_BYTES) != hipSuccess || per_cu < 1) { fprintf(stderr, "kernel_launch: occupancy query says %d\n", per_cu); per_cu = 1; }
        (void)hipGetLastError();
        grid = cus * (per_cu > 1 ? 1 : per_cu);
    }
    if (grid < 0) return;
    if (hipMemsetAsync((char*)d_ws + WS_BAR, 0, XCD_BAR_WORDS * 4, stream) != hipSuccess) { fprintf(stderr, "kernel_launch: memset failed\n"); return; }
    Args a{};
    a.x = (const float*)d_in[0]; a.mem = (const float*)d_in[1]; a.pos = (const int*)d_in[2]; a.norm_g = (const float*)d_in[3]; a.w_in = (const float*)d_in[4]; a.w_out = (const float*)d_in[5];
    a.mqn = (const float*)d_in[6]; a.mkn = (const float*)d_in[7]; a.lbl = (const float*)d_in[8]; a.hon = (const float*)d_in[9]; a.mng = (const float*)d_in[10]; a.wmem = (const float*)d_in[11];
    a.memqn = (const float*)d_in[12]; a.memkn = (const float*)d_in[13]; a.out = (float*)d_out; a.ws = (unsigned char*)d_ws; a.rep = 0;
#if MK_ONE_LAUNCH
    a.ph_lo = 0; a.ph_hi = NPHASE;
    void* args[] = {&a};
    hipError_t e = hipLaunchCooperativeKernel((const void*)hymba_fwd, dim3(grid), dim3(512), args, LDS_BYTES, stream);
    if (e != hipSuccess) fprintf(stderr, "cooperative launch failed: %s (grid %d)\n", hipGetErrorString(e), grid);
#else
    for (int p = 0; p < NPHASE; ++p) { a.ph_lo = p; a.ph_hi = p + 1; hipLaunchKernelGGL(hymba_fwd, dim3(grid), dim3(512), LDS_BYTES, stream, a); }
#endif
}
```

```cpp
#include <hip/hip_runtime.h>
#include <hip/hip_cooperative_groups.h>
#include <cstdio>
#include <cstdint>
namespace cg = cooperative_groups;

#ifndef MK_ONE_LAUNCH
#define MK_ONE_LAUNCH 1
#endif

#define LAS __attribute__((address_space(3)))
typedef unsigned short bf16_t;
typedef short bf16x8 __attribute__((ext_vector_type(8)));
typedef short s16x4 __attribute__((ext_vector_type(4)));
typedef float f32x4 __attribute__((ext_vector_type(4)));
typedef unsigned u32x4 __attribute__((ext_vector_type(4)));
typedef unsigned u32x2 __attribute__((ext_vector_type(2)));

constexpr int NB = 8, SEQ = 2048, DM = 1024, NTOK = NB * SEQ, MEML = 256, NMEM = NB * MEML, NCOL = 4096  , NIN = 5120  , DMIX = 1536;
constexpr int CQA = 0, CQH = 512, CQM = 1024, CZ = 1536, CFH = 3072, CIH = 3584;
constexpr float EPS = 1e-6f;
constexpr float LOG2E = 1.4426950408889634f;
constexpr size_t MiB = 1u << 20;
constexpr size_t WS_WIN = 0, WS_WOUT = 20 * MiB, WS_WMEM = 26 * MiB, WS_H = 30 * MiB  , WS_MEMH = 62 * MiB, WS_KVM = 66 * MiB,
                 WS_PROJ = 70 * MiB, WS_KC = 198 * MiB, WS_VC = 214 * MiB, WS_VT = 230 * MiB, WS_KMEAN = 246 * MiB, WS_DECAY = 246 * MiB + 128 * 1024, WS_ROPE = 247 * MiB, WS_END = 248 * MiB, WS_MEMH1 = 230 * MiB  , WS_RSS = 250 * MiB  , WS_LB = 251 * MiB  , WS_BAR = 252 * MiB  ;
constexpr int LDS_BYTES = 147456;
constexpr int NPHASE = 11;

struct Args {
    const float *x, *mem; const int* pos; const float *norm_g, *w_in, *w_out, *mqn, *mkn, *lbl, *hon, *mng, *wmem, *memqn, *memkn;
    float* out; unsigned char* ws; int ph_lo, ph_hi, rep, pad;
};

typedef float f32x2_t __attribute__((ext_vector_type(2))); typedef __bf16 bf16x2_t __attribute__((ext_vector_type(2)));
__device__ __forceinline__ unsigned pk2(float lo, float hi) { f32x2_t v = {lo, hi}; bf16x2_t b = __builtin_convertvector(v, bf16x2_t); return __builtin_bit_cast(unsigned, b); }
__device__ __forceinline__ unsigned f2bf(float f) { return pk2(f, 0.f) & 0xffffu; }
__device__ __forceinline__ float bflo(unsigned u) { return __uint_as_float(u << 16); }
__device__ __forceinline__ float bfhi(unsigned u) { return __uint_as_float(u & 0xffff0000u); }
__device__ __forceinline__ float bf2f(short s) { return __uint_as_float(((unsigned)(unsigned short)s) << 16); }
__device__ __forceinline__ float wave_sum(float v) {
#pragma unroll
    for (int o = 1; o < 64; o <<= 1) v += __shfl_xor(v, o);
    return v;
}
__device__ __forceinline__ float ex2(float x) { return __builtin_amdgcn_exp2f(x); }
__device__ __forceinline__ float fexp(float x) { return __builtin_amdgcn_exp2f(x * LOG2E); }
__device__ __forceinline__ float frcp(float x) { return __builtin_amdgcn_rcpf(x); }
__device__ __forceinline__ float frsq(float x) { return __builtin_amdgcn_rsqf(x); }
__device__ __forceinline__ float sigm(float x) { return frcp(1.f + fexp(-x)); }
__device__ __forceinline__ float silu(float x) { return x * frcp(1.f + fexp(-x)); }
#define LDS_WAIT() asm volatile("s_waitcnt lgkmcnt(0)" ::: "memory")
__device__ __forceinline__ int otid() { int t = threadIdx.x; asm volatile("" : "+v"(t)); return t; }
typedef short v4i16_t __attribute__((ext_vector_type(4)));
__device__ __forceinline__ s16x4 tr4(const LAS unsigned char* base, int pitch, int r0, int c0, int lane) {
    const int q = (lane & 15) >> 2, p = lane & 3;
    return __builtin_bit_cast(s16x4, __builtin_amdgcn_ds_read_tr16_b64_v4i16((LAS v4i16_t*)(base + (r0 + q) * pitch + (c0 + 4 * p) * 2)));
}
#define MFMA16(a, b, c) __builtin_amdgcn_mfma_f32_16x16x32_bf16((a), (b), (c), 0, 0, 0)

namespace pg8 {
constexpr int BM = 256, BK = 64, HALF = 128, HTB = HALF * BK * 2, NXCD = 8, WGM = 8;
__host__ __device__ __forceinline__ int lds_byte(int r, int c) { const int st = (r >> 4) * 2 + (c >> 5), rr = r & 15, cc = c & 31, ob = rr * 64 + cc * 2; return st * 1024 + (ob ^ (((ob >> 9) & 1) << 5)); }
__host__ __device__ __forceinline__ void stage_rc(int b, int& R, int& C) { const int st = b / 1024, sb = b % 1024, swz = sb ^ (((sb >> 9) & 1) << 5); R = (st >> 1) * 16 + swz / 64; C = (st & 1) * 32 + (swz % 64) / 2; }
__host__ __device__ __forceinline__ int perm32(int rho) { const int n = rho >> 4, i = rho & 15; return 8 * (i >> 2) + 4 * n + (i & 3); }
struct Unit { int pm, pn; };
struct Gemm { const bf16_t* A; const bf16_t* Bt; int M, N, K, lda; };
struct StaticOrder {
    int nM, nN, nwg, G, c;
    __device__ void init(int M, int N, int G_, int c_) { nM = M / BM; nN = N / BM; nwg = nM * nN; G = G_; c = c_; }
    __device__ bool next(int i, Unit& u) const {
        const long L = (long)i * G + c; if (L >= nwg) return false;
        int wgid = (int)L; { const int q = nwg / NXCD, r = nwg % NXCD, xcd = wgid % NXCD, off = wgid / NXCD; wgid = (xcd < r ? xcd * (q + 1) : r * (q + 1) + (xcd - r) * q) + off; }
        const int nig = WGM * nN, gid = wgid / nig, fm = gid * WGM, gsz = (nM - fm) < WGM ? (nM - fm) : WGM;
        u.pm = fm + ((wgid % nig) % gsz); u.pn = (wgid % nig) / gsz; return true;
    }
};
__device__ __forceinline__ unsigned cvt_pk_bf16(float lo, float hi) { unsigned r; asm volatile("v_cvt_pk_bf16_f32 %0, %1, %2" : "=v"(r) : "v"(lo), "v"(hi)); return r; }
struct EpiBf16 {
    static constexpr bool PERM = true;
    bf16_t* O; int ldc;
    __device__ __forceinline__ void operator()(const f32x4 (&acc)[2][2][4][2], const Unit& u, int wr, int wc, int fr, int fq, LAS unsigned char*) const {
        const int row0 = u.pm * BM + wr * 64 + fr; const int col0 = u.pn * BM + wc * 32 + 8 * fq;
#pragma unroll
        for (int ai = 0; ai < 2; ++ai)
#pragma unroll
            for (int m = 0; m < 4; ++m) { bf16_t* rowp = O + (size_t)(row0 + ai * HALF + m * 16) * ldc + col0;
#pragma unroll
                for (int bj = 0; bj < 2; ++bj) { const f32x4 v0 = acc[ai][bj][m][0], v1 = acc[ai][bj][m][1];
                    u32x4 w; w.x = cvt_pk_bf16(v0[0], v0[1]); w.y = cvt_pk_bf16(v0[2], v0[3]); w.z = cvt_pk_bf16(v1[0], v1[1]); w.w = cvt_pk_bf16(v1[2], v1[3]);
                    *(u32x4*)(rowp + bj * HALF) = w; } }
    }
};
struct EpiBf16Scale {
    static constexpr bool PERM = true;
    bf16_t* O; int ldc; bf16_t* Kc; bf16_t* Vc;
    __device__ __forceinline__ void operator()(const f32x4 (&acc)[2][2][4][2], const Unit& u, int wr, int wc, int fr, int fq, LAS unsigned char* lds) const {
        const int row0 = u.pm * BM + wr * 64 + fr; const int col0 = u.pn * BM + wc * 32 + 8 * fq;
        const LAS float* rtab = (const LAS float*)(lds + 131072);
        const bool compact = u.pn >= 16;
#pragma unroll
        for (int ai = 0; ai < 2; ++ai)
#pragma unroll
            for (int m = 0; m < 4; ++m) { const int row = row0 + ai * HALF + m * 16;
                const float r = rtab[ai * HALF + wr * 64 + m * 16 + fr];
#pragma unroll
                for (int bj = 0; bj < 2; ++bj) { const f32x4 v0 = acc[ai][bj][m][0] * r, v1 = acc[ai][bj][m][1] * r;
                    u32x4 w; w.x = cvt_pk_bf16(v0[0], v0[1]); w.y = cvt_pk_bf16(v0[2], v0[3]); w.z = cvt_pk_bf16(v1[0], v1[1]); w.w = cvt_pk_bf16(v1[2], v1[3]);
                    bf16_t* dst;
                    if (compact) { const int cc = col0 + bj * HALF - 4096, hc = cc & 511, hh = hc >> 6, d = hc & 63;
                        dst = ((cc >> 9) ? Vc : Kc) + ((size_t)((row >> 11) * 8 + hh) * 2048 + (row & 2047)) * 64 + d; }
                    else dst = O + (size_t)row * ldc + col0 + bj * HALF;
                    *(u32x4*)dst = w; } }
    }
};
struct EpiResF32Norm {
    static constexpr bool PERM = true;
    const float* res; float* O; int ldc; const float* g; bf16_t* H; float* rss;
    __device__ __forceinline__ void operator()(const f32x4 (&acc)[2][2][4][2], const Unit& u, int wr, int wc, int fr, int fq, LAS unsigned char* lds) const {
        const int row0 = u.pm * BM + wr * 64 + fr; const int col0 = u.pn * BM + wc * 32 + 8 * fq;
        LAS float* part = (LAS float*)(lds + 131072);
        f32x4 gg[2][2];
#pragma unroll
        for (int bj = 0; bj < 2; ++bj)
#pragma unroll
            for (int n = 0; n < 2; ++n) gg[bj][n] = *(const f32x4*)(g + col0 + bj * HALF + 4 * n);
#pragma unroll
        for (int ai = 0; ai < 2; ++ai)
#pragma unroll
            for (int m = 0; m < 4; ++m) { const size_t ro = (size_t)(row0 + ai * HALF + m * 16) * ldc + col0; float ssq = 0.f;
#pragma unroll
                for (int bj = 0; bj < 2; ++bj) { const size_t o = ro + bj * HALF;
                    const f32x4 r0 = *(const f32x4*)(res + o), r1 = *(const f32x4*)(res + o + 4);
                    const f32x4 x0 = r0 + acc[ai][bj][m][0], x1 = r1 + acc[ai][bj][m][1];
                    *(f32x4*)(O + o) = x0; *(f32x4*)(O + o + 4) = x1;
                    u32x4 hb; hb.x = cvt_pk_bf16(x0[0] * gg[bj][0][0], x0[1] * gg[bj][0][1]); hb.y = cvt_pk_bf16(x0[2] * gg[bj][0][2], x0[3] * gg[bj][0][3]);
                    hb.z = cvt_pk_bf16(x1[0] * gg[bj][1][0], x1[1] * gg[bj][1][1]); hb.w = cvt_pk_bf16(x1[2] * gg[bj][1][2], x1[3] * gg[bj][1][3]);
                    *(u32x4*)(H + o) = hb;
                    ssq += ((x0[0] * x0[0] + x0[1] * x0[1]) + (x0[2] * x0[2] + x0[3] * x0[3])) + ((x1[0] * x1[0] + x1[1] * x1[1]) + (x1[2] * x1[2] + x1[3] * x1[3])); }
                ssq += __shfl_xor(ssq, 16); ssq += __shfl_xor(ssq, 32);
                if (fq == 0) part[(ai * HALF + wr * 64 + m * 16 + fr) * 4 + wc] = ssq; }
        asm volatile("s_waitcnt lgkmcnt(0)" ::: "memory"); __builtin_amdgcn_s_barrier(); asm volatile("" ::: "memory");
        const int t = threadIdx.x;
        if (t < 256) { const f32x4 p = *(const LAS f32x4*)(part + t * 4); rss[(size_t)u.pn * NTOK + u.pm * BM + t] = (p[0] + p[1]) + (p[2] + p[3]); }
    }
};
struct EpiResF32 {
    static constexpr bool PERM = true;
    const float* res; float* O; int ldc;
    __device__ __forceinline__ void operator()(const f32x4 (&acc)[2][2][4][2], const Unit& u, int wr, int wc, int fr, int fq, LAS unsigned char*) const {
        const int row0 = u.pm * BM + wr * 64 + fr; const int col0 = u.pn * BM + wc * 32 + 8 * fq;
#pragma unroll
        for (int ai = 0; ai < 2; ++ai)
#pragma unroll
            for (int m = 0; m < 4; ++m) { const size_t ro = (size_t)(row0 + ai * HALF + m * 16) * ldc + col0;
#pragma unroll
                for (int bj = 0; bj < 2; ++bj) { const size_t o = ro + bj * HALF; const f32x4 r0 = *(const f32x4*)(res + o), r1 = *(const f32x4*)(res + o + 4);
                    *(f32x4*)(O + o) = r0 + acc[ai][bj][m][0]; *(f32x4*)(O + o + 4) = r1 + acc[ai][bj][m][1]; } }
    }
};

template <class Epi, class Sched>
__device__ __forceinline__ void gemm_phase(LAS unsigned char* lds, const Gemm g, const Sched& S, const Epi& E) {
    const int tid = otid(), wid = __builtin_amdgcn_readfirstlane(tid >> 6), lane = tid & 63, wr = wid >> 2, wc = wid & 3, fr = lane & 15, fq = lane >> 4;
    const int K = g.K, nt = K / BK, lda = g.lda;
    unsigned voffA[2], voffB[2];
#pragma unroll
    for (int i = 0; i < 2; ++i) { int R, C; stage_rc(tid * 16 + i * 8192, R, C); const int Rb = Epi::PERM ? ((R & ~31) + perm32(R & 31)) : R;
        voffA[i] = (unsigned)(R * lda + C) * 2u; voffB[i] = (unsigned)(Rb * K + C) * 2u; }
    const size_t kstep = (size_t)(BK * 2);
    const size_t hstepA = (size_t)HALF * lda * 2, hstepB = (size_t)HALF * K * 2;
    const size_t tstepA = 2 * hstepA, tstepB = 2 * hstepB;
    const unsigned ldsw = (unsigned)wid * 1024u;
    const int aoff = lds_byte(wr * 64 + fr, fq * 8), boff = lds_byte(wc * 32 + fr, fq * 8);
#define PG8_SA(b, h) (((b) * 2 + (h)) * HTB)
#define PG8_SB(b, h) ((4 + (b) * 2 + (h)) * HTB)
#define PG8_STAGE(bufoff, gbase, voff) do { _Pragma("unroll") for (int _i = 0; _i < 2; ++_i) \
        __builtin_amdgcn_global_load_lds((const unsigned*)((const char*)(gbase) + (voff)[_i]), (LAS unsigned*)(lds + (bufoff) + ldsw + _i * 8192), 16, 0, 0); } while (0)
#define PG8_LDA(dst, b, h) do { _Pragma("unroll") for (int m = 0; m < 4; ++m) _Pragma("unroll") for (int k = 0; k < 2; ++k) dst[m][k] = *(const LAS bf16x8*)(lds + PG8_SA(b, h) + aoff + m * 2048 + k * 1024); } while (0)
#define PG8_LDB(dst, b, h) do { _Pragma("unroll") for (int n = 0; n < 2; ++n) _Pragma("unroll") for (int k = 0; k < 2; ++k) dst[n][k] = *(const LAS bf16x8*)(lds + PG8_SB(b, h) + boff + n * 2048 + k * 1024); } while (0)
#define PG8_MMA(ai, bj, At, Bt) do { __builtin_amdgcn_s_setprio(1); _Pragma("unroll") for (int m = 0; m < 4; ++m) _Pragma("unroll") for (int n = 0; n < 2; ++n) _Pragma("unroll") for (int k = 0; k < 2; ++k) \
        acc[ai][bj][m][n] = __builtin_amdgcn_mfma_f32_16x16x32_bf16(Bt[n][k], At[m][k], acc[ai][bj][m][n], 0, 0, 0); __builtin_amdgcn_s_setprio(0); } while (0)
#define PG8_WAIT_V(n) asm volatile("s_waitcnt vmcnt(" #n ")" ::: "memory")
#define PG8_WAIT_L(n) asm volatile("s_waitcnt lgkmcnt(" #n ")" ::: "memory")
#define PG8_BAR __builtin_amdgcn_s_barrier()
#define PG8_SCHED __builtin_amdgcn_sched_barrier(0)
    Unit cur, nxt; int ui = 0;
    if (!S.next(0, cur)) return;
    f32x4 acc[2][2][4][2];
#pragma unroll
    for (int a = 0; a < 2; ++a)
#pragma unroll
        for (int b = 0; b < 2; ++b)
#pragma unroll
            for (int m = 0; m < 4; ++m)
#pragma unroll
                for (int n = 0; n < 2; ++n) acc[a][b][m][n] = (f32x4){0.f, 0.f, 0.f, 0.f};
    bf16x8 At[4][2], B0[2][2], B1[2][2];
    const char* cA = (const char*)g.A + (size_t)cur.pm * tstepA; const char* cB = (const char*)g.Bt + (size_t)cur.pn * tstepB;
    PG8_STAGE(PG8_SB(0, 0), cB, voffB); PG8_STAGE(PG8_SB(0, 1), cB + hstepB, voffB); PG8_STAGE(PG8_SA(0, 0), cA, voffA); PG8_STAGE(PG8_SA(0, 1), cA + hstepA, voffA);
    if (wr == 1) PG8_BAR;
    PG8_WAIT_V(2); PG8_BAR;
    PG8_STAGE(PG8_SB(1, 0), cB + kstep, voffB); PG8_STAGE(PG8_SA(1, 0), cA + kstep, voffA); PG8_STAGE(PG8_SB(1, 1), cB + hstepB + kstep, voffB);
    PG8_WAIT_V(6); PG8_BAR;
    for (;;) {
        const bool has_next = S.next(ui + 1, nxt);
        const char* nA = has_next ? (const char*)g.A + (size_t)nxt.pm * tstepA : cA; const char* nB = has_next ? (const char*)g.Bt + (size_t)nxt.pn * tstepB : cB;
        for (int t = 0; t < nt; t += 2) {
            const bool last = (t == nt - 2);
            const char* a1 = cA + (size_t)(t + 1) * kstep;
            const char* a2 = last ? nA : cA + (size_t)(t + 2) * kstep; const char* b2 = last ? nB : cB + (size_t)(t + 2) * kstep;
            const char* a3 = a2 + kstep; const char* b3 = b2 + kstep;
            PG8_LDB(B0, 0, 0); PG8_LDB(B1, 0, 1); PG8_SCHED; PG8_LDA(At, 0, 0); PG8_STAGE(PG8_SA(1, 1), a1 + hstepA, voffA);
            PG8_WAIT_V(8); PG8_WAIT_L(0); PG8_BAR; PG8_MMA(0, 0, At, B0); PG8_MMA(0, 1, At, B1); PG8_BAR; PG8_SCHED;
            PG8_LDA(At, 0, 1); PG8_STAGE(PG8_SB(0, 0), b2, voffB); PG8_STAGE(PG8_SB(0, 1), b2 + hstepB, voffB); PG8_STAGE(PG8_SA(0, 0), a2, voffA);
            PG8_WAIT_V(8); PG8_WAIT_L(0); PG8_BAR; PG8_MMA(1, 0, At, B0); PG8_MMA(1, 1, At, B1); PG8_BAR; PG8_SCHED;
            PG8_LDB(B0, 1, 0); PG8_LDB(B1, 1, 1); PG8_SCHED; PG8_LDA(At, 1, 0); PG8_STAGE(PG8_SA(0, 1), a2 + hstepA, voffA);
            PG8_WAIT_V(8); PG8_WAIT_L(0); PG8_BAR; PG8_MMA(0, 0, At, B0); PG8_MMA(0, 1, At, B1); PG8_BAR; PG8_SCHED;
            PG8_LDA(At, 1, 1); PG8_STAGE(PG8_SB(1, 0), b3, voffB); PG8_STAGE(PG8_SB(1, 1), b3 + hstepB, voffB); PG8_STAGE(PG8_SA(1, 0), a3, voffA);
            PG8_WAIT_V(8); PG8_WAIT_L(0); PG8_BAR; PG8_MMA(1, 0, At, B0); PG8_MMA(1, 1, At, B1); PG8_BAR; PG8_SCHED;
        }
        if (wr == 0) PG8_BAR;
        E(acc, cur, wr, wc, fr, fq, lds);
        if (!has_next) break;
#pragma unroll
        for (int a = 0; a < 2; ++a)
#pragma unroll
            for (int b = 0; b < 2; ++b)
#pragma unroll
                for (int m = 0; m < 4; ++m)
#pragma unroll
                    for (int n = 0; n < 2; ++n) acc[a][b][m][n] = (f32x4){0.f, 0.f, 0.f, 0.f};
        cur = nxt; cA = nA; cB = nB; ++ui;
        if (wr == 1) PG8_BAR;
    }
    PG8_WAIT_V(0);
    PG8_BAR;
#undef PG8_SA
#undef PG8_SB
#undef PG8_STAGE
#undef PG8_LDA
#undef PG8_LDB
#undef PG8_MMA
#undef PG8_WAIT_V
#undef PG8_WAIT_L
#undef PG8_BAR
#undef PG8_SCHED
}
}

__device__ __forceinline__ void transpose_item(const float* W, int ldw, int K, int ncols, bf16_t* WT, int row_off, LAS float* scr, int item, int lane) {
    const int nblk = ncols / 64, kb = item / nblk, nb = item % nblk, k0 = 64 * kb, n0 = 64 * nb;
    f32x4 v[16];
#pragma unroll
    for (int i = 0; i < 16; ++i) v[i] = *(const f32x4*)(W + (size_t)(k0 + 4 * i + (lane >> 4)) * ldw + n0 + (lane & 15) * 4);
#pragma unroll
    for (int i = 0; i < 16; ++i) { LAS float* d = scr + (4 * i + (lane >> 4)) * 65 + (lane & 15) * 4; d[0] = v[i].x; d[1] = v[i].y; d[2] = v[i].z; d[3] = v[i].w; }
    LDS_WAIT();
    const int c = lane & 7;
#pragma unroll
    for (int j = 0; j < 8; ++j) { const int n = (lane >> 3) + 8 * j; const LAS float* s = scr + (8 * c) * 65 + n;
        u32x4 o; o.x = pk2(s[0 * 65], s[1 * 65]); o.y = pk2(s[2 * 65], s[3 * 65]); o.z = pk2(s[4 * 65], s[5 * 65]); o.w = pk2(s[6 * 65], s[7 * 65]);
        *(u32x4*)(WT + (size_t)(row_off + n0 + n) * K + k0 + 8 * c) = o; }
    LDS_WAIT();
}
struct RowSet { f32x4 v[4][4]; };
__device__ __forceinline__ void norm_rows_load(const Args& a, int m0, int NGW, int lane, RowSet& r) {
    constexpr int NROWS = NTOK + 2 * NMEM;
#pragma unroll
    for (int q = 0; q < 4; ++q) { int m = m0 + q * NGW; if (m >= NROWS) m = m0;
        const float* xrow = (m < NTOK) ? a.x + (size_t)m * DM : a.mem + (size_t)((m - NTOK) & (NMEM - 1)) * DM;
#pragma unroll
        for (int j = 0; j < 4; ++j) r.v[q][j] = ((const f32x4*)xrow + lane)[64 * j]; }
}
__device__ __forceinline__ void norm_phase(const Args& a) {
    const int tid = otid(); const int lane = tid & 63, gw = blockIdx.x * 8 + (tid >> 6), NGW = gridDim.x * 8;
    bf16_t* H = (bf16_t*)(a.ws + WS_H); float* rss = (float*)(a.ws + WS_RSS);
    constexpr int NROWS = NTOK + 2 * NMEM;
    f32x4 gx[4], gm0[4], gm1[4];
#pragma unroll
    for (int j = 0; j < 4; ++j) { gx[j] = ((const f32x4*)a.norm_g + lane)[64 * j]; gm0[j] = ((const f32x4*)a.mng + lane)[64 * j]; gm1[j] = ((const f32x4*)(a.mng + DM) + lane)[64 * j]; }
    RowSet cur; norm_rows_load(a, gw < NROWS ? gw : 0, NGW, lane, cur);
    for (int m0 = gw; m0 < NROWS; m0 += 4 * NGW) {
        float sacc[4];
#pragma unroll
        for (int q = 0; q < 4; ++q) { sacc[q] = 0.f;
#pragma unroll
            for (int j = 0; j < 4; ++j) sacc[q] += (cur.v[q][j].x * cur.v[q][j].x + cur.v[q][j].y * cur.v[q][j].y) + (cur.v[q][j].z * cur.v[q][j].z + cur.v[q][j].w * cur.v[q][j].w); }
        asm volatile("" ::: "memory");
        RowSet nxt; norm_rows_load(a, (m0 + 4 * NGW < NROWS) ? m0 + 4 * NGW : m0, NGW, lane, nxt);
#pragma unroll
        for (int q = 0; q < 4; ++q) {
            int m = m0 + q * NGW; if (m >= NROWS) m = m0;
            const bool tokrow = m < NTOK; const int qq = (m - NTOK) & (NMEM - 1), l = (m - NTOK) >> 11;
            bf16_t* op = tokrow ? H + (size_t)m * DM : (bf16_t*)(a.ws + (l ? WS_MEMH1 : WS_MEMH)) + (size_t)qq * DM;
            const float tot = wave_sum(sacc[q]);
            const float rr = tokrow ? 1.f : 1.f / sqrtf(tot * (1.f / DM) + EPS);
            unsigned long long* o8 = (unsigned long long*)op + lane;
#pragma unroll
            for (int j = 0; j < 4; ++j) { const f32x4 gg = tokrow ? gx[j] : (l ? gm1[j] : gm0[j]); const f32x4 v = cur.v[q][j];
                o8[64 * j] = (unsigned long long)pk2(v.x * rr * gg.x, v.y * rr * gg.y) | ((unsigned long long)pk2(v.z * rr * gg.z, v.w * rr * gg.w) << 32); }
            if (tokrow && lane < 4) rss[lane * NTOK + m] = (lane == 0) ? tot : 0.f;
        }
        cur = nxt;
    }
}
__device__ __forceinline__ void p0_phase(const Args& a, LAS unsigned char* lds) {
    const int tid = otid(), lane = tid & 63, wave = tid >> 6;
    LAS float* scr = (LAS float*)(lds + wave * 17408);
    const int gw = blockIdx.x * 8 + wave, NGW = gridDim.x * 8;
    bf16_t* WinT = (bf16_t*)(a.ws + WS_WIN); bf16_t* WoutT = (bf16_t*)(a.ws + WS_WOUT); bf16_t* WmemT = (bf16_t*)(a.ws + WS_WMEM);
    for (int it = gw; it < 3840; it += NGW) {
        const int l = it / 1920; int r = it % 1920;
        if (r < 1280) { const int seg = r >> 7, sub = r & 127; const int oseg = (int)((0x2154987630ULL >> (4 * seg)) & 15ULL);
            transpose_item(a.w_in + (size_t)l * DM * NIN + oseg * 512, NIN, DM, 512, WinT + (size_t)l * NIN * DM, seg * 512, scr, sub, lane); }
        else if (r < 1664) { r -= 1280; transpose_item(a.w_out + (size_t)l * DMIX * DM, DM, DMIX, DM, WoutT + (size_t)l * DM * DMIX, 0, scr, r, lane); }
        else { r -= 1664; transpose_item(a.wmem + (size_t)l * DM * DM, DM, DM, DM, WmemT + (size_t)l * DM * DM, 0, scr, r, lane); }
    }
    float* rope = (float*)(a.ws + WS_ROPE);
    for (int e = blockIdx.x * 512 + tid; e < NTOK * 8; e += gridDim.x * 512) {
        const int tok = e >> 3, i = e & 7;
        const float inv = powf(500000.0f, -(float)i * 0.125f);
        const float ang = (float)a.pos[tok] * inv;
        const double ad = (double)ang; const double n = rint(ad * 0.15915494309189535); const float rr = (float)(ad - n * 6.283185307179586);
        rope[tok * 16 + i] = __cosf(rr); rope[tok * 16 + 8 + i] = __sinf(rr);
    }
    if (blockIdx.x == 0) { float* LB = (float*)(a.ws + WS_LB); LB[tid] = 0.f; const float l0 = a.lbl[tid], l1 = a.lbl[512 + tid]; LB[512 + tid] = 1.f / (1.f + expf(l0 - l1)); }
    norm_phase(a);
}

#define BAR_LDS() do { asm volatile("s_waitcnt lgkmcnt(0)" ::: "memory"); __builtin_amdgcn_s_barrier(); asm volatile("" ::: "memory"); } while (0)
struct PrepIn { u32x4 q[4], k[4]; float cs[8], sn[8]; };
__device__ __forceinline__ void moba_prep_load(const Args& a, int tid, int u, PrepIn& r) {
    const int b = u >> 6, j = (u >> 3) & 7, h = u & 7, tok = tid >> 1, half = tid & 1;
    const size_t row = (size_t)b * SEQ + j * 256 + tok;
    const bf16_t* p = (const bf16_t*)(a.ws + WS_PROJ) + row * NCOL + h * 64 + half * 32;
    const bf16_t* pk = (const bf16_t*)(a.ws + WS_KC) + ((size_t)(b * 8 + h) * SEQ + j * 256 + tok) * 64 + half * 32;
#pragma unroll
    for (int c = 0; c < 4; ++c) { r.q[c] = *(const u32x4*)(p + CQA + c * 8); r.k[c] = *(const u32x4*)(pk + c * 8); }
    const f32x4* rope = (const f32x4*)((const float*)(a.ws + WS_ROPE) + row * 16);
    const f32x4 c0 = rope[0], c1 = rope[1], s0 = rope[2], s1 = rope[3];
    r.cs[0] = c0.x; r.cs[1] = c0.y; r.cs[2] = c0.z; r.cs[3] = c0.w; r.cs[4] = c1.x; r.cs[5] = c1.y; r.cs[6] = c1.z; r.cs[7] = c1.w;
    r.sn[0] = s0.x; r.sn[1] = s0.y; r.sn[2] = s0.z; r.sn[3] = s0.w; r.sn[4] = s1.x; r.sn[5] = s1.y; r.sn[6] = s1.z; r.sn[7] = s1.w;
}
__device__ __forceinline__ void moba_prep_unit(const Args& a, int l, LAS unsigned char* lds, int tid, int u, const PrepIn& in, PrepIn& nxt, int unext) {
    const int b = u >> 6, j = (u >> 3) & 7, h = u & 7, tok = tid >> 1, half = tid & 1;
    bf16_t* proj = (bf16_t*)(a.ws + WS_PROJ);
    const size_t row = (size_t)b * SEQ + j * 256 + tok;
    LAS float* kt = (LAS float*)lds;
    LAS float* part = (LAS float*)(lds + 66560);
    float vq[32], vk[32];
#pragma unroll
    for (int c = 0; c < 4; ++c) { const u32x4 uq = in.q[c], uk = in.k[c];
        vq[c * 8 + 0] = bflo(uq.x); vq[c * 8 + 1] = bfhi(uq.x); vq[c * 8 + 2] = bflo(uq.y); vq[c * 8 + 3] = bfhi(uq.y); vq[c * 8 + 4] = bflo(uq.z); vq[c * 8 + 5] = bfhi(uq.z); vq[c * 8 + 6] = bflo(uq.w); vq[c * 8 + 7] = bfhi(uq.w);
        vk[c * 8 + 0] = bflo(uk.x); vk[c * 8 + 1] = bfhi(uk.x); vk[c * 8 + 2] = bflo(uk.y); vk[c * 8 + 3] = bfhi(uk.y); vk[c * 8 + 4] = bflo(uk.z); vk[c * 8 + 5] = bfhi(uk.z); vk[c * 8 + 6] = bflo(uk.w); vk[c * 8 + 7] = bfhi(uk.w); }
    float cs[8], sn[8];
#pragma unroll
    for (int i = 0; i < 8; ++i) { cs[i] = in.cs[i]; sn[i] = in.sn[i]; }
    asm volatile("" ::: "memory");
    moba_prep_load(a, tid, unext, nxt);
#pragma unroll
    for (int which = 0; which < 2; ++which) {
        bf16_t* p = which ? (bf16_t*)(a.ws + WS_KC) + ((size_t)(b * 8 + h) * SEQ + j * 256 + tok) * 64 + half * 32 : proj + row * NCOL + CQA + h * 64 + half * 32;
        const LAS float* g = (const LAS float*)(lds + 68608) + which * 64 + half * 32;
        float v[32]; float ss = 0.f;
#pragma unroll
        for (int i = 0; i < 32; ++i) { v[i] = which ? vk[i] : vq[i]; ss += v[i] * v[i]; }
        ss += __shfl_xor(ss, 1);
        const float r = frsq(ss * (1.f / 64.f) + EPS) * (which ? 1.f : 0.125f * LOG2E);
#pragma unroll
        for (int c = 0; c < 8; ++c) { const f32x4 gg = *(const LAS f32x4*)(g + c * 4); v[c * 4] *= r * gg.x; v[c * 4 + 1] *= r * gg.y; v[c * 4 + 2] *= r * gg.z; v[c * 4 + 3] *= r * gg.w; }
        if (half == 0) {
#pragma unroll
            for (int i = 0; i < 8; ++i) { const float x1 = v[i], x2 = v[8 + i]; v[i] = x1 * cs[i] - x2 * sn[i]; v[8 + i] = x2 * cs[i] + x1 * sn[i]; }
        }
#pragma unroll
        for (int c = 0; c < 4; ++c) { u32x4 uu; uu.x = pk2(v[c * 8 + 0], v[c * 8 + 1]); uu.y = pk2(v[c * 8 + 2], v[c * 8 + 3]); uu.z = pk2(v[c * 8 + 4], v[c * 8 + 5]); uu.w = pk2(v[c * 8 + 6], v[c * 8 + 7]);
            *(u32x4*)(p + c * 8) = uu; }
        if (which == 1) {
#pragma unroll
            for (int i = 0; i < 32; ++i) kt[tok * 65 + half * 32 + i] = v[i];
        }
    }
    BAR_LDS();
    {
        const int d = tid & 63, pt = tid >> 6; float sacc = 0.f;
#pragma unroll 8
        for (int t = 0; t < 32; ++t) sacc += kt[(pt * 32 + t) * 65 + d];
        part[pt * 64 + d] = sacc;
    }
    BAR_LDS();
    if (tid < 64) { float sacc = 0.f;
#pragma unroll
        for (int p = 0; p < 8; ++p) sacc += part[p * 64 + tid];
        ((float*)(a.ws + WS_KMEAN))[((size_t)(b * 8 + h) * 8 + j) * 64 + tid] = sacc * (1.f / 256.f); }
    BAR_LDS();
}

struct HIn { u32x4 f[2], q[2], v[2]; };
template <bool NEEDQ>
__device__ __forceinline__ void hgrn_load(const Args& a, int tid, int u, HIn& r) {
    const int bh = u >> 5, c = u & 31, b = bh >> 2, hh = bh & 3; const size_t row0 = (size_t)b * SEQ + c * 64;
#pragma unroll
    for (int ii = 0; ii < 2; ++ii) { const int cid = tid + 512 * ii, t = cid >> 4, d0 = (cid & 15) * 8;
        const bf16_t* p = (const bf16_t*)(a.ws + WS_PROJ) + (row0 + t) * NCOL + hh * 128 + d0;
        r.f[ii] = *(const u32x4*)(p + CFH); r.v[ii] = *(const u32x4*)(p + CIH); if (NEEDQ) r.q[ii] = *(const u32x4*)(p + CQH); }
}
__device__ __forceinline__ void hgrn_stepA(const Args& a, int l, LAS unsigned char* lds, int tid, int hh, const HIn& in, float (&kf)[16]) {
    LAS float* LF = (LAS float*)lds;
    LAS float* PT = (LAS float*)(lds + 32768);
#pragma unroll
    for (int ii = 0; ii < 2; ++ii) {
        const int cid = tid + 512 * ii, t = cid >> 4, d0 = (cid & 15) * 8;
        const u32x4 u = in.f[ii];
        float fl[8] = {bflo(u.x), bfhi(u.x), bflo(u.y), bfhi(u.y), bflo(u.z), bfhi(u.z), bflo(u.w), bfhi(u.w)};
        float lf[8];
        const LAS float* LB = (const LAS float*)(lds + 106496) + hh * 128 + d0; const f32x4 lb0 = *(const LAS f32x4*)LB, lb1 = *(const LAS f32x4*)(LB + 4);
        const float lbv[8] = {lb0.x, lb0.y, lb0.z, lb0.w, lb1.x, lb1.y, lb1.z, lb1.w};
#pragma unroll
        for (int i = 0; i < 8; ++i) { const float lb = lbv[i]; const float sg = sigm(fl[i]);
            const float f = lb + (1.f - lb) * sg; lf[i] = __logf(f); kf[ii * 8 + i] = (1.f - lb) * (1.f - sg); }
        *(LAS f32x4*)(LF + t * 128 + d0) = (f32x4){lf[0], lf[1], lf[2], lf[3]}; *(LAS f32x4*)(LF + t * 128 + d0 + 4) = (f32x4){lf[4], lf[5], lf[6], lf[7]};
    }
}
__device__ __forceinline__ void hgrn_cumsum_scan(LAS unsigned char* lds, int tid) {
    LAS float* LF = (LAS float*)lds;
    LAS float* PT = (LAS float*)(lds + 32768);
    BAR_LDS();
    const int d = tid & 127, pt = tid >> 7;
    float v[16];
#pragma unroll
    for (int t = 0; t < 16; ++t) v[t] = LF[(pt * 16 + t) * 128 + d];
#pragma unroll
    for (int t = 1; t < 16; ++t) v[t] += v[t - 1];
    PT[pt * 128 + d] = v[15];
    BAR_LDS();
    { float off = 0.f;
#pragma unroll
      for (int p = 0; p < 3; ++p) off += (p < pt) ? PT[p * 128 + d] : 0.f;
#pragma unroll
      for (int t = 0; t < 16; ++t) LF[(pt * 16 + t) * 128 + d] = v[t] + off; }
    BAR_LDS();
}
__device__ __forceinline__ void hgrn_stage1_unit(const Args& a, int l, LAS unsigned char* lds, int tid, int u, const HIn& in, HIn& nxt, int unext) {
    const int lane = tid & 63, w = __builtin_amdgcn_readfirstlane(tid >> 6), fr = lane & 15, fq = lane >> 4;
    const int bh = u >> 5, c = u & 31, hh = bh & 3;
    LAS float* LF = (LAS float*)lds;
    LAS unsigned char* KN = lds + 34816;
    LAS unsigned char* VN = lds + 34816 + 18432;
    float kf[16];
    hgrn_stepA(a, l, lds, tid, hh, in, kf);
    hgrn_load<false>(a, tid, unext, nxt);
    hgrn_cumsum_scan(lds, tid);
    if (tid < 128) ((float*)(a.ws + WS_DECAY))[((size_t)bh * 32 + c) * 128 + tid] = fexp(LF[63 * 128 + tid]);
#pragma unroll
    for (int ii = 0; ii < 2; ++ii) {
        const int cid = tid + 512 * ii, t = cid >> 4, d0 = (cid & 15) * 8;
        const f32x4 ae0 = *(const LAS f32x4*)(LF + 63 * 128 + d0), ae1 = *(const LAS f32x4*)(LF + 63 * 128 + d0 + 4), at0 = *(const LAS f32x4*)(LF + t * 128 + d0), at1 = *(const LAS f32x4*)(LF + t * 128 + d0 + 4);
        const f32x4 e0 = ae0 - at0, e1 = ae1 - at1;
        u32x4 o; o.x = pk2(kf[ii * 8 + 0] * fexp(e0.x), kf[ii * 8 + 1] * fexp(e0.y)); o.y = pk2(kf[ii * 8 + 2] * fexp(e0.z), kf[ii * 8 + 3] * fexp(e0.w));
        o.z = pk2(kf[ii * 8 + 4] * fexp(e1.x), kf[ii * 8 + 5] * fexp(e1.y)); o.w = pk2(kf[ii * 8 + 6] * fexp(e1.z), kf[ii * 8 + 7] * fexp(e1.w));
        *(LAS u32x4*)(KN + t * 288 + d0 * 2) = o;
        *(LAS u32x4*)(VN + t * 288 + d0 * 2) = in.v[ii];
    }
    BAR_LDS();
    f32x4 acc[8];
#pragma unroll
    for (int n = 0; n < 8; ++n) acc[n] = (f32x4){0.f, 0.f, 0.f, 0.f};
#pragma unroll
    for (int ks = 0; ks < 2; ++ks) {
        const s16x4 alo = tr4(VN, 288, ks * 32 + fq * 4, w * 16, fr), ahi = tr4(VN, 288, ks * 32 + 16 + fq * 4, w * 16, fr);
        const bf16x8 af = __builtin_shufflevector(alo, ahi, 0, 1, 2, 3, 4, 5, 6, 7);
#pragma unroll
        for (int n = 0; n < 8; ++n) { const s16x4 blo = tr4(KN, 288, ks * 32 + fq * 4, n * 16, fr), bhi = tr4(KN, 288, ks * 32 + 16 + fq * 4, n * 16, fr);
            const bf16x8 bfr = __builtin_shufflevector(blo, bhi, 0, 1, 2, 3, 4, 5, 6, 7); acc[n] = MFMA16(bfr, af, acc[n]); }
    }
    bf16_t* ST = (bf16_t*)(a.ws + WS_H) + ((size_t)bh * 32 + c) * 16384;
#pragma unroll
    for (int n = 0; n < 8; ++n) { u32x2 o; o.x = pk2(acc[n][0], acc[n][1]); o.y = pk2(acc[n][2], acc[n][3]); *(u32x2*)(ST + (w * 16 + fr) * 128 + n * 16 + fq * 4) = o; }
    BAR_LDS();
}
__device__ __forceinline__ void hgrn_scan_phase(const Args& a) {
    const int id = blockIdx.x * 512 + otid(), NT = gridDim.x * 512;
    for (int it = id; it < 32 * 128 * 32; it += NT) {
        const int bh = it >> 12, dv = (it >> 5) & 127, dkc = it & 31;
        u32x2* st = (u32x2*)((bf16_t*)(a.ws + WS_H) + (size_t)bh * 32 * 16384 + dv * 128 + dkc * 4);
        const f32x4* dc = (const f32x4*)((const float*)(a.ws + WS_DECAY) + (size_t)bh * 32 * 128 + dkc * 4);
        float r0 = 0.f, r1 = 0.f, r2 = 0.f, r3 = 0.f;
#pragma unroll 8
        for (int c = 0; c < 32; ++c) {
            const u32x2 u = st[(size_t)c * 4096]; const f32x4 dd = dc[c * 32];
            u32x2 o; o.x = pk2(r0, r1); o.y = pk2(r2, r3); st[(size_t)c * 4096] = o;
            r0 = dd.x * r0 + bflo(u.x); r1 = dd.y * r1 + bfhi(u.x); r2 = dd.z * r2 + bflo(u.y); r3 = dd.w * r3 + bfhi(u.y);
        }
    }
}
__device__ __forceinline__ void hgrn_stage3_unit(const Args& a, int l, LAS unsigned char* lds, int tid, int u, const HIn& in, HIn& nxt, int unext) {
    const int lane = tid & 63, w = __builtin_amdgcn_readfirstlane(tid >> 6), fr = lane & 15, fq = lane >> 4;
    const int bh = u >> 5, c = u & 31, b = bh >> 2, hh = bh & 3; const size_t row0 = (size_t)b * SEQ + c * 64;
    const int tt = w & 3, vh = w >> 2;
    bf16_t* proj = (bf16_t*)(a.ws + WS_PROJ);
    LAS float* LF = (LAS float*)lds;
    LAS unsigned char* QM = lds + 34816;
    LAS unsigned char* Q0 = QM + 17408;
    LAS unsigned char* KM = Q0 + 17408;
    LAS unsigned char* VN = KM + 17408;
    LAS float* SSQ = (LAS float*)(VN + 18432);
    float kf[16];
    hgrn_stepA(a, l, lds, tid, hh, in, kf);
    const size_t row = row0 + tt * 16 + fr;
    const bf16_t* ST = (const bf16_t*)(a.ws + WS_H) + ((size_t)bh * 32 + c) * 16384;
    bf16x8 stf[4][4]; u32x2 zz[4];
#pragma unroll
    for (int ks = 0; ks < 4; ++ks)
#pragma unroll
        for (int v = 0; v < 4; ++v) stf[ks][v] = *(const bf16x8*)(ST + ((vh * 4 + v) * 16 + fr) * 128 + ks * 32 + fq * 8);
#pragma unroll
    for (int v = 0; v < 4; ++v) zz[v] = *(const u32x2*)(proj + row * NCOL + CZ + 512 + hh * 128 + (vh * 4 + v) * 16 + fq * 4);
    hgrn_load<true>(a, tid, unext, nxt);
    hgrn_cumsum_scan(lds, tid);
#pragma unroll
    for (int ii = 0; ii < 2; ++ii) {
        const int cid = tid + 512 * ii, t = cid >> 4, d0 = (cid & 15) * 8;
        const u32x4 uq = in.q[ii];
        float q[8] = {bflo(uq.x), bfhi(uq.x), bflo(uq.y), bfhi(uq.y), bflo(uq.z), bfhi(uq.z), bflo(uq.w), bfhi(uq.w)};
        float qm[8], q0[8], km[8];
        const f32x4 at0 = *(const LAS f32x4*)(LF + t * 128 + d0), at1 = *(const LAS f32x4*)(LF + t * 128 + d0 + 4), am0 = *(const LAS f32x4*)(LF + 31 * 128 + d0), am1 = *(const LAS f32x4*)(LF + 31 * 128 + d0 + 4);
        const float Atv[8] = {at0.x, at0.y, at0.z, at0.w, at1.x, at1.y, at1.z, at1.w}, Amv[8] = {am0.x, am0.y, am0.z, am0.w, am1.x, am1.y, am1.z, am1.w};
#pragma unroll
        for (int i = 0; i < 8; ++i) { const float At = Atv[i], Am = Amv[i]; const float sq = silu(q[i]);
            qm[i] = sq * fexp(At - Am); q0[i] = sq * fexp(At); km[i] = kf[ii * 8 + i] * fexp(Am - At); }
        u32x4 o;
        o.x = pk2(qm[0], qm[1]); o.y = pk2(qm[2], qm[3]); o.z = pk2(qm[4], qm[5]); o.w = pk2(qm[6], qm[7]); *(LAS u32x4*)(QM + t * 272 + d0 * 2) = o;
        o.x = pk2(q0[0], q0[1]); o.y = pk2(q0[2], q0[3]); o.z = pk2(q0[4], q0[5]); o.w = pk2(q0[6], q0[7]); *(LAS u32x4*)(Q0 + t * 272 + d0 * 2) = o;
        o.x = pk2(km[0], km[1]); o.y = pk2(km[2], km[3]); o.z = pk2(km[4], km[5]); o.w = pk2(km[6], km[7]); *(LAS u32x4*)(KM + t * 272 + d0 * 2) = o;
        *(LAS u32x4*)(VN + t * 288 + d0 * 2) = in.v[ii];
    }
    BAR_LDS();
    f32x4 sc[4];
#pragma unroll
    for (int s = 0; s < 4; ++s) sc[s] = (f32x4){0.f, 0.f, 0.f, 0.f};
#pragma unroll
    for (int ks = 0; ks < 4; ++ks) {
        const bf16x8 qf = *(const LAS bf16x8*)(QM + (tt * 16 + fr) * 272 + (ks * 32 + fq * 8) * 2);
#pragma unroll
        for (int s = 0; s < 4; ++s) if (s <= tt) { const bf16x8 kfr = *(const LAS bf16x8*)(KM + (s * 16 + fr) * 272 + (ks * 32 + fq * 8) * 2); sc[s] = MFMA16(kfr, qf, sc[s]); }
    }
#pragma unroll
    for (int s = 0; s < 4; ++s)
#pragma unroll
        for (int jj = 0; jj < 4; ++jj) { const bool ok = (s < tt) || (s == tt && (fq * 4 + jj) <= fr); sc[s][jj] = ok ? sc[s][jj] : 0.f; }
    f32x4 o[4];
#pragma unroll
    for (int v = 0; v < 4; ++v) o[v] = (f32x4){0.f, 0.f, 0.f, 0.f};
#pragma unroll
    for (int kst = 0; kst < 2; ++kst) {
        if (kst * 2 <= tt) {
            u32x4 pw; pw.x = pk2(sc[2 * kst][0], sc[2 * kst][1]); pw.y = pk2(sc[2 * kst][2], sc[2 * kst][3]); pw.z = pk2(sc[2 * kst + 1][0], sc[2 * kst + 1][1]); pw.w = pk2(sc[2 * kst + 1][2], sc[2 * kst + 1][3]);
            const bf16x8 pb = __builtin_bit_cast(bf16x8, pw);
#pragma unroll
            for (int v = 0; v < 4; ++v) { const s16x4 lo = tr4(VN, 288, kst * 32 + fq * 4, (vh * 4 + v) * 16, fr), hi = tr4(VN, 288, kst * 32 + 16 + fq * 4, (vh * 4 + v) * 16, fr);
                const bf16x8 vf = __builtin_shufflevector(lo, hi, 0, 1, 2, 3, 4, 5, 6, 7);
                o[v] = MFMA16(vf, pb, o[v]); }
        }
    }
#pragma unroll
    for (int ks = 0; ks < 4; ++ks) {
        const bf16x8 q0f = *(const LAS bf16x8*)(Q0 + (tt * 16 + fr) * 272 + (ks * 32 + fq * 8) * 2);
#pragma unroll
        for (int v = 0; v < 4; ++v) o[v] = MFMA16(stf[ks][v], q0f, o[v]);
    }
    float ss = 0.f;
#pragma unroll
    for (int v = 0; v < 4; ++v)
#pragma unroll
        for (int jj = 0; jj < 4; ++jj) ss += o[v][jj] * o[v][jj];
    ss += __shfl_xor(ss, 16); ss += __shfl_xor(ss, 32);
    if (fq == 0) SSQ[vh * 64 + tt * 16 + fr] = ss;
    BAR_LDS();
    const float tot = SSQ[tt * 16 + fr] + SSQ[64 + tt * 16 + fr];
    const float r = frsq(tot * (1.f / 128.f) + EPS);
#pragma unroll
    for (int v = 0; v < 4; ++v) { const int v0 = (vh * 4 + v) * 16 + fq * 4;
        const f32x4 g = *(const LAS f32x4*)((const LAS float*)(lds + 106496 + 2048) + v0);
        const u32x2 z = zz[v];
        u32x2 y; y.x = pk2(o[v][0] * r * g.x * silu(bflo(z.x)), o[v][1] * r * g.y * silu(bfhi(z.x))); y.y = pk2(o[v][2] * r * g.z * silu(bflo(z.y)), o[v][3] * r * g.w * silu(bfhi(z.y)));
        *(u32x2*)(proj + row * NCOL + CQH + hh * 128 + v0) = y; }
    BAR_LDS();
}

template <int D, int QT0>
__device__ __forceinline__ void qk_tile(const LAS unsigned char* Ks, int KP, const bf16x8 (&qf)[2][D / 32], f32x4 (&s)[4][2], int fr, int fq, float b0, float b1) {
#pragma unroll
    for (int a = 0; a < 4; ++a) { s[a][0] = (f32x4){b0, b0, b0, b0}; s[a][1] = (f32x4){b1, b1, b1, b1}; }
#pragma unroll
    for (int a = 0; a < 4; ++a)
#pragma unroll
        for (int ks = 0; ks < D / 32; ++ks) { const bf16x8 kfr = *(const LAS bf16x8*)(Ks + (a * 16 + fr) * KP + (ks * 32 + fq * 8) * 2);
            if (QT0 == 0) s[a][0] = MFMA16(kfr, qf[0][ks], s[a][0]);
            s[a][1] = MFMA16(kfr, qf[1][ks], s[a][1]); }
}
#define ONES8 ((bf16x8){16256, 16256, 16256, 16256, 16256, 16256, 16256, 16256})
template <int D, bool DIAG, int QT0>
__device__ __forceinline__ void sm_pv_tile(f32x4 (&s)[4][2], const LAS unsigned char* Vs, int VP, f32x4 (&o)[D / 16][2], f32x4 (&ol)[2], int fr, int fq, int keyl0, int qla, int qlb) {
#pragma unroll
    for (int qt = QT0; qt < 2; ++qt) {
        if (DIAG) {
            const int ql = (qt == 0 ? qla : qlb) + fr - keyl0 - fq * 4;
#pragma unroll
            for (int a = 0; a < 4; ++a)
#pragma unroll
                for (int jj = 0; jj < 4; ++jj) s[a][qt][jj] = (a * 16 + jj > ql) ? -1e30f : s[a][qt][jj];
        }
#pragma unroll
        for (int a = 0; a < 4; ++a)
#pragma unroll
            for (int jj = 0; jj < 4; ++jj) s[a][qt][jj] = ex2(s[a][qt][jj]);
    }
#pragma unroll
    for (int kst = 0; kst < 2; ++kst) {
        bf16x8 pb[2];
#pragma unroll
        for (int qt = QT0; qt < 2; ++qt) { u32x4 pw; pw.x = pk2(s[2 * kst][qt][0], s[2 * kst][qt][1]); pw.y = pk2(s[2 * kst][qt][2], s[2 * kst][qt][3]);
            pw.z = pk2(s[2 * kst + 1][qt][0], s[2 * kst + 1][qt][1]); pw.w = pk2(s[2 * kst + 1][qt][2], s[2 * kst + 1][qt][3]); pb[qt] = __builtin_bit_cast(bf16x8, pw); }
        if (QT0 == 0) ol[0] = MFMA16(ONES8, pb[0], ol[0]);
        ol[1] = MFMA16(ONES8, pb[1], ol[1]);
#pragma unroll
        for (int dt = 0; dt < D / 16; ++dt) { const s16x4 lo = tr4(Vs, VP, kst * 32 + fq * 4, dt * 16, fr), hi = tr4(Vs, VP, kst * 32 + 16 + fq * 4, dt * 16, fr);
            const bf16x8 vf = __builtin_shufflevector(lo, hi, 0, 1, 2, 3, 4, 5, 6, 7);
            if (QT0 == 0) o[dt][0] = MFMA16(vf, pb[0], o[dt][0]);
            o[dt][1] = MFMA16(vf, pb[1], o[dt][1]); }
    }
}
__device__ __forceinline__ void sm_pv_tile128(f32x4 (&sa)[4][2], f32x4 (&sb)[4][2], const LAS unsigned char* Vs, int VP, f32x4 (&o)[4][2], f32x4 (&ol)[2], int fr, int fq) {
#pragma unroll
    for (int qt = 0; qt < 2; ++qt)
#pragma unroll
        for (int a = 0; a < 4; ++a)
#pragma unroll
            for (int jj = 0; jj < 4; ++jj) { sa[a][qt][jj] = ex2(sa[a][qt][jj]); sb[a][qt][jj] = ex2(sb[a][qt][jj]); }
#pragma unroll
    for (int half = 0; half < 2; ++half)
#pragma unroll
        for (int kst = 0; kst < 2; ++kst) {
            bf16x8 pb[2];
#pragma unroll
            for (int qt = 0; qt < 2; ++qt) { const f32x4 x0 = half ? sb[2 * kst][qt] : sa[2 * kst][qt], x1 = half ? sb[2 * kst + 1][qt] : sa[2 * kst + 1][qt];
                u32x4 pw; pw.x = pk2(x0[0], x0[1]); pw.y = pk2(x0[2], x0[3]); pw.z = pk2(x1[0], x1[1]); pw.w = pk2(x1[2], x1[3]); pb[qt] = __builtin_bit_cast(bf16x8, pw); }
            ol[0] = MFMA16(ONES8, pb[0], ol[0]); ol[1] = MFMA16(ONES8, pb[1], ol[1]);
#pragma unroll
            for (int dt = 0; dt < 4; ++dt) { const s16x4 lo = tr4(Vs, VP, half * 64 + kst * 32 + fq * 4, dt * 16, fr), hi = tr4(Vs, VP, half * 64 + kst * 32 + 16 + fq * 4, dt * 16, fr);
                const bf16x8 vf = __builtin_shufflevector(lo, hi, 0, 1, 2, 3, 4, 5, 6, 7);
                o[dt][0] = MFMA16(vf, pb[0], o[dt][0]); o[dt][1] = MFMA16(vf, pb[1], o[dt][1]); }
            __builtin_amdgcn_sched_barrier(0);
        }
}
template <int D, bool DIAG, int QT0>
__device__ __forceinline__ void attn_tile(const LAS unsigned char* Ks, int KP, const LAS unsigned char* Vs, int VP, const bf16x8 (&qf)[2][D / 32], f32x4 (&o)[D / 16][2], f32x4 (&ol)[2],
                                          int fr, int fq, int keyl0, int qla, int qlb, float b0, float b1) {
    f32x4 s[4][2];
    qk_tile<D, QT0>(Ks, KP, qf, s, fr, fq, b0, b1);
    sm_pv_tile<D, DIAG, QT0>(s, Vs, VP, o, ol, fr, fq, keyl0, qla, qlb);
}

__device__ __forceinline__ void moba_unit(const Args& a, int l, LAS unsigned char* lds, int b, int h, int qb) {
    const int tid = otid(), lane = tid & 63, w = __builtin_amdgcn_readfirstlane(tid >> 6), fr = lane & 15, fq = lane >> 4;
    bf16_t* proj = (bf16_t*)(a.ws + WS_PROJ);
    LAS float* kml = (LAS float*)(lds + 77824);
    kml[tid] = ((const float*)(a.ws + WS_KMEAN))[(size_t)(b * 8 + h) * 512 + tid];
    const size_t rowbase = (size_t)b * SEQ;
    const bf16_t* Kc = (const bf16_t*)(a.ws + WS_KC) + (size_t)(b * 8 + h) * SEQ * 64; const bf16_t* Vc = (const bf16_t*)(a.ws + WS_VC) + (size_t)(b * 8 + h) * SEQ * 64;
    const int qrow[2] = {qb * 256 + w * 16, qb * 256 + (15 - w) * 16};
    bf16x8 qf[2][2];
#pragma unroll
    for (int qt = 0; qt < 2; ++qt)
#pragma unroll
        for (int ks = 0; ks < 2; ++ks) qf[qt][ks] = *(const bf16x8*)(proj + (rowbase + qrow[qt] + fr) * NCOL + CQA + h * 64 + ks * 32 + fq * 8);
    const int NT2 = (qb + 1) * 2;
    u32x4 kreg[2], vreg[2];
#define MOBA_T128(i) ((i) < 2 ? qb * 2 + (i) : (i) - 2)
#define MOBA_LOAD(t128) do { _Pragma("unroll") for (int ii = 0; ii < 2; ++ii) { const int cid = tid + 512 * ii; \
        kreg[ii] = *(const u32x4*)(Kc + (size_t)((t128) * 128) * 64 + cid * 8); \
        vreg[ii] = *(const u32x4*)(Vc + (size_t)((t128) * 128) * 64 + cid * 8); } } while (0)
#define MOBA_STORE(buf) do { _Pragma("unroll") for (int ii = 0; ii < 2; ++ii) { const int cid = tid + 512 * ii; \
        *(LAS u32x4*)(lds + (buf) * 38912 + (cid >> 3) * 144 + (cid & 7) * 16) = kreg[ii]; \
        *(LAS u32x4*)(lds + (buf) * 38912 + 18432 + (cid >> 3) * 160 + (cid & 7) * 16) = vreg[ii]; } } while (0)
    MOBA_LOAD(MOBA_T128(0));
    __syncthreads();
    unsigned selmask[2];
    if (qb <= 3) { selmask[0] = selmask[1] = (1u << qb) - 1u; }
    else {
#pragma unroll
        for (int qt = 0; qt < 2; ++qt) {
            float g[8];
#pragma unroll
            for (int j = 0; j < 8; ++j) { float psum = 0.f;
                if (j < qb) {
#pragma unroll
                    for (int ks = 0; ks < 2; ++ks)
#pragma unroll
                        for (int i = 0; i < 8; ++i) psum += bf2f(qf[qt][ks][i]) * kml[j * 64 + ks * 32 + fq * 8 + i];
                    psum += __shfl_xor(psum, 16); psum += __shfl_xor(psum, 32);
                }
                g[j] = (j < qb) ? psum : -INFINITY; }
            unsigned msk = 0u;
#pragma unroll
            for (int j = 0; j < 8; ++j) { int rank = 0;
#pragma unroll
                for (int mth = 0; mth < 8; ++mth) if (mth != j) rank += (g[mth] > g[j] || (g[mth] == g[j] && mth < j)) ? 1 : 0;
                if (j < qb && rank < 3) msk |= (1u << j); }
            selmask[qt] = msk;
        }
    }
    f32x4 o[4][2];
#pragma unroll
    for (int dt = 0; dt < 4; ++dt) { o[dt][0] = (f32x4){0.f, 0.f, 0.f, 0.f}; o[dt][1] = (f32x4){0.f, 0.f, 0.f, 0.f}; }
    float gm; { float xq = fabsf(a.mqn[l * 64 + lane]), xk = fabsf(a.mkn[l * 64 + lane]);
#pragma unroll
      for (int ofs = 1; ofs < 64; ofs <<= 1) { xq = fmaxf(xq, __shfl_xor(xq, ofs)); xk = fmaxf(xk, __shfl_xor(xk, ofs)); }
      gm = xq * xk * (8.f * 1.03f * LOG2E); }
    f32x4 ol[2] = {(f32x4){0.f, 0.f, 0.f, 0.f}, (f32x4){0.f, 0.f, 0.f, 0.f}};
    MOBA_STORE(0);
    BAR_LDS();
    for (int i = 0; i < NT2; ++i) {
        if (i + 1 < NT2) { const int tn = MOBA_T128(i + 1); MOBA_LOAD(tn); }
        const int t128 = MOBA_T128(i), j = t128 >> 1, hb = t128 & 1; const bool diag = (j == qb);
        const LAS unsigned char* Kb = lds + (i & 1) * 38912;
        const unsigned rs0 = diag ? 1u : ((selmask[0] >> j) & 1u), rs1 = diag ? 1u : ((selmask[1] >> j) & 1u);
        if (!diag) {
            f32x4 sA[4][2], sB[4][2];
            const float b0 = rs0 ? -gm : -1e30f, b1 = rs1 ? -gm : -1e30f;
            qk_tile<64, 0>(Kb, 144, qf, sA, fr, fq, b0, b1);
            qk_tile<64, 0>(Kb + 64 * 144, 144, qf, sB, fr, fq, b0, b1);
            sm_pv_tile128(sA, sB, Kb + 18432, 160, o, ol, fr, fq);
        } else
#pragma unroll
        for (int sub = 0; sub < 2; ++sub) {
            const int ktl = hb * 2 + sub;
            if (diag) {
                if (ktl <= (w >> 2)) attn_tile<64, true, 0>(Kb + sub * 64 * 144, 144, Kb + 18432 + sub * 64 * 160, 160, qf, o, ol, fr, fq, ktl * 64, w * 16, (15 - w) * 16, -gm, -gm);
                else if (ktl <= ((15 - w) >> 2)) attn_tile<64, true, 1>(Kb + sub * 64 * 144, 144, Kb + 18432 + sub * 64 * 160, 160, qf, o, ol, fr, fq, ktl * 64, w * 16, (15 - w) * 16, -gm, -gm);
            } else attn_tile<64, false, 0>(Kb + sub * 64 * 144, 144, Kb + 18432 + sub * 64 * 160, 160, qf, o, ol, fr, fq, 0, 0, 0, rs0 ? -gm : -1e30f, rs1 ? -gm : -1e30f);
        }
        if (i + 1 < NT2) MOBA_STORE((i + 1) & 1);
        BAR_LDS();
    }
#undef MOBA_T128
#undef MOBA_LOAD
#undef MOBA_STORE
#pragma unroll
    for (int qt = 0; qt < 2; ++qt) {
        const float inv = frcp(ol[qt][0]);
        const size_t row = rowbase + qrow[qt] + fr;
#pragma unroll
        for (int dt = 0; dt < 4; ++dt) { const int d0 = dt * 16 + fq * 4;
            const u32x2 z = *(const u32x2*)(proj + row * NCOL + CZ + h * 64 + d0);
            u32x2 y; y.x = pk2(o[dt][qt][0] * inv * silu(bflo(z.x)), o[dt][qt][1] * inv * silu(bfhi(z.x))); y.y = pk2(o[dt][qt][2] * inv * silu(bflo(z.y)), o[dt][qt][3] * inv * silu(bfhi(z.y)));
            *(u32x2*)(proj + row * NCOL + CQA + h * 64 + d0) = y; }
    }
    __syncthreads();
}

__device__ __forceinline__ void mem_unit(const Args& a, int l, LAS unsigned char* lds, int b, int hm, int qb) {
    const int tid = otid(), lane = tid & 63, w = __builtin_amdgcn_readfirstlane(tid >> 6), fr = lane & 15, fq = lane >> 4;
    bf16_t* proj = (bf16_t*)(a.ws + WS_PROJ);
    const bf16_t* kvm = (const bf16_t*)(a.ws + WS_KVM) + (size_t)b * MEML * 1024;
    const size_t rowbase = (size_t)b * SEQ; const int q0 = qb * 256 + w * 32;
    u32x4 ukr[2], uvr[2];
#define MEM_LOAD(kt) do { _Pragma("unroll") for (int ii = 0; ii < 2; ++ii) { const int cid = tid + 512 * ii; \
        ukr[ii] = *(const u32x4*)(kvm + (size_t)((kt) * 64 + (cid >> 4)) * 1024 + hm * 128 + (cid & 15) * 8); \
        uvr[ii] = *(const u32x4*)(kvm + (size_t)((kt) * 64 + (cid >> 4)) * 1024 + 512 + hm * 128 + (cid & 15) * 8); } } while (0)
    const f32x4 g0 = *(const f32x4*)(a.memkn + l * 128 + (tid & 15) * 8), g1 = *(const f32x4*)(a.memkn + l * 128 + (tid & 15) * 8 + 4);
    MEM_LOAD(0);
    bf16x8 qf[2][4];
#pragma unroll
    for (int qt = 0; qt < 2; ++qt) {
        u32x4 u[4]; float ss = 0.f;
#pragma unroll
        for (int ks = 0; ks < 4; ++ks) { u[ks] = *(const u32x4*)(proj + (rowbase + q0 + qt * 16 + fr) * NCOL + CQM + hm * 128 + ks * 32 + fq * 8);
            ss += bflo(u[ks].x) * bflo(u[ks].x) + bfhi(u[ks].x) * bfhi(u[ks].x) + bflo(u[ks].y) * bflo(u[ks].y) + bfhi(u[ks].y) * bfhi(u[ks].y)
                + bflo(u[ks].z) * bflo(u[ks].z) + bfhi(u[ks].z) * bfhi(u[ks].z) + bflo(u[ks].w) * bflo(u[ks].w) + bfhi(u[ks].w) * bfhi(u[ks].w); }
        ss += __shfl_xor(ss, 16); ss += __shfl_xor(ss, 32);
        const float r = frsq(ss * (1.f / 128.f) + EPS) * (0.08838834764831845f * LOG2E);
#pragma unroll
        for (int ks = 0; ks < 4; ++ks) { const float* g = a.memqn + l * 128 + ks * 32 + fq * 8; const f32x4 g0 = *(const f32x4*)g, g1 = *(const f32x4*)(g + 4);
            u32x4 o; o.x = pk2(bflo(u[ks].x) * r * g0.x, bfhi(u[ks].x) * r * g0.y); o.y = pk2(bflo(u[ks].y) * r * g0.z, bfhi(u[ks].y) * r * g0.w);
            o.z = pk2(bflo(u[ks].z) * r * g1.x, bfhi(u[ks].z) * r * g1.y); o.w = pk2(bflo(u[ks].w) * r * g1.z, bfhi(u[ks].w) * r * g1.w);
            qf[qt][ks] = __builtin_bit_cast(bf16x8, o); }
    }
    f32x4 o[8][2];
#pragma unroll
    for (int dt = 0; dt < 8; ++dt) { o[dt][0] = (f32x4){0.f, 0.f, 0.f, 0.f}; o[dt][1] = (f32x4){0.f, 0.f, 0.f, 0.f}; }
    float gm; { float xq = fmaxf(fabsf(a.memqn[l * 128 + lane]), fabsf(a.memqn[l * 128 + 64 + lane])), xk = fmaxf(fabsf(a.memkn[l * 128 + lane]), fabsf(a.memkn[l * 128 + 64 + lane]));
#pragma unroll
      for (int ofs = 1; ofs < 64; ofs <<= 1) { xq = fmaxf(xq, __shfl_xor(xq, ofs)); xk = fmaxf(xk, __shfl_xor(xk, ofs)); }
      gm = xq * xk * (11.3137085f * 1.03f * LOG2E); }
    f32x4 ol[2] = {(f32x4){0.f, 0.f, 0.f, 0.f}, (f32x4){0.f, 0.f, 0.f, 0.f}};
    LAS unsigned char* Ks = lds;
    LAS unsigned char* Vs = lds + 17408;
#define MEM_STORE(buf) do { _Pragma("unroll") for (int ii = 0; ii < 2; ++ii) { \
            const int cid = tid + 512 * ii, key = cid >> 4, dc = cid & 15; \
            const u32x4 uk = ukr[ii]; \
            float kv[8] = {bflo(uk.x), bfhi(uk.x), bflo(uk.y), bfhi(uk.y), bflo(uk.z), bfhi(uk.z), bflo(uk.w), bfhi(uk.w)}; \
            float ss = 0.f; \
            _Pragma("unroll") for (int i = 0; i < 8; ++i) ss += kv[i] * kv[i]; \
            ss += __shfl_xor(ss, 1); ss += __shfl_xor(ss, 2); ss += __shfl_xor(ss, 4); ss += __shfl_xor(ss, 8); \
            const float r = frsq(ss * (1.f / 128.f) + EPS); \
            u32x4 ok; ok.x = pk2(kv[0] * r * g0.x, kv[1] * r * g0.y); ok.y = pk2(kv[2] * r * g0.z, kv[3] * r * g0.w); ok.z = pk2(kv[4] * r * g1.x, kv[5] * r * g1.y); ok.w = pk2(kv[6] * r * g1.z, kv[7] * r * g1.w); \
            *(LAS u32x4*)(Ks + (buf) * 35840 + key * 272 + dc * 16) = ok; \
            *(LAS u32x4*)(Vs + (buf) * 35840 + key * 288 + dc * 16) = uvr[ii]; } } while (0)
    MEM_STORE(0);
    BAR_LDS();
    for (int kt = 0; kt < 4; ++kt) {
        if (kt < 3) MEM_LOAD(kt + 1);
        attn_tile<128, false, 0>(Ks + (kt & 1) * 35840, 272, Vs + (kt & 1) * 35840, 288, qf, o, ol, fr, fq, 0, 0, 0, -gm, -gm);
        if (kt < 3) MEM_STORE((kt + 1) & 1);
        BAR_LDS();
    }
#undef MEM_STORE
#undef MEM_LOAD
#pragma unroll
    for (int qt = 0; qt < 2; ++qt) {
        const float inv = frcp(ol[qt][0]);
        const size_t row = rowbase + q0 + qt * 16 + fr;
#pragma unroll
        for (int dt = 0; dt < 8; ++dt) { const int d0 = dt * 16 + fq * 4;
            const u32x2 z = *(const u32x2*)(proj + row * NCOL + CZ + 1024 + hm * 128 + d0);
            u32x2 y; y.x = pk2(o[dt][qt][0] * inv * silu(bflo(z.x)), o[dt][qt][1] * inv * silu(bfhi(z.x))); y.y = pk2(o[dt][qt][2] * inv * silu(bflo(z.y)), o[dt][qt][3] * inv * silu(bfhi(z.y)));
            *(u32x2*)(proj + row * NCOL + CQM + hm * 128 + d0) = y; }
    }
}

#define XB_TMO      128
#define XB_XCNT(j)  (256  + 64 * (j))
#define XB_XSUB(j)  (1280 + 64 * (j))
#define XB_XGEN(j)  (2304 + 64 * (j))
#define XB_TOP      3328
#define XB_TOPGEN   3392
#define XCD_BAR_WORDS 3456
#define XB_SPIN_CAP (1u << 18)
__device__ __forceinline__ unsigned xb_ld(unsigned* p)              { return __hip_atomic_load(p, __ATOMIC_RELAXED, __HIP_MEMORY_SCOPE_AGENT); }
__device__ __forceinline__ unsigned xb_add(unsigned* p, unsigned v) { return __hip_atomic_fetch_add(p, v, __ATOMIC_RELAXED, __HIP_MEMORY_SCOPE_AGENT); }
__device__ __forceinline__ unsigned xb_xcc_id() { return (unsigned)__builtin_amdgcn_s_getreg((3 << 11) | 20) & 0xFu; }
#define XB_SPIN(cond, bar) do { unsigned _sp = 0; while (cond) { __builtin_amdgcn_s_sleep(1); \
    if ((++_sp & 255u) == 0u) { if (xb_ld(&(bar)[XB_TMO])) break; if (_sp > XB_SPIN_CAP) { atomicAdd(&(bar)[XB_TMO], 1u); break; } } } } while (0)
struct XcdBarrier { unsigned* bar; unsigned x; volatile LAS unsigned* st; };
__device__ __forceinline__ XcdBarrier xcd_barrier_post(unsigned* bar, volatile LAS unsigned* st) {
    XcdBarrier b; b.bar = bar; b.x = xb_xcc_id(); b.st = st;
    if (threadIdx.x == 0) (void)xb_add(&bar[XB_XCNT(b.x)], 1u);
    return b;
}
__device__ __forceinline__ void xcd_barrier_complete(unsigned* bar, unsigned x, unsigned& nloc, unsigned& nx) {
    const unsigned G = gridDim.x * gridDim.y * gridDim.z;
    unsigned sum, cnt, mine, sp = 0u;
    for (;;) {
        sum = 0u; cnt = 0u; mine = 0u;
#pragma unroll
        for (unsigned j = 0; j < 16; ++j) { const unsigned c = xb_ld(&bar[XB_XCNT(j)]); sum += c; cnt += (c > 0u) ? 1u : 0u; mine = (j == x) ? c : mine; }
        if (sum == G) break;
        __builtin_amdgcn_s_sleep(1);
        if ((++sp & 255u) == 0u) { if (xb_ld(&bar[XB_TMO])) break; if (sp > XB_SPIN_CAP) { atomicAdd(&bar[XB_TMO], 1u); break; } }
    }
    nloc = mine > 0u ? mine : 1u; nx = cnt > 0u ? cnt : 1u;
}
__device__ __forceinline__ void xcd_barrier(const XcdBarrier& b) {
    asm volatile("s_waitcnt vmcnt(0)" ::: "memory");
    __syncthreads();
    if (threadIdx.x == 0) {
        unsigned* bar = b.bar;
        __builtin_amdgcn_s_waitcnt(0);
        unsigned nloc = b.st[0], nx = b.st[1];
        if (nloc == 0u) { xcd_barrier_complete(bar, b.x, nloc, nx); b.st[0] = nloc; b.st[1] = nx; }
        const unsigned old = xb_add(&bar[XB_XSUB(b.x)], 1u);
        const unsigned gen = old / nloc;
        if (old + 1u == (gen + 1u) * nloc) {
            __builtin_amdgcn_fence(__ATOMIC_RELEASE, "agent");
            asm volatile("s_waitcnt vmcnt(0)" ::: "memory");
            const unsigned og = xb_add(&bar[XB_TOP], 1u);
            const unsigned tg = og / nx;
            if (og + 1u == (tg + 1u) * nx) xb_add(&bar[XB_TOPGEN], 1u);
            else XB_SPIN(xb_ld(&bar[XB_TOPGEN]) == tg, bar);
            __builtin_amdgcn_fence(__ATOMIC_ACQUIRE, "agent");
            xb_add(&bar[XB_XGEN(b.x)], 1u);
            asm volatile("s_waitcnt vmcnt(0)" ::: "memory");
        } else {
            XB_SPIN(xb_ld(&bar[XB_XGEN(b.x)]) == gen, bar);
            __builtin_amdgcn_fence(__ATOMIC_ACQUIRE, "agent");
            asm volatile("s_waitcnt vmcnt(0)" ::: "memory");
        }
    }
    __syncthreads();
}

__global__ void __launch_bounds__(512) hymba_fwd(Args a) {
    extern __shared__ __attribute__((aligned(16))) unsigned char lds_raw[];
    LAS unsigned char* lds = (LAS unsigned char*)lds_raw;
    const int G = gridDim.x, bx = blockIdx.x;
    const int lo = a.ph_lo, hi = a.ph_hi;
    bf16_t* proj = (bf16_t*)(a.ws + WS_PROJ);
#define IN(k) (lo <= (k) && (k) < hi)
#define SEAM(k) do { if (IN(k) && IN((k) + 1)) { if (a.pad == 0x5eed) cg::this_grid().sync(); xcd_barrier(xbar); } } while (0)
    volatile LAS unsigned* xst = (volatile LAS unsigned*)(lds + LDS_BYTES - 16);
    if (threadIdx.x < 2) xst[threadIdx.x] = 0u;
    __syncthreads();
    XcdBarrier xbar; xbar.bar = (unsigned*)(a.ws + WS_BAR); xbar.x = 0; xbar.st = xst;
    if (hi - lo > 1) xbar = xcd_barrier_post((unsigned*)(a.ws + WS_BAR), xst);
    if (IN(0)) { p0_phase(a, lds); __syncthreads(); }
    SEAM(0);
#pragma unroll 1
    for (int l = 0; l < 2; ++l) {
        const int base = 1 + 5 * l;
        if (IN(base)) {
            {
            pg8::Gemm g{(const bf16_t*)(a.ws + WS_H), (const bf16_t*)(a.ws + WS_WIN) + (size_t)l * NIN * DM, NTOK, NIN, DM, DM};
            pg8::StaticOrder S; S.init(NTOK, NIN, G, bx);
            pg8::EpiBf16Scale E{proj, NCOL, (bf16_t*)(a.ws + WS_KC), (bf16_t*)(a.ws + WS_VC)};
            if (G == 256) {
                pg8::Unit u0; if (S.next(0, u0) && threadIdx.x < 256) { const float* rss = (const float*)(a.ws + WS_RSS) + u0.pm * 256 + threadIdx.x;
                    ((LAS float*)(lds + 131072))[threadIdx.x] = frsq(((rss[0] + rss[NTOK]) + (rss[2 * NTOK] + rss[3 * NTOK])) * (1.f / 1024.f) + EPS); }
                __syncthreads();
                pg8::gemm_phase<pg8::EpiBf16Scale, pg8::StaticOrder>(lds, g, S, E);
            } else {
                for (int i = 0; ; ++i) { pg8::Unit u0; if (!S.next(i, u0)) break;
                    if (threadIdx.x < 256) { const float* rss = (const float*)(a.ws + WS_RSS) + u0.pm * 256 + threadIdx.x;
                        ((LAS float*)(lds + 131072))[threadIdx.x] = frsq(((rss[0] + rss[NTOK]) + (rss[2 * NTOK] + rss[3 * NTOK])) * (1.f / 1024.f) + EPS); }
                    __syncthreads();
                    pg8::StaticOrder S1; S1.init(NTOK, NIN, 1 << 30, i * G + bx);
                    pg8::gemm_phase<pg8::EpiBf16Scale, pg8::StaticOrder>(lds, g, S1, E); __syncthreads(); }
            }
            __syncthreads();
            }
        }
        SEAM(base);
        if (IN(base + 1)) {
            const int NKV = (G >= 64) ? 32 : 0;
            {
            {
                pg8::Gemm g{(const bf16_t*)(a.ws + (l ? WS_MEMH1 : WS_MEMH)), (const bf16_t*)(a.ws + WS_WMEM) + (size_t)l * DM * DM, NMEM, 1024, DM, DM};
                pg8::StaticOrder S; S.init(NMEM, 1024, G, bx);
                pg8::EpiBf16 E{(bf16_t*)(a.ws + WS_KVM), 1024};
                pg8::gemm_phase<pg8::EpiBf16, pg8::StaticOrder>(lds, g, S, E);
                __syncthreads();
            }
            if (bx >= NKV) {
                const int wb = bx - NKV, WG = G - NKV;
                const int tid = otid();
                if (tid < 128) ((LAS float*)(lds + 68608))[tid] = (tid < 64) ? a.mqn[l * 64 + tid] : a.mkn[l * 64 + tid - 64];
                if (tid < 512) ((LAS float*)(lds + 106496))[tid] = ((const float*)(a.ws + WS_LB))[l * 512 + tid];
                __syncthreads();
                { PrepIn cur; int u = wb; moba_prep_load(a, tid, u < 512 ? u : 0, cur);
                  for (; u < 512; u += WG) { PrepIn nxt; moba_prep_unit(a, l, lds, tid, u, cur, nxt, (u + WG < 512) ? u + WG : u); cur = nxt; } }
                { HIn cur; int u = (wb + 160) % WG;     hgrn_load<false>(a, tid, u < 1024 ? u : 0, cur);
                  for (; u < 1024; u += WG) { HIn nxt; hgrn_stage1_unit(a, l, lds, tid, u, cur, nxt, (u + WG < 1024) ? u + WG : u); cur = nxt; } }
                __syncthreads();
            }
            }
        }
        SEAM(base + 1);
        if (IN(base + 2)) {
            {
                for (int u = bx; u < 512; u += G) {
                    int bh, qb; if (G == 256) { bh = bx >> 2; const int s = bx & 3; qb = (u < 256) ? 7 - s : s; } else { bh = u >> 3; qb = 7 - (u & 7); }
                    moba_unit(a, l, lds, bh >> 3, bh & 7, qb);
                }
            }
            for (int u = bx; u < 256; u += G) mem_unit(a, l, lds, u >> 5, (u >> 3) & 3, u & 7);
            hgrn_scan_phase(a);
            __syncthreads();
        }
        SEAM(base + 2);
        if (IN(base + 3)) {
            { const int tid = otid();
              if (tid < 512) ((LAS float*)(lds + 106496))[tid] = ((const float*)(a.ws + WS_LB))[l * 512 + tid];
              if (tid < 128) ((LAS float*)(lds + 106496 + 2048))[tid] = a.hon[l * 128 + tid];
              __syncthreads();
              HIn cur; int u = bx; hgrn_load<true>(a, tid, u < 1024 ? u : 0, cur);
                for (; u < 1024; u += G) { HIn nxt; hgrn_stage3_unit(a, l, lds, tid, u, cur, nxt, (u + G < 1024) ? u + G : u); cur = nxt; } }
            __syncthreads();
        }
        SEAM(base + 3);
        if (IN(base + 4)) {
            pg8::Gemm g{proj, (const bf16_t*)(a.ws + WS_WOUT) + (size_t)l * DM * DMIX, NTOK, DM, DMIX, NCOL};
            pg8::StaticOrder S; S.init(NTOK, DM, G, bx);
            if (l == 0) { {
                pg8::EpiResF32Norm E{a.x, a.out, DM, a.norm_g + DM, (bf16_t*)(a.ws + WS_H), (float*)(a.ws + WS_RSS)};
                pg8::gemm_phase<pg8::EpiResF32Norm, pg8::StaticOrder>(lds, g, S, E); __syncthreads(); } }
            else { pg8::EpiResF32 E{(const float*)a.out, a.out, DM};
                pg8::gemm_phase<pg8::EpiResF32, pg8::StaticOrder>(lds, g, S, E); __syncthreads(); }
        }
        if (l == 0) SEAM(base + 4);
    }
#undef IN
#undef SEAM
}

extern "C" void kernel_launch(void* const* d_in, const int* in_sizes, int n_in, void* d_out, int out_size, void* d_ws, size_t ws_size, hipStream_t stream) {
    static int grid = 0;
    if (grid == 0) {
        if (n_in != 14 || out_size != NTOK * DM || ws_size < WS_BAR + 65536) { fprintf(stderr, "kernel_launch: unexpected shapes (n_in %d out %d ws %zu)\n", n_in, out_size, ws_size); grid = -1; return; }
        int dev = 0, cus = 0, per_cu = 0;
        hipGetDevice(&dev); hipDeviceGetAttribute(&cus, hipDeviceAttributeMultiprocessorCount, dev);
        if (hipFuncSetAttribute((const void*)hymba_fwd, hipFuncAttributeMaxDynamicSharedMemorySize, LDS_BYTES) != hipSuccess) { fprintf(stderr, "kernel_launch: hipFuncSetAttribute failed\n"); grid = -1; return; }
        if (hipOccupancyMaxActiveBlocksPerMultiprocessor(&per_cu, (const void*)hymba_fwd, 512, LDS_BYTES) != hipSuccess || per_cu < 1) { fprintf(stderr, "kernel_launch: occupancy query says %d\n", per_cu); per_cu = 1; }
        (void)hipGetLastError();
        grid = cus * (per_cu > 1 ? 1 : per_cu);
    }
    if (grid < 0) return;
    if (hipMemsetAsync((char*)d_ws + WS_BAR, 0, XCD_BAR_WORDS * 4, stream) != hipSuccess) { fprintf(stderr, "kernel_launch: memset failed\n"); return; }
    Args a{};
    a.x = (const float*)d_in[0]; a.mem = (const float*)d_in[1]; a.pos = (const int*)d_in[2]; a.norm_g = (const float*)d_in[3]; a.w_in = (const float*)d_in[4]; a.w_out = (const float*)d_in[5];
    a.mqn = (const float*)d_in[6]; a.mkn = (const float*)d_in[7]; a.lbl = (const float*)d_in[8]; a.hon = (const float*)d_in[9]; a.mng = (const float*)d_in[10]; a.wmem = (const float*)d_in[11];
    a.memqn = (const float*)d_in[12]; a.memkn = (const float*)d_in[13]; a.out = (float*)d_out; a.ws = (unsigned char*)d_ws; a.rep = 0;
#if MK_ONE_LAUNCH
    a.ph_lo = 0; a.ph_hi = NPHASE;
    void* args[] = {&a};
    hipError_t e = hipLaunchCooperativeKernel((const void*)hymba_fwd, dim3(grid), dim3(512), args, LDS_BYTES, stream);
    if (e != hipSuccess) fprintf(stderr, "cooperative launch failed: %s (grid %d)\n", hipGetErrorString(e), grid);
#else
    for (int p = 0; p < NPHASE; ++p) { a.ph_lo = p; a.ph_hi = p + 1; hipLaunchKernelGGL(hymba_fwd, dim3(grid), dim3(512), LDS_BYTES, stream, a); }
#endif
}
```

```cpp
#include <hip/hip_runtime.h>
#include <hip/hip_cooperative_groups.h>
#include <cstdio>
#include <cstdint>
namespace cg = cooperative_groups;

#ifndef MK_ONE_LAUNCH
#define MK_ONE_LAUNCH 1
#endif

#define LAS __attribute__((address_space(3)))
typedef unsigned short bf16_t;
typedef short bf16x8 __attribute__((ext_vector_type(8)));
typedef short s16x4 __attribute__((ext_vector_type(4)));
typedef float f32x4 __attribute__((ext_vector_type(4)));
typedef unsigned u32x4 __attribute__((ext_vector_type(4)));
typedef unsigned u32x2 __attribute__((ext_vector_type(2)));

constexpr int NB = 8, SEQ = 2048, DM = 1024, NTOK = NB * SEQ, MEML = 256, NMEM = NB * MEML, NCOL = 4096  , NIN = 5120  , DMIX = 1536;
constexpr int CQA = 0, CQH = 512, CQM = 1024, CZ = 1536, CFH = 3072, CIH = 3584;
constexpr float EPS = 1e-6f;
constexpr float LOG2E = 1.4426950408889634f;
constexpr size_t MiB = 1u << 20;
constexpr size_t WS_WIN = 0, WS_WOUT = 20 * MiB, WS_WMEM = 26 * MiB, WS_H = 30 * MiB  , WS_MEMH = 62 * MiB, WS_KVM = 66 * MiB,
                 WS_PROJ = 70 * MiB, WS_KC = 198 * MiB, WS_VC = 214 * MiB, WS_VT = 230 * MiB, WS_KMEAN = 246 * MiB, WS_DECAY = 246 * MiB + 128 * 1024, WS_ROPE = 247 * MiB, WS_END = 248 * MiB, WS_MEMH1 = 230 * MiB  , WS_RSS = 250 * MiB  , WS_LB = 251 * MiB  , WS_BAR = 252 * MiB  ;
constexpr int LDS_BYTES = 147456;
constexpr int NPHASE = 11;

struct Args {
    const float *x, *mem; const int* pos; const float *norm_g, *w_in, *w_out, *mqn, *mkn, *lbl, *hon, *mng, *wmem, *memqn, *memkn;
    float* out; unsigned char* ws; int ph_lo, ph_hi, rep, pad;
};

typedef float f32x2_t __attribute__((ext_vector_type(2))); typedef __bf16 bf16x2_t __attribute__((ext_vector_type(2)));
__device__ __forceinline__ unsigned pk2(float lo, float hi) { f32x2_t v = {lo, hi}; bf16x2_t b = __builtin_convertvector(v, bf16x2_t); return __builtin_bit_cast(unsigned, b); }
__device__ __forceinline__ unsigned f2bf(float f) { return pk2(f, 0.f) & 0xffffu; }
__device__ __forceinline__ float bflo(unsigned u) { return __uint_as_float(u << 16); }
__device__ __forceinline__ float bfhi(unsigned u) { return __uint_as_float(u & 0xffff0000u); }
__device__ __forceinline__ float bf2f(short s) { return __uint_as_float(((unsigned)(unsigned short)s) << 16); }
__device__ __forceinline__ float wave_sum(float v) {
#pragma unroll
    for (int o = 1; o < 64; o <<= 1) v += __shfl_xor(v, o);
    return v;
}
__device__ __forceinline__ float ex2(float x) { return __builtin_amdgcn_exp2f(x); }
__device__ __forceinline__ float fexp(float x) { return __builtin_amdgcn_exp2f(x * LOG2E); }
__device__ __forceinline__ float frcp(float x) { return __builtin_amdgcn_rcpf(x); }
__device__ __forceinline__ float frsq(float x) { return __builtin_amdgcn_rsqf(x); }
__device__ __forceinline__ float sigm(float x) { return frcp(1.f + fexp(-x)); }
__device__ __forceinline__ float silu(float x) { return x * frcp(1.f + fexp(-x)); }
#define LDS_WAIT() asm volatile("s_waitcnt lgkmcnt(0)" ::: "memory")
__device__ __forceinline__ int otid() { int t = threadIdx.x; asm volatile("" : "+v"(t)); return t; }
typedef short v4i16_t __attribute__((ext_vector_type(4)));
__device__ __forceinline__ s16x4 tr4(const LAS unsigned char* base, int pitch, int r0, int c0, int lane) {
    const int q = (lane & 15) >> 2, p = lane & 3;
    return __builtin_bit_cast(s16x4, __builtin_amdgcn_ds_read_tr16_b64_v4i16((LAS v4i16_t*)(base + (r0 + q) * pitch + (c0 + 4 * p) * 2)));
}
#define MFMA16(a, b, c) __builtin_amdgcn_mfma_f32_16x16x32_bf16((a), (b), (c), 0, 0, 0)

namespace pg8 {
constexpr int BM = 256, BK = 64, HALF = 128, HTB = HALF * BK * 2, NXCD = 8, WGM = 8;
__host__ __device__ __forceinline__ int lds_byte(int r, int c) { const int st = (r >> 4) * 2 + (c >> 5), rr = r & 15, cc = c & 31, ob = rr * 64 + cc * 2; return st * 1024 + (ob ^ (((ob >> 9) & 1) << 5)); }
__host__ __device__ __forceinline__ void stage_rc(int b, int& R, int& C) { const int st = b / 1024, sb = b % 1024, swz = sb ^ (((sb >> 9) & 1) << 5); R = (st >> 1) * 16 + swz / 64; C = (st & 1) * 32 + (swz % 64) / 2; }
__host__ __device__ __forceinline__ int perm32(int rho) { const int n = rho >> 4, i = rho & 15; return 8 * (i >> 2) + 4 * n + (i & 3); }
struct Unit { int pm, pn; };
struct Gemm { const bf16_t* A; const bf16_t* Bt; int M, N, K, lda; };
struct StaticOrder {
    int nM, nN, nwg, G, c;
    __device__ void init(int M, int N, int G_, int c_) { nM = M / BM; nN = N / BM; nwg = nM * nN; G = G_; c = c_; }
    __device__ bool next(int i, Unit& u) const {
        const long L = (long)i * G + c; if (L >= nwg) return false;
        int wgid = (int)L; { const int q = nwg / NXCD, r = nwg % NXCD, xcd = wgid % NXCD, off = wgid / NXCD; wgid = (xcd < r ? xcd * (q + 1) : r * (q + 1) + (xcd - r) * q) + off; }
        const int nig = WGM * nN, gid = wgid / nig, fm = gid * WGM, gsz = (nM - fm) < WGM ? (nM - fm) : WGM;
        u.pm = fm + ((wgid % nig) % gsz); u.pn = (wgid % nig) / gsz; return true;
    }
};
__device__ __forceinline__ unsigned cvt_pk_bf16(float lo, float hi) { unsigned r; asm volatile("v_cvt_pk_bf16_f32 %0, %1, %2" : "=v"(r) : "v"(lo), "v"(hi)); return r; }
struct EpiBf16 {
    static constexpr bool PERM = true;
    bf16_t* O; int ldc;
    __device__ __forceinline__ void operator()(const f32x4 (&acc)[2][2][4][2], const Unit& u, int wr, int wc, int fr, int fq, LAS unsigned char*) const {
        const int row0 = u.pm * BM + wr * 64 + fr; const int col0 = u.pn * BM + wc * 32 + 8 * fq;
#pragma unroll
        for (int ai = 0; ai < 2; ++ai)
#pragma unroll
            for (int m = 0; m < 4; ++m) { bf16_t* rowp = O + (size_t)(row0 + ai * HALF + m * 16) * ldc + col0;
#pragma unroll
                for (int bj = 0; bj < 2; ++bj) { const f32x4 v0 = acc[ai][bj][m][0], v1 = acc[ai][bj][m][1];
                    u32x4 w; w.x = cvt_pk_bf16(v0[0], v0[1]); w.y = cvt_pk_bf16(v0[2], v0[3]); w.z = cvt_pk_bf16(v1[0], v1[1]); w.w = cvt_pk_bf16(v1[2], v1[3]);
                    *(u32x4*)(rowp + bj * HALF) = w; } }
    }
};
struct EpiBf16Scale {
    static constexpr bool PERM = true;
    bf16_t* O; int ldc; bf16_t* Kc; bf16_t* Vc;
    __device__ __forceinline__ void operator()(const f32x4 (&acc)[2][2][4][2], const Unit& u, int wr, int wc, int fr, int fq, LAS unsigned char* lds) const {
        const int row0 = u.pm * BM + wr * 64 + fr; const int col0 = u.pn * BM + wc * 32 + 8 * fq;
        const LAS float* rtab = (const LAS float*)(lds + 131072);
        const bool compact = u.pn >= 16;
#pragma unroll
        for (int ai = 0; ai < 2; ++ai)
#pragma unroll
            for (int m = 0; m < 4; ++m) { const int row = row0 + ai * HALF + m * 16;
                const float r = rtab[ai * HALF + wr * 64 + m * 16 + fr];
#pragma unroll
                for (int bj = 0; bj < 2; ++bj) { const f32x4 v0 = acc[ai][bj][m][0] * r, v1 = acc[ai][bj][m][1] * r;
                    u32x4 w; w.x = cvt_pk_bf16(v0[0], v0[1]); w.y = cvt_pk_bf16(v0[2], v0[3]); w.z = cvt_pk_bf16(v1[0], v1[1]); w.w = cvt_pk_bf16(v1[2], v1[3]);
                    bf16_t* dst;
                    if (compact) { const int cc = col0 + bj * HALF - 4096, hc = cc & 511, hh = hc >> 6, d = hc & 63;
                        dst = ((cc >> 9) ? Vc : Kc) + ((size_t)((row >> 11) * 8 + hh) * 2048 + (row & 2047)) * 64 + d; }
                    else dst = O + (size_t)row * ldc + col0 + bj * HALF;
                    *(u32x4*)dst = w; } }
    }
};
struct EpiResF32Norm {
    static constexpr bool PERM = true;
    const float* res; float* O; int ldc; const float* g; bf16_t* H; float* rss;
    __device__ __forceinline__ void operator()(const f32x4 (&acc)[2][2][4][2], const Unit& u, int wr, int wc, int fr, int fq, LAS unsigned char* lds) const {
        const int row0 = u.pm * BM + wr * 64 + fr; const int col0 = u.pn * BM + wc * 32 + 8 * fq;
        LAS float* part = (LAS float*)(lds + 131072);
        f32x4 gg[2][2];
#pragma unroll
        for (int bj = 0; bj < 2; ++bj)
#pragma unroll
            for (int n = 0; n < 2; ++n) gg[bj][n] = *(const f32x4*)(g + col0 + bj * HALF + 4 * n);
#pragma unroll
        for (int ai = 0; ai < 2; ++ai)
#pragma unroll
            for (int m = 0; m < 4; ++m) { const size_t ro = (size_t)(row0 + ai * HALF + m * 16) * ldc + col0; float ssq = 0.f;
#pragma unroll
                for (int bj = 0; bj < 2; ++bj) { const size_t o = ro + bj * HALF;
                    const f32x4 r0 = *(const f32x4*)(res + o), r1 = *(const f32x4*)(res + o + 4);
                    const f32x4 x0 = r0 + acc[ai][bj][m][0], x1 = r1 + acc[ai][bj][m][1];
                    *(f32x4*)(O + o) = x0; *(f32x4*)(O + o + 4) = x1;
                    u32x4 hb; hb.x = cvt_pk_bf16(x0[0] * gg[bj][0][0], x0[1] * gg[bj][0][1]); hb.y = cvt_pk_bf16(x0[2] * gg[bj][0][2], x0[3] * gg[bj][0][3]);
                    hb.z = cvt_pk_bf16(x1[0] * gg[bj][1][0], x1[1] * gg[bj][1][1]); hb.w = cvt_pk_bf16(x1[2] * gg[bj][1][2], x1[3] * gg[bj][1][3]);
                    *(u32x4*)(H + o) = hb;
                    ssq += ((x0[0] * x0[0] + x0[1] * x0[1]) + (x0[2] * x0[2] + x0[3] * x0[3])) + ((x1[0] * x1[0] + x1[1] * x1[1]) + (x1[2] * x1[2] + x1[3] * x1[3])); }
                ssq += __shfl_xor(ssq, 16); ssq += __shfl_xor(ssq, 32);
                if (fq == 0) part[(ai * HALF + wr * 64 + m * 16 + fr) * 4 + wc] = ssq; }
        asm volatile("s_waitcnt lgkmcnt(0)" ::: "memory"); __builtin_amdgcn_s_barrier(); asm volatile("" ::: "memory");
        const int t = threadIdx.x;
        if (t < 256) { const f32x4 p = *(const LAS f32x4*)(part + t * 4); rss[(size_t)u.pn * NTOK + u.pm * BM + t] = (p[0] + p[1]) + (p[2] + p[3]); }
    }
};
struct EpiResF32 {
    static constexpr bool PERM = true;
    const float* res; float* O; int ldc;
    __device__ __forceinline__ void operator()(const f32x4 (&acc)[2][2][4][2], const Unit& u, int wr, int wc, int fr, int fq, LAS unsigned char*) const {
        const int row0 = u.pm * BM + wr * 64 + fr; const int col0 = u.pn * BM + wc * 32 + 8 * fq;
#pragma unroll
        for (int ai = 0; ai < 2; ++ai)
#pragma unroll
            for (int m = 0; m < 4; ++m) { const size_t ro = (size_t)(row0 + ai * HALF + m * 16) * ldc + col0;
#pragma unroll
                for (int bj = 0; bj < 2; ++bj) { const size_t o = ro + bj * HALF; const f32x4 r0 = *(const f32x4*)(res + o), r1 = *(const f32x4*)(res + o + 4);
                    *(f32x4*)(O + o) = r0 + acc[ai][bj][m][0]; *(f32x4*)(O + o + 4) = r1 + acc[ai][bj][m][1]; } }
    }
};

template <class Epi, class Sched>
__device__ __forceinline__ void gemm_phase(LAS unsigned char* lds, const Gemm g, const Sched& S, const Epi& E) {
    const int tid = otid(), wid = __builtin_amdgcn_readfirstlane(tid >> 6), lane = tid & 63, wr = wid >> 2, wc = wid & 3, fr = lane & 15, fq = lane >> 4;
    const int K = g.K, nt = K / BK, lda = g.lda;
    unsigned voffA[2], voffB[2];
#pragma unroll
    for (int i = 0; i < 2; ++i) { int R, C; stage_rc(tid * 16 + i * 8192, R, C); const int Rb = Epi::PERM ? ((R & ~31) + perm32(R & 31)) : R;
        voffA[i] = (unsigned)(R * lda + C) * 2u; voffB[i] = (unsigned)(Rb * K + C) * 2u; }
    const size_t kstep = (size_t)(BK * 2);
    const size_t hstepA = (size_t)HALF * lda * 2, hstepB = (size_t)HALF * K * 2;
    const size_t tstepA = 2 * hstepA, tstepB = 2 * hstepB;
    const unsigned ldsw = (unsigned)wid * 1024u;
    const int aoff = lds_byte(wr * 64 + fr, fq * 8), boff = lds_byte(wc * 32 + fr, fq * 8);
#define PG8_SA(b, h) (((b) * 2 + (h)) * HTB)
#define PG8_SB(b, h) ((4 + (b) * 2 + (h)) * HTB)
#define PG8_STAGE(bufoff, gbase, voff) do { _Pragma("unroll") for (int _i = 0; _i < 2; ++_i) \
        __builtin_amdgcn_global_load_lds((const unsigned*)((const char*)(gbase) + (voff)[_i]), (LAS unsigned*)(lds + (bufoff) + ldsw + _i * 8192), 16, 0, 0); } while (0)
#define PG8_LDA(dst, b, h) do { _Pragma("unroll") for (int m = 0; m < 4; ++m) _Pragma("unroll") for (int k = 0; k < 2; ++k) dst[m][k] = *(const LAS bf16x8*)(lds + PG8_SA(b, h) + aoff + m * 2048 + k * 1024); } while (0)
#define PG8_LDB(dst, b, h) do { _Pragma("unroll") for (int n = 0; n < 2; ++n) _Pragma("unroll") for (int k = 0; k < 2; ++k) dst[n][k] = *(const LAS bf16x8*)(lds + PG8_SB(b, h) + boff + n * 2048 + k * 1024); } while (0)
#define PG8_MMA(ai, bj, At, Bt) do { __builtin_amdgcn_s_setprio(1); _Pragma("unroll") for (int m = 0; m < 4; ++m) _Pragma("unroll") for (int n = 0; n < 2; ++n) _Pragma("unroll") for (int k = 0; k < 2; ++k) \
        acc[ai][bj][m][n] = __builtin_amdgcn_mfma_f32_16x16x32_bf16(Bt[n][k], At[m][k], acc[ai][bj][m][n], 0, 0, 0); __builtin_amdgcn_s_setprio(0); } while (0)
#define PG8_WAIT_V(n) asm volatile("s_waitcnt vmcnt(" #n ")" ::: "memory")
#define PG8_WAIT_L(n) asm volatile("s_waitcnt lgkmcnt(" #n ")" ::: "memory")
#define PG8_BAR __builtin_amdgcn_s_barrier()
#define PG8_SCHED __builtin_amdgcn_sched_barrier(0)
    Unit cur, nxt; int ui = 0;
    if (!S.next(0, cur)) return;
    f32x4 acc[2][2][4][2];
#pragma unroll
    for (int a = 0; a < 2; ++a)
#pragma unroll
        for (int b = 0; b < 2; ++b)
#pragma unroll
            for (int m = 0; m < 4; ++m)
#pragma unroll
                for (int n = 0; n < 2; ++n) acc[a][b][m][n] = (f32x4){0.f, 0.f, 0.f, 0.f};
    bf16x8 At[4][2], B0[2][2], B1[2][2];
    const char* cA = (const char*)g.A + (size_t)cur.pm * tstepA; const char* cB = (const char*)g.Bt + (size_t)cur.pn * tstepB;
    PG8_STAGE(PG8_SB(0, 0), cB, voffB); PG8_STAGE(PG8_SB(0, 1), cB + hstepB, voffB); PG8_STAGE(PG8_SA(0, 0), cA, voffA); PG8_STAGE(PG8_SA(0, 1), cA + hstepA, voffA);
    if (wr == 1) PG8_BAR;
    PG8_WAIT_V(2); PG8_BAR;
    PG8_STAGE(PG8_SB(1, 0), cB + kstep, voffB); PG8_STAGE(PG8_SA(1, 0), cA + kstep, voffA); PG8_STAGE(PG8_SB(1, 1), cB + hstepB + kstep, voffB);
    PG8_WAIT_V(6); PG8_BAR;
    for (;;) {
        const bool has_next = S.next(ui + 1, nxt);
        const char* nA = has_next ? (const char*)g.A + (size_t)nxt.pm * tstepA : cA; const char* nB = has_next ? (const char*)g.Bt + (size_t)nxt.pn * tstepB : cB;
        for (int t = 0; t < nt; t += 2) {
            const bool last = (t == nt - 2);
            const char* a1 = cA + (size_t)(t + 1) * kstep;
            const char* a2 = last ? nA : cA + (size_t)(t + 2) * kstep; const char* b2 = last ? nB : cB + (size_t)(t + 2) * kstep;
            const char* a3 = a2 + kstep; const char* b3 = b2 + kstep;
            PG8_LDB(B0, 0, 0); PG8_LDB(B1, 0, 1); PG8_SCHED; PG8_LDA(At, 0, 0); PG8_STAGE(PG8_SA(1, 1), a1 + hstepA, voffA);
            PG8_WAIT_V(8); PG8_WAIT_L(0); PG8_BAR; PG8_MMA(0, 0, At, B0); PG8_MMA(0, 1, At, B1); PG8_BAR; PG8_SCHED;
            PG8_LDA(At, 0, 1); PG8_STAGE(PG8_SB(0, 0), b2, voffB); PG8_STAGE(PG8_SB(0, 1), b2 + hstepB, voffB); PG8_STAGE(PG8_SA(0, 0), a2, voffA);
            PG8_WAIT_V(8); PG8_WAIT_L(0); PG8_BAR; PG8_MMA(1, 0, At, B0); PG8_MMA(1, 1, At, B1); PG8_BAR; PG8_SCHED;
            PG8_LDB(B0, 1, 0); PG8_LDB(B1, 1, 1); PG8_SCHED; PG8_LDA(At, 1, 0); PG8_STAGE(PG8_SA(0, 1), a2 + hstepA, voffA);
            PG8_WAIT_V(8); PG8_WAIT_L(0); PG8_BAR; PG8_MMA(0, 0, At, B0); PG8_MMA(0, 1, At, B1); PG8_BAR; PG8_SCHED;
            PG8_LDA(At, 1, 1); PG8_STAGE(PG8_SB(1, 0), b3, voffB); PG8_STAGE(PG8_SB(1, 1), b3 + hstepB, voffB); PG8_STAGE(PG8_SA(1, 0), a3, voffA);
            PG8_WAIT_V(8); PG8_WAIT_L(0); PG8_BAR; PG8_MMA(1, 0, At, B0); PG8_MMA(1, 1, At, B1); PG8_BAR; PG8_SCHED;
        }
        if (wr == 0) PG8_BAR;
        E(acc, cur, wr, wc, fr, fq, lds);
        if (!has_next) break;
#pragma unroll
        for (int a = 0; a < 2; ++a)
#pragma unroll
            for (int b = 0; b < 2; ++b)
#pragma unroll
                for (int m = 0; m < 4; ++m)
#pragma unroll
                    for (int n = 0; n < 2; ++n) acc[a][b][m][n] = (f32x4){0.f, 0.f, 0.f, 0.f};
        cur = nxt; cA = nA; cB = nB; ++ui;
        if (wr == 1) PG8_BAR;
    }
    PG8_WAIT_V(0);
    PG8_BAR;
#undef PG8_SA
#undef PG8_SB
#undef PG8_STAGE
#undef PG8_LDA
#undef PG8_LDB
#undef PG8_MMA
#undef PG8_WAIT_V
#undef PG8_WAIT_L
#undef PG8_BAR
#undef PG8_SCHED
}
}

__device__ __forceinline__ void transpose_item(const float* W, int ldw, int K, int ncols, bf16_t* WT, int row_off, LAS float* scr, int item, int lane) {
    const int nblk = ncols / 64, kb = item / nblk, nb = item % nblk, k0 = 64 * kb, n0 = 64 * nb;
    f32x4 v[16];
#pragma unroll
    for (int i = 0; i < 16; ++i) v[i] = *(const f32x4*)(W + (size_t)(k0 + 4 * i + (lane >> 4)) * ldw + n0 + (lane & 15) * 4);
#pragma unroll
    for (int i = 0; i < 16; ++i) { LAS float* d = scr + (4 * i + (lane >> 4)) * 65 + (lane & 15) * 4; d[0] = v[i].x; d[1] = v[i].y; d[2] = v[i].z; d[3] = v[i].w; }
    LDS_WAIT();
    const int c = lane & 7;
#pragma unroll
    for (int j = 0; j < 8; ++j) { const int n = (lane >> 3) + 8 * j; const LAS float* s = scr + (8 * c) * 65 + n;
        u32x4 o; o.x = pk2(s[0 * 65], s[1 * 65]); o.y = pk2(s[2 * 65], s[3 * 65]); o.z = pk2(s[4 * 65], s[5 * 65]); o.w = pk2(s[6 * 65], s[7 * 65]);
        *(u32x4*)(WT + (size_t)(row_off + n0 + n) * K + k0 + 8 * c) = o; }
    LDS_WAIT();
}
struct RowSet { f32x4 v[4][4]; };
__device__ __forceinline__ void norm_rows_load(const Args& a, int m0, int NGW, int lane, RowSet& r) {
    constexpr int NROWS = NTOK + 2 * NMEM;
#pragma unroll
    for (int q = 0; q < 4; ++q) { int m = m0 + q * NGW; if (m >= NROWS) m = m0;
        const float* xrow = (m < NTOK) ? a.x + (size_t)m * DM : a.mem + (size_t)((m - NTOK) & (NMEM - 1)) * DM;
#pragma unroll
        for (int j = 0; j < 4; ++j) r.v[q][j] = ((const f32x4*)xrow + lane)[64 * j]; }
}
__device__ __forceinline__ void norm_phase(const Args& a) {
    const int tid = otid(); const int lane = tid & 63, gw = blockIdx.x * 8 + (tid >> 6), NGW = gridDim.x * 8;
    bf16_t* H = (bf16_t*)(a.ws + WS_H); float* rss = (float*)(a.ws + WS_RSS);
    constexpr int NROWS = NTOK + 2 * NMEM;
    f32x4 gx[4], gm0[4], gm1[4];
#pragma unroll
    for (int j = 0; j < 4; ++j) { gx[j] = ((const f32x4*)a.norm_g + lane)[64 * j]; gm0[j] = ((const f32x4*)a.mng + lane)[64 * j]; gm1[j] = ((const f32x4*)(a.mng + DM) + lane)[64 * j]; }
    RowSet cur; norm_rows_load(a, gw < NROWS ? gw : 0, NGW, lane, cur);
    for (int m0 = gw; m0 < NROWS; m0 += 4 * NGW) {
        float sacc[4];
#pragma unroll
        for (int q = 0; q < 4; ++q) { sacc[q] = 0.f;
#pragma unroll
            for (int j = 0; j < 4; ++j) sacc[q] += (cur.v[q][j].x * cur.v[q][j].x + cur.v[q][j].y * cur.v[q][j].y) + (cur.v[q][j].z * cur.v[q][j].z + cur.v[q][j].w * cur.v[q][j].w); }
        asm volatile("" ::: "memory");
        RowSet nxt; norm_rows_load(a, (m0 + 4 * NGW < NROWS) ? m0 + 4 * NGW : m0, NGW, lane, nxt);
#pragma unroll
        for (int q = 0; q < 4; ++q) {
            int m = m0 + q * NGW; if (m >= NROWS) m = m0;
            const bool tokrow = m < NTOK; const int qq = (m - NTOK) & (NMEM - 1), l = (m - NTOK) >> 11;
            bf16_t* op = tokrow ? H + (size_t)m * DM : (bf16_t*)(a.ws + (l ? WS_MEMH1 : WS_MEMH)) + (size_t)qq * DM;
            const float tot = wave_sum(sacc[q]);
            const float rr = tokrow ? 1.f : 1.f / sqrtf(tot * (1.f / DM) + EPS);
            unsigned long long* o8 = (unsigned long long*)op + lane;
#pragma unroll
            for (int j = 0; j < 4; ++j) { const f32x4 gg = tokrow ? gx[j] : (l ? gm1[j] : gm0[j]); const f32x4 v = cur.v[q][j];
                o8[64 * j] = (unsigned long long)pk2(v.x * rr * gg.x, v.y * rr * gg.y) | ((unsigned long long)pk2(v.z * rr * gg.z, v.w * rr * gg.w) << 32); }
            if (tokrow && lane < 4) rss[lane * NTOK + m] = (lane == 0) ? tot : 0.f;
        }
        cur = nxt;
    }
}
__device__ __forceinline__ void p0_phase(const Args& a, LAS unsigned char* lds) {
    const int tid = otid(), lane = tid & 63, wave = tid >> 6;
    LAS float* scr = (LAS float*)(lds + wave * 17408);
    const int gw = blockIdx.x * 8 + wave, NGW = gridDim.x * 8;
    bf16_t* WinT = (bf16_t*)(a.ws + WS_WIN); bf16_t* WoutT = (bf16_t*)(a.ws + WS_WOUT); bf16_t* WmemT = (bf16_t*)(a.ws + WS_WMEM);
    for (int it = gw; it < 3840; it += NGW) {
        const int l = it / 1920; int r = it % 1920;
        if (r < 1280) { const int seg = r >> 7, sub = r & 127; const int oseg = (int)((0x2154987630ULL >> (4 * seg)) & 15ULL);
            transpose_item(a.w_in + (size_t)l * DM * NIN + oseg * 512, NIN, DM, 512, WinT + (size_t)l * NIN * DM, seg * 512, scr, sub, lane); }
        else if (r < 1664) { r -= 1280; transpose_item(a.w_out + (size_t)l * DMIX * DM, DM, DMIX, DM, WoutT + (size_t)l * DM * DMIX, 0, scr, r, lane); }
        else { r -= 1664; transpose_item(a.wmem + (size_t)l * DM * DM, DM, DM, DM, WmemT + (size_t)l * DM * DM, 0, scr, r, lane); }
    }
    float* rope = (float*)(a.ws + WS_ROPE);
    for (int e = blockIdx.x * 512 + tid; e < NTOK * 8; e += gridDim.x * 512) {
        const int tok = e >> 3, i = e & 7;
        const float inv = powf(500000.0f, -(float)i * 0.125f);
        const float ang = (float)a.pos[tok] * inv;
        const double ad = (double)ang; const double n = rint(ad * 0.15915494309189535); const float rr = (float)(ad - n * 6.283185307179586);
        rope[tok * 16 + i] = __cosf(rr); rope[tok * 16 + 8 + i] = __sinf(rr);
    }
    if (blockIdx.x == 0) { float* LB = (float*)(a.ws + WS_LB); LB[tid] = 0.f; const float l0 = a.lbl[tid], l1 = a.lbl[512 + tid]; LB[512 + tid] = 1.f / (1.f + expf(l0 - l1)); }
    norm_phase(a);
}

#define BAR_LDS() do { asm volatile("s_waitcnt lgkmcnt(0)" ::: "memory"); __builtin_amdgcn_s_barrier(); asm volatile("" ::: "memory"); } while (0)
struct PrepIn { u32x4 q[4], k[4]; float cs[8], sn[8]; };
__device__ __forceinline__ void moba_prep_load(const Args& a, int tid, int u, PrepIn& r) {
    const int b = u >> 6, j = (u >> 3) & 7, h = u & 7, tok = tid >> 1, half = tid & 1;
    const size_t row = (size_t)b * SEQ + j * 256 + tok;
    const bf16_t* p = (const bf16_t*)(a.ws + WS_PROJ) + row * NCOL + h * 64 + half * 32;
    const bf16_t* pk = (const bf16_t*)(a.ws + WS_KC) + ((size_t)(b * 8 + h) * SEQ + j * 256 + tok) * 64 + half * 32;
#pragma unroll
    for (int c = 0; c < 4; ++c) { r.q[c] = *(const u32x4*)(p + CQA + c * 8); r.k[c] = *(const u32x4*)(pk + c * 8); }
    const f32x4* rope = (const f32x4*)((const float*)(a.ws + WS_ROPE) + row * 16);
    const f32x4 c0 = rope[0], c1 = rope[1], s0 = rope[2], s1 = rope[3];
    r.cs[0] = c0.x; r.cs[1] = c0.y; r.cs[2] = c0.z; r.cs[3] = c0.w; r.cs[4] = c1.x; r.cs[5] = c1.y; r.cs[6] = c1.z; r.cs[7] = c1.w;
    r.sn[0] = s0.x; r.sn[1] = s0.y; r.sn[2] = s0.z; r.sn[3] = s0.w; r.sn[4] = s1.x; r.sn[5] = s1.y; r.sn[6] = s1.z; r.sn[7] = s1.w;
}
__device__ __forceinline__ void moba_prep_unit(const Args& a, int l, LAS unsigned char* lds, int tid, int u, const PrepIn& in, PrepIn& nxt, int unext) {
    const int b = u >> 6, j = (u >> 3) & 7, h = u & 7, tok = tid >> 1, half = tid & 1;
    bf16_t* proj = (bf16_t*)(a.ws + WS_PROJ);
    const size_t row = (size_t)b * SEQ + j * 256 + tok;
    LAS float* kt = (LAS float*)lds;
    LAS float* part = (LAS float*)(lds + 66560);
    float vq[32], vk[32];
#pragma unroll
    for (int c = 0; c < 4; ++c) { const u32x4 uq = in.q[c], uk = in.k[c];
        vq[c * 8 + 0] = bflo(uq.x); vq[c * 8 + 1] = bfhi(uq.x); vq[c * 8 + 2] = bflo(uq.y); vq[c * 8 + 3] = bfhi(uq.y); vq[c * 8 + 4] = bflo(uq.z); vq[c * 8 + 5] = bfhi(uq.z); vq[c * 8 + 6] = bflo(uq.w); vq[c * 8 + 7] = bfhi(uq.w);
        vk[c * 8 + 0] = bflo(uk.x); vk[c * 8 + 1] = bfhi(uk.x); vk[c * 8 + 2] = bflo(uk.y); vk[c * 8 + 3] = bfhi(uk.y); vk[c * 8 + 4] = bflo(uk.z); vk[c * 8 + 5] = bfhi(uk.z); vk[c * 8 + 6] = bflo(uk.w); vk[c * 8 + 7] = bfhi(uk.w); }
    float cs[8], sn[8];
#pragma unroll
    for (int i = 0; i < 8; ++i) { cs[i] = in.cs[i]; sn[i] = in.sn[i]; }
    asm volatile("" ::: "memory");
    moba_prep_load(a, tid, unext, nxt);
#pragma unroll
    for (int which = 0; which < 2; ++which) {
        bf16_t* p = which ? (bf16_t*)(a.ws + WS_KC) + ((size_t)(b * 8 + h) * SEQ + j * 256 + tok) * 64 + half * 32 : proj + row * NCOL + CQA + h * 64 + half * 32;
        const LAS float* g = (const LAS float*)(lds + 68608) + which * 64 + half * 32;
        float v[32]; float ss = 0.f;
#pragma unroll
        for (int i = 0; i < 32; ++i) { v[i] = which ? vk[i] : vq[i]; ss += v[i] * v[i]; }
        ss += __shfl_xor(ss, 1);
        const float r = frsq(ss * (1.f / 64.f) + EPS) * (which ? 1.f : 0.125f * LOG2E);
#pragma unroll
        for (int c = 0; c < 8; ++c) { const f32x4 gg = *(const LAS f32x4*)(g + c * 4); v[c * 4] *= r * gg.x; v[c * 4 + 1] *= r * gg.y; v[c * 4 + 2] *= r * gg.z; v[c * 4 + 3] *= r * gg.w; }
        if (half == 0) {
#pragma unroll
            for (int i = 0; i < 8; ++i) { const float x1 = v[i], x2 = v[8 + i]; v[i] = x1 * cs[i] - x2 * sn[i]; v[8 + i] = x2 * cs[i] + x1 * sn[i]; }
        }
#pragma unroll
        for (int c = 0; c < 4; ++c) { u32x4 uu; uu.x = pk2(v[c * 8 + 0], v[c * 8 + 1]); uu.y = pk2(v[c * 8 + 2], v[c * 8 + 3]); uu.z = pk2(v[c * 8 + 4], v[c * 8 + 5]); uu.w = pk2(v[c * 8 + 6], v[c * 8 + 7]);
            *(u32x4*)(p + c * 8) = uu; }
        if (which == 1) {
#pragma unroll
            for (int i = 0; i < 32; ++i) kt[tok * 65 + half * 32 + i] = v[i];
        }
    }
    BAR_LDS();
    {
        const int d = tid & 63, pt = tid >> 6; float sacc = 0.f;
#pragma unroll 8
        for (int t = 0; t < 32; ++t) sacc += kt[(pt * 32 + t) * 65 + d];
        part[pt * 64 + d] = sacc;
    }
    BAR_LDS();
    if (tid < 64) { float sacc = 0.f;
#pragma unroll
        for (int p = 0; p < 8; ++p) sacc += part[p * 64 + tid];
        ((float*)(a.ws + WS_KMEAN))[((size_t)(b * 8 + h) * 8 + j) * 64 + tid] = sacc * (1.f / 256.f); }
    BAR_LDS();
}

struct HIn { u32x4 f[2], q[2], v[2]; };
template <bool NEEDQ>
__device__ __forceinline__ void hgrn_load(const Args& a, int tid, int u, HIn& r) {
    const int bh = u >> 5, c = u & 31, b = bh >> 2, hh = bh & 3; const size_t row0 = (size_t)b * SEQ + c * 64;
#pragma unroll
    for (int ii = 0; ii < 2; ++ii) { const int cid = tid + 512 * ii, t = cid >> 4, d0 = (cid & 15) * 8;
        const bf16_t* p = (const bf16_t*)(a.ws + WS_PROJ) + (row0 + t) * NCOL + hh * 128 + d0;
        r.f[ii] = *(const u32x4*)(p + CFH); r.v[ii] = *(const u32x4*)(p + CIH); if (NEEDQ) r.q[ii] = *(const u32x4*)(p + CQH); }
}
__device__ __forceinline__ void hgrn_stepA(const Args& a, int l, LAS unsigned char* lds, int tid, int hh, const HIn& in, float (&kf)[16]) {
    LAS float* LF = (LAS float*)lds;
    LAS float* PT = (LAS float*)(lds + 32768);
#pragma unroll
    for (int ii = 0; ii < 2; ++ii) {
        const int cid = tid + 512 * ii, t = cid >> 4, d0 = (cid & 15) * 8;
        const u32x4 u = in.f[ii];
        float fl[8] = {bflo(u.x), bfhi(u.x), bflo(u.y), bfhi(u.y), bflo(u.z), bfhi(u.z), bflo(u.w), bfhi(u.w)};
        float lf[8];
        const LAS float* LB = (const LAS float*)(lds + 106496) + hh * 128 + d0; const f32x4 lb0 = *(const LAS f32x4*)LB, lb1 = *(const LAS f32x4*)(LB + 4);
        const float lbv[8] = {lb0.x, lb0.y, lb0.z, lb0.w, lb1.x, lb1.y, lb1.z, lb1.w};
#pragma unroll
        for (int i = 0; i < 8; ++i) { const float lb = lbv[i]; const float sg = sigm(fl[i]);
            const float f = lb + (1.f - lb) * sg; lf[i] = __logf(f); kf[ii * 8 + i] = (1.f - lb) * (1.f - sg); }
        *(LAS f32x4*)(LF + t * 128 + d0) = (f32x4){lf[0], lf[1], lf[2], lf[3]}; *(LAS f32x4*)(LF + t * 128 + d0 + 4) = (f32x4){lf[4], lf[5], lf[6], lf[7]};
    }
}
__device__ __forceinline__ void hgrn_cumsum_scan(LAS unsigned char* lds, int tid) {
    LAS float* LF = (LAS float*)lds;
    LAS float* PT = (LAS float*)(lds + 32768);
    BAR_LDS();
    const int d = tid & 127, pt = tid >> 7;
    float v[16];
#pragma unroll
    for (int t = 0; t < 16; ++t) v[t] = LF[(pt * 16 + t) * 128 + d];
#pragma unroll
    for (int t = 1; t < 16; ++t) v[t] += v[t - 1];
    PT[pt * 128 + d] = v[15];
    BAR_LDS();
    { float off = 0.f;
#pragma unroll
      for (int p = 0; p < 3; ++p) off += (p < pt) ? PT[p * 128 + d] : 0.f;
#pragma unroll
      for (int t = 0; t < 16; ++t) LF[(pt * 16 + t) * 128 + d] = v[t] + off; }
    BAR_LDS();
}
__device__ __forceinline__ void hgrn_stage1_unit(const Args& a, int l, LAS unsigned char* lds, int tid, int u, const HIn& in, HIn& nxt, int unext) {
    const int lane = tid & 63, w = __builtin_amdgcn_readfirstlane(tid >> 6), fr = lane & 15, fq = lane >> 4;
    const int bh = u >> 5, c = u & 31, hh = bh & 3;
    LAS float* LF = (LAS float*)lds;
    LAS unsigned char* KN = lds + 34816;
    LAS unsigned char* VN = lds + 34816 + 18432;
    float kf[16];
    hgrn_stepA(a, l, lds, tid, hh, in, kf);
    hgrn_load<false>(a, tid, unext, nxt);
    hgrn_cumsum_scan(lds, tid);
    if (tid < 128) ((float*)(a.ws + WS_DECAY))[((size_t)bh * 32 + c) * 128 + tid] = fexp(LF[63 * 128 + tid]);
#pragma unroll
    for (int ii = 0; ii < 2; ++ii) {
        const int cid = tid + 512 * ii, t = cid >> 4, d0 = (cid & 15) * 8;
        const f32x4 ae0 = *(const LAS f32x4*)(LF + 63 * 128 + d0), ae1 = *(const LAS f32x4*)(LF + 63 * 128 + d0 + 4), at0 = *(const LAS f32x4*)(LF + t * 128 + d0), at1 = *(const LAS f32x4*)(LF + t * 128 + d0 + 4);
        const f32x4 e0 = ae0 - at0, e1 = ae1 - at1;
        u32x4 o; o.x = pk2(kf[ii * 8 + 0] * fexp(e0.x), kf[ii * 8 + 1] * fexp(e0.y)); o.y = pk2(kf[ii * 8 + 2] * fexp(e0.z), kf[ii * 8 + 3] * fexp(e0.w));
        o.z = pk2(kf[ii * 8 + 4] * fexp(e1.x), kf[ii * 8 + 5] * fexp(e1.y)); o.w = pk2(kf[ii * 8 + 6] * fexp(e1.z), kf[ii * 8 + 7] * fexp(e1.w));
        *(LAS u32x4*)(KN + t * 288 + d0 * 2) = o;
        *(LAS u32x4*)(VN + t * 288 + d0 * 2) = in.v[ii];
    }
    BAR_LDS();
    f32x4 acc[8];
#pragma unroll
    for (int n = 0; n < 8; ++n) acc[n] = (f32x4){0.f, 0.f, 0.f, 0.f};
#pragma unroll
    for (int ks = 0; ks < 2; ++ks) {
        const s16x4 alo = tr4(VN, 288, ks * 32 + fq * 4, w * 16, fr), ahi = tr4(VN, 288, ks * 32 + 16 + fq * 4, w * 16, fr);
        const bf16x8 af = __builtin_shufflevector(alo, ahi, 0, 1, 2, 3, 4, 5, 6, 7);
#pragma unroll
        for (int n = 0; n < 8; ++n) { const s16x4 blo = tr4(KN, 288, ks * 32 + fq * 4, n * 16, fr), bhi = tr4(KN, 288, ks * 32 + 16 + fq * 4, n * 16, fr);
            const bf16x8 bfr = __builtin_shufflevector(blo, bhi, 0, 1, 2, 3, 4, 5, 6, 7); acc[n] = MFMA16(bfr, af, acc[n]); }
    }
    bf16_t* ST = (bf16_t*)(a.ws + WS_H) + ((size_t)bh * 32 + c) * 16384;
#pragma unroll
    for (int n = 0; n < 8; ++n) { u32x2 o; o.x = pk2(acc[n][0], acc[n][1]); o.y = pk2(acc[n][2], acc[n][3]); *(u32x2*)(ST + (w * 16 + fr) * 128 + n * 16 + fq * 4) = o; }
    BAR_LDS();
}
__device__ __forceinline__ void hgrn_scan_phase(const Args& a) {
    const int id = blockIdx.x * 512 + otid(), NT = gridDim.x * 512;
    for (int it = id; it < 32 * 128 * 32; it += NT) {
        const int bh = it >> 12, dv = (it >> 5) & 127, dkc = it & 31;
        u32x2* st = (u32x2*)((bf16_t*)(a.ws + WS_H) + (size_t)bh * 32 * 16384 + dv * 128 + dkc * 4);
        const f32x4* dc = (const f32x4*)((const float*)(a.ws + WS_DECAY) + (size_t)bh * 32 * 128 + dkc * 4);
        float r0 = 0.f, r1 = 0.f, r2 = 0.f, r3 = 0.f;
#pragma unroll 8
        for (int c = 0; c < 32; ++c) {
            const u32x2 u = st[(size_t)c * 4096]; const f32x4 dd = dc[c * 32];
            u32x2 o; o.x = pk2(r0, r1); o.y = pk2(r2, r3); st[(size_t)c * 4096] = o;
            r0 = dd.x * r0 + bflo(u.x); r1 = dd.y * r1 + bfhi(u.x); r2 = dd.z * r2 + bflo(u.y); r3 = dd.w * r3 + bfhi(u.y);
        }
    }
}
__device__ __forceinline__ void hgrn_stage3_unit(const Args& a, int l, LAS unsigned char* lds, int tid, int u, const HIn& in, HIn& nxt, int unext) {
    const int lane = tid & 63, w = __builtin_amdgcn_readfirstlane(tid >> 6), fr = lane & 15, fq = lane >> 4;
    const int bh = u >> 5, c = u & 31, b = bh >> 2, hh = bh & 3; const size_t row0 = (size_t)b * SEQ + c * 64;
    const int tt = w & 3, vh = w >> 2;
    bf16_t* proj = (bf16_t*)(a.ws + WS_PROJ);
    LAS float* LF = (LAS float*)lds;
    LAS unsigned char* QM = lds + 34816;
    LAS unsigned char* Q0 = QM + 17408;
    LAS unsigned char* KM = Q0 + 17408;
    LAS unsigned char* VN = KM + 17408;
    LAS float* SSQ = (LAS float*)(VN + 18432);
    float kf[16];
    hgrn_stepA(a, l, lds, tid, hh, in, kf);
    const size_t row = row0 + tt * 16 + fr;
    const bf16_t* ST = (const bf16_t*)(a.ws + WS_H) + ((size_t)bh * 32 + c) * 16384;
    bf16x8 stf[4][4]; u32x2 zz[4];
#pragma unroll
    for (int ks = 0; ks < 4; ++ks)
#pragma unroll
        for (int v = 0; v < 4; ++v) stf[ks][v] = *(const bf16x8*)(ST + ((vh * 4 + v) * 16 + fr) * 128 + ks * 32 + fq * 8);
#pragma unroll
    for (int v = 0; v < 4; ++v) zz[v] = *(const u32x2*)(proj + row * NCOL + CZ + 512 + hh * 128 + (vh * 4 + v) * 16 + fq * 4);
    hgrn_load<true>(a, tid, unext, nxt);
    hgrn_cumsum_scan(lds, tid);
#pragma unroll
    for (int ii = 0; ii < 2; ++ii) {
        const int cid = tid + 512 * ii, t = cid >> 4, d0 = (cid & 15) * 8;
        const u32x4 uq = in.q[ii];
        float q[8] = {bflo(uq.x), bfhi(uq.x), bflo(uq.y), bfhi(uq.y), bflo(uq.z), bfhi(uq.z), bflo(uq.w), bfhi(uq.w)};
        float qm[8], q0[8], km[8];
        const f32x4 at0 = *(const LAS f32x4*)(LF + t * 128 + d0), at1 = *(const LAS f32x4*)(LF + t * 128 + d0 + 4), am0 = *(const LAS f32x4*)(LF + 31 * 128 + d0), am1 = *(const LAS f32x4*)(LF + 31 * 128 + d0 + 4);
        const float Atv[8] = {at0.x, at0.y, at0.z, at0.w, at1.x, at1.y, at1.z, at1.w}, Amv[8] = {am0.x, am0.y, am0.z, am0.w, am1.x, am1.y, am1.z, am1.w};
#pragma unroll
        for (int i = 0; i < 8; ++i) { const float At = Atv[i], Am = Amv[i]; const float sq = silu(q[i]);
            qm[i] = sq * fexp(At - Am); q0[i] = sq * fexp(At); km[i] = kf[ii * 8 + i] * fexp(Am - At); }
        u32x4 o;
        o.x = pk2(qm[0], qm[1]); o.y = pk2(qm[2], qm[3]); o.z = pk2(qm[4], qm[5]); o.w = pk2(qm[6], qm[7]); *(LAS u32x4*)(QM + t * 272 + d0 * 2) = o;
        o.x = pk2(q0[0], q0[1]); o.y = pk2(q0[2], q0[3]); o.z = pk2(q0[4], q0[5]); o.w = pk2(q0[6], q0[7]); *(LAS u32x4*)(Q0 + t * 272 + d0 * 2) = o;
        o.x = pk2(km[0], km[1]); o.y = pk2(km[2], km[3]); o.z = pk2(km[4], km[5]); o.w = pk2(km[6], km[7]); *(LAS u32x4*)(KM + t * 272 + d0 * 2) = o;
        *(LAS u32x4*)(VN + t * 288 + d0 * 2) = in.v[ii];
    }
    BAR_LDS();
    f32x4 sc[4];
#pragma unroll
    for (int s = 0; s < 4; ++s) sc[s] = (f32x4){0.f, 0.f, 0.f, 0.f};
#pragma unroll
    for (int ks = 0; ks < 4; ++ks) {
        const bf16x8 qf = *(const LAS bf16x8*)(QM + (tt * 16 + fr) * 272 + (ks * 32 + fq * 8) * 2);
#pragma unroll
        for (int s = 0; s < 4; ++s) if (s <= tt) { const bf16x8 kfr = *(const LAS bf16x8*)(KM + (s * 16 + fr) * 272 + (ks * 32 + fq * 8) * 2); sc[s] = MFMA16(kfr, qf, sc[s]); }
    }
#pragma unroll
    for (int s = 0; s < 4; ++s)
#pragma unroll
        for (int jj = 0; jj < 4; ++jj) { const bool ok = (s < tt) || (s == tt && (fq * 4 + jj) <= fr); sc[s][jj] = ok ? sc[s][jj] : 0.f; }
    f32x4 o[4];
#pragma unroll
    for (int v = 0; v < 4; ++v) o[v] = (f32x4){0.f, 0.f, 0.f, 0.f};
#pragma unroll
    for (int kst = 0; kst < 2; ++kst) {
        if (kst * 2 <= tt) {
            u32x4 pw; pw.x = pk2(sc[2 * kst][0], sc[2 * kst][1]); pw.y = pk2(sc[2 * kst][2], sc[2 * kst][3]); pw.z = pk2(sc[2 * kst + 1][0], sc[2 * kst + 1][1]); pw.w = pk2(sc[2 * kst + 1][2], sc[2 * kst + 1][3]);
            const bf16x8 pb = __builtin_bit_cast(bf16x8, pw);
#pragma unroll
            for (int v = 0; v < 4; ++v) { const s16x4 lo = tr4(VN, 288, kst * 32 + fq * 4, (vh * 4 + v) * 16, fr), hi = tr4(VN, 288, kst * 32 + 16 + fq * 4, (vh * 4 + v) * 16, fr);
                const bf16x8 vf = __builtin_shufflevector(lo, hi, 0, 1, 2, 3, 4, 5, 6, 7);
                o[v] = MFMA16(vf, pb, o[v]); }
        }
    }
#pragma unroll
    for (int ks = 0; ks < 4; ++ks) {
        const bf16x8 q0f = *(const LAS bf16x8*)(Q0 + (tt * 16 + fr) * 272 + (ks * 32 + fq * 8) * 2);
#pragma unroll
        for (int v = 0; v < 4; ++v) o[v] = MFMA16(stf[ks][v], q0f, o[v]);
    }
    float ss = 0.f;
#pragma unroll
    for (int v = 0; v < 4; ++v)
#pragma unroll
        for (int jj = 0; jj < 4; ++jj) ss += o[v][jj] * o[v][jj];
    ss += __shfl_xor(ss, 16); ss += __shfl_xor(ss, 32);
    if (fq == 0) SSQ[vh * 64 + tt * 16 + fr] = ss;
    BAR_LDS();
    const float tot = SSQ[tt * 16 + fr] + SSQ[64 + tt * 16 + fr];
    const float r = frsq(tot * (1.f / 128.f) + EPS);
#pragma unroll
    for (int v = 0; v < 4; ++v) { const int v0 = (vh * 4 + v) * 16 + fq * 4;
        const f32x4 g = *(const LAS f32x4*)((const LAS float*)(lds + 106496 + 2048) + v0);
        const u32x2 z = zz[v];
        u32x2 y; y.x = pk2(o[v][0] * r * g.x * silu(bflo(z.x)), o[v][1] * r * g.y * silu(bfhi(z.x))); y.y = pk2(o[v][2] * r * g.z * silu(bflo(z.y)), o[v][3] * r * g.w * silu(bfhi(z.y)));
        *(u32x2*)(proj + row * NCOL + CQH + hh * 128 + v0) = y; }
    BAR_LDS();
}

template <int D, int QT0>
__device__ __forceinline__ void qk_tile(const LAS unsigned char* Ks, int KP, const bf16x8 (&qf)[2][D / 32], f32x4 (&s)[4][2], int fr, int fq, float b0, float b1) {
#pragma unroll
    for (int a = 0; a < 4; ++a) { s[a][0] = (f32x4){b0, b0, b0, b0}; s[a][1] = (f32x4){b1, b1, b1, b1}; }
#pragma unroll
    for (int a = 0; a < 4; ++a)
#pragma unroll
        for (int ks = 0; ks < D / 32; ++ks) { const bf16x8 kfr = *(const LAS bf16x8*)(Ks + (a * 16 + fr) * KP + (ks * 32 + fq * 8) * 2);
            if (QT0 == 0) s[a][0] = MFMA16(kfr, qf[0][ks], s[a][0]);
            s[a][1] = MFMA16(kfr, qf[1][ks], s[a][1]); }
}
#define ONES8 ((bf16x8){16256, 16256, 16256, 16256, 16256, 16256, 16256, 16256})
template <int D, bool DIAG, int QT0>
__device__ __forceinline__ void sm_pv_tile(f32x4 (&s)[4][2], const LAS unsigned char* Vs, int VP, f32x4 (&o)[D / 16][2], f32x4 (&ol)[2], int fr, int fq, int keyl0, int qla, int qlb) {
#pragma unroll
    for (int qt = QT0; qt < 2; ++qt) {
        if (DIAG) {
            const int ql = (qt == 0 ? qla : qlb) + fr - keyl0 - fq * 4;
#pragma unroll
            for (int a = 0; a < 4; ++a)
#pragma unroll
                for (int jj = 0; jj < 4; ++jj) s[a][qt][jj] = (a * 16 + jj > ql) ? -1e30f : s[a][qt][jj];
        }
#pragma unroll
        for (int a = 0; a < 4; ++a)
#pragma unroll
            for (int jj = 0; jj < 4; ++jj) s[a][qt][jj] = ex2(s[a][qt][jj]);
    }
#pragma unroll
    for (int kst = 0; kst < 2; ++kst) {
        bf16x8 pb[2];
#pragma unroll
        for (int qt = QT0; qt < 2; ++qt) { u32x4 pw; pw.x = pk2(s[2 * kst][qt][0], s[2 * kst][qt][1]); pw.y = pk2(s[2 * kst][qt][2], s[2 * kst][qt][3]);
            pw.z = pk2(s[2 * kst + 1][qt][0], s[2 * kst + 1][qt][1]); pw.w = pk2(s[2 * kst + 1][qt][2], s[2 * kst + 1][qt][3]); pb[qt] = __builtin_bit_cast(bf16x8, pw); }
        if (QT0 == 0) ol[0] = MFMA16(ONES8, pb[0], ol[0]);
        ol[1] = MFMA16(ONES8, pb[1], ol[1]);
#pragma unroll
        for (int dt = 0; dt < D / 16; ++dt) { const s16x4 lo = tr4(Vs, VP, kst * 32 + fq * 4, dt * 16, fr), hi = tr4(Vs, VP, kst * 32 + 16 + fq * 4, dt * 16, fr);
            const bf16x8 vf = __builtin_shufflevector(lo, hi, 0, 1, 2, 3, 4, 5, 6, 7);
            if (QT0 == 0) o[dt][0] = MFMA16(vf, pb[0], o[dt][0]);
            o[dt][1] = MFMA16(vf, pb[1], o[dt][1]); }
    }
}
__device__ __forceinline__ void sm_pv_tile128(f32x4 (&sa)[4][2], f32x4 (&sb)[4][2], const LAS unsigned char* Vs, int VP, f32x4 (&o)[4][2], f32x4 (&ol)[2], int fr, int fq) {
#pragma unroll
    for (int qt = 0; qt < 2; ++qt)
#pragma unroll
        for (int a = 0; a < 4; ++a)
#pragma unroll
            for (int jj = 0; jj < 4; ++jj) { sa[a][qt][jj] = ex2(sa[a][qt][jj]); sb[a][qt][jj] = ex2(sb[a][qt][jj]); }
#pragma unroll
    for (int half = 0; half < 2; ++half)
#pragma unroll
        for (int kst = 0; kst < 2; ++kst) {
            bf16x8 pb[2];
#pragma unroll
            for (int qt = 0; qt < 2; ++qt) { const f32x4 x0 = half ? sb[2 * kst][qt] : sa[2 * kst][qt], x1 = half ? sb[2 * kst + 1][qt] : sa[2 * kst + 1][qt];
                u32x4 pw; pw.x = pk2(x0[0], x0[1]); pw.y = pk2(x0[2], x0[3]); pw.z = pk2(x1[0], x1[1]); pw.w = pk2(x1[2], x1[3]); pb[qt] = __builtin_bit_cast(bf16x8, pw); }
            ol[0] = MFMA16(ONES8, pb[0], ol[0]); ol[1] = MFMA16(ONES8, pb[1], ol[1]);
#pragma unroll
            for (int dt = 0; dt < 4; ++dt) { const s16x4 lo = tr4(Vs, VP, half * 64 + kst * 32 + fq * 4, dt * 16, fr), hi = tr4(Vs, VP, half * 64 + kst * 32 + 16 + fq * 4, dt * 16, fr);
                const bf16x8 vf = __builtin_shufflevector(lo, hi, 0, 1, 2, 3, 4, 5, 6, 7);
                o[dt][0] = MFMA16(vf, pb[0], o[dt][0]); o[dt][1] = MFMA16(vf, pb[1], o[dt][1]); }
            __builtin_amdgcn_sched_barrier(0);
        }
}
template <int D, bool DIAG, int QT0>
__device__ __forceinline__ void attn_tile(const LAS unsigned char* Ks, int KP, const LAS unsigned char* Vs, int VP, const bf16x8 (&qf)[2][D / 32], f32x4 (&o)[D / 16][2], f32x4 (&ol)[2],
                                          int fr, int fq, int keyl0, int qla, int qlb, float b0, float b1) {
    f32x4 s[4][2];
    qk_tile<D, QT0>(Ks, KP, qf, s, fr, fq, b0, b1);
    sm_pv_tile<D, DIAG, QT0>(s, Vs, VP, o, ol, fr, fq, keyl0, qla, qlb);
}

__device__ __forceinline__ void moba_unit(const Args& a, int l, LAS unsigned char* lds, int b, int h, int qb) {
    const int tid = otid(), lane = tid & 63, w = __builtin_amdgcn_readfirstlane(tid >> 6), fr = lane & 15, fq = lane >> 4;
    bf16_t* proj = (bf16_t*)(a.ws + WS_PROJ);
    LAS float* kml = (LAS float*)(lds + 77824);
    kml[tid] = ((const float*)(a.ws + WS_KMEAN))[(size_t)(b * 8 + h) * 512 + tid];
    const size_t rowbase = (size_t)b * SEQ;
    const bf16_t* Kc = (const bf16_t*)(a.ws + WS_KC) + (size_t)(b * 8 + h) * SEQ * 64; const bf16_t* Vc = (const bf16_t*)(a.ws + WS_VC) + (size_t)(b * 8 + h) * SEQ * 64;
    const int qrow[2] = {qb * 256 + w * 16, qb * 256 + (15 - w) * 16};
    bf16x8 qf[2][2];
#pragma unroll
    for (int qt = 0; qt < 2; ++qt)
#pragma unroll
        for (int ks = 0; ks < 2; ++ks) qf[qt][ks] = *(const bf16x8*)(proj + (rowbase + qrow[qt] + fr) * NCOL + CQA + h * 64 + ks * 32 + fq * 8);
    const int NT2 = (qb + 1) * 2;
    u32x4 kreg[2], vreg[2];
#define MOBA_T128(i) ((i) < 2 ? qb * 2 + (i) : (i) - 2)
#define MOBA_LOAD(t128) do { _Pragma("unroll") for (int ii = 0; ii < 2; ++ii) { const int cid = tid + 512 * ii; \
        kreg[ii] = *(const u32x4*)(Kc + (size_t)((t128) * 128) * 64 + cid * 8); \
        vreg[ii] = *(const u32x4*)(Vc + (size_t)((t128) * 128) * 64 + cid * 8); } } while (0)
#define MOBA_STORE(buf) do { _Pragma("unroll") for (int ii = 0; ii < 2; ++ii) { const int cid = tid + 512 * ii; \
        *(LAS u32x4*)(lds + (buf) * 38912 + (cid >> 3) * 144 + (cid & 7) * 16) = kreg[ii]; \
        *(LAS u32x4*)(lds + (buf) * 38912 + 18432 + (cid >> 3) * 160 + (cid & 7) * 16) = vreg[ii]; } } while (0)
    MOBA_LOAD(MOBA_T128(0));
    __syncthreads();
    unsigned selmask[2];
    if (qb <= 3) { selmask[0] = selmask[1] = (1u << qb) - 1u; }
    else {
#pragma unroll
        for (int qt = 0; qt < 2; ++qt) {
            float g[8];
#pragma unroll
            for (int j = 0; j < 8; ++j) { float psum = 0.f;
                if (j < qb) {
#pragma unroll
                    for (int ks = 0; ks < 2; ++ks)
#pragma unroll
                        for (int i = 0; i < 8; ++i) psum += bf2f(qf[qt][ks][i]) * kml[j * 64 + ks * 32 + fq * 8 + i];
                    psum += __shfl_xor(psum, 16); psum += __shfl_xor(psum, 32);
                }
                g[j] = (j < qb) ? psum : -INFINITY; }
            unsigned msk = 0u;
#pragma unroll
            for (int j = 0; j < 8; ++j) { int rank = 0;
#pragma unroll
                for (int mth = 0; mth < 8; ++mth) if (mth != j) rank += (g[mth] > g[j] || (g[mth] == g[j] && mth < j)) ? 1 : 0;
                if (j < qb && rank < 3) msk |= (1u << j); }
            selmask[qt] = msk;
        }
    }
    f32x4 o[4][2];
#pragma unroll
    for (int dt = 0; dt < 4; ++dt) { o[dt][0] = (f32x4){0.f, 0.f, 0.f, 0.f}; o[dt][1] = (f32x4){0.f, 0.f, 0.f, 0.f}; }
    const float gm = *(const LAS float*)(lds + 80000);
    f32x4 ol[2] = {(f32x4){0.f, 0.f, 0.f, 0.f}, (f32x4){0.f, 0.f, 0.f, 0.f}};
    MOBA_STORE(0);
    BAR_LDS();
    u32x2 zq[2][4];
    for (int i = 0; i < NT2; ++i) {
        if (i + 1 < NT2) { const int tn = MOBA_T128(i + 1); MOBA_LOAD(tn); }
        else {
#pragma unroll
            for (int qt = 0; qt < 2; ++qt)
#pragma unroll
                for (int dt = 0; dt < 4; ++dt) zq[qt][dt] = *(const u32x2*)(proj + (rowbase + qrow[qt] + fr) * NCOL + CZ + h * 64 + dt * 16 + fq * 4); }
        const int t128 = MOBA_T128(i), j = t128 >> 1, hb = t128 & 1; const bool diag = (j == qb);
        const LAS unsigned char* Kb = lds + (i & 1) * 38912;
        const unsigned rs0 = diag ? 1u : ((selmask[0] >> j) & 1u), rs1 = diag ? 1u : ((selmask[1] >> j) & 1u);
        if (!diag) {
            const float b0 = rs0 ? -gm : -1e30f, b1 = rs1 ? -gm : -1e30f;
            attn_tile<64, false, 0>(Kb, 144, Kb + 18432, 160, qf, o, ol, fr, fq, 0, 0, 0, b0, b1);
            attn_tile<64, false, 0>(Kb + 64 * 144, 144, Kb + 18432 + 64 * 160, 160, qf, o, ol, fr, fq, 0, 0, 0, b0, b1);
        } else
#pragma unroll
        for (int sub = 0; sub < 2; ++sub) {
            const int ktl = hb * 2 + sub;
            if (diag) {
                if (ktl <= (w >> 2)) attn_tile<64, true, 0>(Kb + sub * 64 * 144, 144, Kb + 18432 + sub * 64 * 160, 160, qf, o, ol, fr, fq, ktl * 64, w * 16, (15 - w) * 16, -gm, -gm);
                else if (ktl <= ((15 - w) >> 2)) attn_tile<64, true, 1>(Kb + sub * 64 * 144, 144, Kb + 18432 + sub * 64 * 160, 160, qf, o, ol, fr, fq, ktl * 64, w * 16, (15 - w) * 16, -gm, -gm);
            } else attn_tile<64, false, 0>(Kb + sub * 64 * 144, 144, Kb + 18432 + sub * 64 * 160, 160, qf, o, ol, fr, fq, 0, 0, 0, rs0 ? -gm : -1e30f, rs1 ? -gm : -1e30f);
        }
        if (i + 1 < NT2) MOBA_STORE((i + 1) & 1);
        BAR_LDS();
    }
#undef MOBA_T128
#undef MOBA_LOAD
#undef MOBA_STORE
#pragma unroll
    for (int qt = 0; qt < 2; ++qt) {
        const float inv = frcp(ol[qt][0]);
        const size_t row = rowbase + qrow[qt] + fr;
#pragma unroll
        for (int dt = 0; dt < 4; ++dt) { const int d0 = dt * 16 + fq * 4;
            const u32x2 z = zq[qt][dt];
            u32x2 y; y.x = pk2(o[dt][qt][0] * inv * silu(bflo(z.x)), o[dt][qt][1] * inv * silu(bfhi(z.x))); y.y = pk2(o[dt][qt][2] * inv * silu(bflo(z.y)), o[dt][qt][3] * inv * silu(bfhi(z.y)));
            *(u32x2*)(proj + row * NCOL + CQA + h * 64 + d0) = y; }
    }
    __syncthreads();
}

__device__ __forceinline__ void mem_unit(const Args& a, int l, LAS unsigned char* lds, int b, int hm, int qb) {
    const int tid = otid(), lane = tid & 63, w = __builtin_amdgcn_readfirstlane(tid >> 6), fr = lane & 15, fq = lane >> 4;
    bf16_t* proj = (bf16_t*)(a.ws + WS_PROJ);
    const bf16_t* kvm = (const bf16_t*)(a.ws + WS_KVM) + (size_t)b * MEML * 1024;
    const size_t rowbase = (size_t)b * SEQ; const int q0 = qb * 256 + w * 32;
    u32x4 ukr[2], uvr[2];
#define MEM_LOAD(kt) do { _Pragma("unroll") for (int ii = 0; ii < 2; ++ii) { const int cid = tid + 512 * ii; \
        ukr[ii] = *(const u32x4*)(kvm + (size_t)((kt) * 64 + (cid >> 4)) * 1024 + hm * 128 + (cid & 15) * 8); \
        uvr[ii] = *(const u32x4*)(kvm + (size_t)((kt) * 64 + (cid >> 4)) * 1024 + 512 + hm * 128 + (cid & 15) * 8); } } while (0)
    const f32x4 g0 = *(const f32x4*)(a.memkn + l * 128 + (tid & 15) * 8), g1 = *(const f32x4*)(a.memkn + l * 128 + (tid & 15) * 8 + 4);
    MEM_LOAD(0);
    bf16x8 qf[2][4];
#pragma unroll
    for (int qt = 0; qt < 2; ++qt) {
        u32x4 u[4]; float ss = 0.f;
#pragma unroll
        for (int ks = 0; ks < 4; ++ks) { u[ks] = *(const u32x4*)(proj + (rowbase + q0 + qt * 16 + fr) * NCOL + CQM + hm * 128 + ks * 32 + fq * 8);
            ss += bflo(u[ks].x) * bflo(u[ks].x) + bfhi(u[ks].x) * bfhi(u[ks].x) + bflo(u[ks].y) * bflo(u[ks].y) + bfhi(u[ks].y) * bfhi(u[ks].y)
                + bflo(u[ks].z) * bflo(u[ks].z) + bfhi(u[ks].z) * bfhi(u[ks].z) + bflo(u[ks].w) * bflo(u[ks].w) + bfhi(u[ks].w) * bfhi(u[ks].w); }
        ss += __shfl_xor(ss, 16); ss += __shfl_xor(ss, 32);
        const float r = frsq(ss * (1.f / 128.f) + EPS) * (0.08838834764831845f * LOG2E);
#pragma unroll
        for (int ks = 0; ks < 4; ++ks) { const float* g = a.memqn + l * 128 + ks * 32 + fq * 8; const f32x4 g0 = *(const f32x4*)g, g1 = *(const f32x4*)(g + 4);
            u32x4 o; o.x = pk2(bflo(u[ks].x) * r * g0.x, bfhi(u[ks].x) * r * g0.y); o.y = pk2(bflo(u[ks].y) * r * g0.z, bfhi(u[ks].y) * r * g0.w);
            o.z = pk2(bflo(u[ks].z) * r * g1.x, bfhi(u[ks].z) * r * g1.y); o.w = pk2(bflo(u[ks].w) * r * g1.z, bfhi(u[ks].w) * r * g1.w);
            qf[qt][ks] = __builtin_bit_cast(bf16x8, o); }
    }
    f32x4 o[8][2];
#pragma unroll
    for (int dt = 0; dt < 8; ++dt) { o[dt][0] = (f32x4){0.f, 0.f, 0.f, 0.f}; o[dt][1] = (f32x4){0.f, 0.f, 0.f, 0.f}; }
    const float gm = *(const LAS float*)(lds + 80004);
    f32x4 ol[2] = {(f32x4){0.f, 0.f, 0.f, 0.f}, (f32x4){0.f, 0.f, 0.f, 0.f}};
    LAS unsigned char* Ks = lds;
    LAS unsigned char* Vs = lds + 17408;
#define MEM_STORE(buf) do { _Pragma("unroll") for (int ii = 0; ii < 2; ++ii) { \
            const int cid = tid + 512 * ii, key = cid >> 4, dc = cid & 15; \
            const u32x4 uk = ukr[ii]; \
            float kv[8] = {bflo(uk.x), bfhi(uk.x), bflo(uk.y), bfhi(uk.y), bflo(uk.z), bfhi(uk.z), bflo(uk.w), bfhi(uk.w)}; \
            float ss = 0.f; \
            _Pragma("unroll") for (int i = 0; i < 8; ++i) ss += kv[i] * kv[i]; \
            ss += __shfl_xor(ss, 1); ss += __shfl_xor(ss, 2); ss += __shfl_xor(ss, 4); ss += __shfl_xor(ss, 8); \
            const float r = frsq(ss * (1.f / 128.f) + EPS); \
            u32x4 ok; ok.x = pk2(kv[0] * r * g0.x, kv[1] * r * g0.y); ok.y = pk2(kv[2] * r * g0.z, kv[3] * r * g0.w); ok.z = pk2(kv[4] * r * g1.x, kv[5] * r * g1.y); ok.w = pk2(kv[6] * r * g1.z, kv[7] * r * g1.w); \
            *(LAS u32x4*)(Ks + (buf) * 35840 + key * 272 + dc * 16) = ok; \
            *(LAS u32x4*)(Vs + (buf) * 35840 + key * 288 + dc * 16) = uvr[ii]; } } while (0)
    MEM_STORE(0);
    BAR_LDS();
    for (int kt = 0; kt < 4; ++kt) {
        if (kt < 3) MEM_LOAD(kt + 1);
        attn_tile<128, false, 0>(Ks + (kt & 1) * 35840, 272, Vs + (kt & 1) * 35840, 288, qf, o, ol, fr, fq, 0, 0, 0, -gm, -gm);
        if (kt < 3) MEM_STORE((kt + 1) & 1);
        BAR_LDS();
    }
#undef MEM_STORE
#undef MEM_LOAD
#pragma unroll
    for (int qt = 0; qt < 2; ++qt) {
        const float inv = frcp(ol[qt][0]);
        const size_t row = rowbase + q0 + qt * 16 + fr;
#pragma unroll
        for (int dt = 0; dt < 8; ++dt) { const int d0 = dt * 16 + fq * 4;
            const u32x2 z = *(const u32x2*)(proj + row * NCOL + CZ + 1024 + hm * 128 + d0);
            u32x2 y; y.x = pk2(o[dt][qt][0] * inv * silu(bflo(z.x)), o[dt][qt][1] * inv * silu(bfhi(z.x))); y.y = pk2(o[dt][qt][2] * inv * silu(bflo(z.y)), o[dt][qt][3] * inv * silu(bfhi(z.y)));
            *(u32x2*)(proj + row * NCOL + CQM + hm * 128 + d0) = y; }
    }
}

#define XB_TMO      128
#define XB_XCNT(j)  (256  + 64 * (j))
#define XB_XSUB(j)  (1280 + 64 * (j))
#define XB_XGEN(j)  (2304 + 64 * (j))
#define XB_TOP      3328
#define XB_TOPGEN   3392
#define XCD_BAR_WORDS 3456
#define XB_SPIN_CAP (1u << 18)
__device__ __forceinline__ unsigned xb_ld(unsigned* p)              { return __hip_atomic_load(p, __ATOMIC_RELAXED, __HIP_MEMORY_SCOPE_AGENT); }
__device__ __forceinline__ unsigned xb_add(unsigned* p, unsigned v) { return __hip_atomic_fetch_add(p, v, __ATOMIC_RELAXED, __HIP_MEMORY_SCOPE_AGENT); }
__device__ __forceinline__ unsigned xb_xcc_id() { return (unsigned)__builtin_amdgcn_s_getreg((3 << 11) | 20) & 0xFu; }
#define XB_SPIN(cond, bar) do { unsigned _sp = 0; while (cond) { __builtin_amdgcn_s_sleep(1); \
    if ((++_sp & 255u) == 0u) { if (xb_ld(&(bar)[XB_TMO])) break; if (_sp > XB_SPIN_CAP) { atomicAdd(&(bar)[XB_TMO], 1u); break; } } } } while (0)
struct XcdBarrier { unsigned* bar; unsigned x; volatile LAS unsigned* st; };
__device__ __forceinline__ XcdBarrier xcd_barrier_post(unsigned* bar, volatile LAS unsigned* st) {
    XcdBarrier b; b.bar = bar; b.x = xb_xcc_id(); b.st = st;
    if (threadIdx.x == 0) (void)xb_add(&bar[XB_XCNT(b.x)], 1u);
    return b;
}
__device__ __forceinline__ void xcd_barrier_complete(unsigned* bar, unsigned x, unsigned& nloc, unsigned& nx) {
    const unsigned G = gridDim.x * gridDim.y * gridDim.z;
    unsigned sum, cnt, mine, sp = 0u;
    for (;;) {
        sum = 0u; cnt = 0u; mine = 0u;
#pragma unroll
        for (unsigned j = 0; j < 16; ++j) { const unsigned c = xb_ld(&bar[XB_XCNT(j)]); sum += c; cnt += (c > 0u) ? 1u : 0u; mine = (j == x) ? c : mine; }
        if (sum == G) break;
        __builtin_amdgcn_s_sleep(1);
        if ((++sp & 255u) == 0u) { if (xb_ld(&bar[XB_TMO])) break; if (sp > XB_SPIN_CAP) { atomicAdd(&bar[XB_TMO], 1u); break; } }
    }
    nloc = mine > 0u ? mine : 1u; nx = cnt > 0u ? cnt : 1u;
}
__device__ __forceinline__ void xcd_barrier(const XcdBarrier& b) {
    asm volatile("s_waitcnt vmcnt(0)" ::: "memory");
    __syncthreads();
    if (threadIdx.x == 0) {
        unsigned* bar = b.bar;
        __builtin_amdgcn_s_waitcnt(0);
        unsigned nloc = b.st[0], nx = b.st[1];
        if (nloc == 0u) { xcd_barrier_complete(bar, b.x, nloc, nx); b.st[0] = nloc; b.st[1] = nx; }
        const unsigned old = xb_add(&bar[XB_XSUB(b.x)], 1u);
        const unsigned gen = old / nloc;
        if (old + 1u == (gen + 1u) * nloc) {
            __builtin_amdgcn_fence(__ATOMIC_RELEASE, "agent");
            asm volatile("s_waitcnt vmcnt(0)" ::: "memory");
            const unsigned og = xb_add(&bar[XB_TOP], 1u);
            const unsigned tg = og / nx;
            if (og + 1u == (tg + 1u) * nx) xb_add(&bar[XB_TOPGEN], 1u);
            else XB_SPIN(xb_ld(&bar[XB_TOPGEN]) == tg, bar);
            __builtin_amdgcn_fence(__ATOMIC_ACQUIRE, "agent");
            xb_add(&bar[XB_XGEN(b.x)], 1u);
            asm volatile("s_waitcnt vmcnt(0)" ::: "memory");
        } else {
            XB_SPIN(xb_ld(&bar[XB_XGEN(b.x)]) == gen, bar);
            __builtin_amdgcn_fence(__ATOMIC_ACQUIRE, "agent");
            asm volatile("s_waitcnt vmcnt(0)" ::: "memory");
        }
    }
    __syncthreads();
}

__global__ void __launch_bounds__(512) hymba_fwd(Args a) {
    extern __shared__ __attribute__((aligned(16))) unsigned char lds_raw[];
    LAS unsigned char* lds = (LAS unsigned char*)lds_raw;
    const int G = gridDim.x, bx = blockIdx.x;
    const int lo = a.ph_lo, hi = a.ph_hi;
    bf16_t* proj = (bf16_t*)(a.ws + WS_PROJ);
#define IN(k) (lo <= (k) && (k) < hi)
#define SEAM(k) do { if (IN(k) && IN((k) + 1)) { if (a.pad == 0x5eed) cg::this_grid().sync(); xcd_barrier(xbar); } } while (0)
    volatile LAS unsigned* xst = (volatile LAS unsigned*)(lds + LDS_BYTES - 16);
    if (threadIdx.x < 2) xst[threadIdx.x] = 0u;
    __syncthreads();
    XcdBarrier xbar; xbar.bar = (unsigned*)(a.ws + WS_BAR); xbar.x = 0; xbar.st = xst;
    if (hi - lo > 1) xbar = xcd_barrier_post((unsigned*)(a.ws + WS_BAR), xst);
    if (IN(0)) { p0_phase(a, lds); __syncthreads(); }
    SEAM(0);
#pragma unroll 1
    for (int l = 0; l < 2; ++l) {
        const int base = 1 + 5 * l;
        if (IN(base)) {
            {
            pg8::Gemm g{(const bf16_t*)(a.ws + WS_H), (const bf16_t*)(a.ws + WS_WIN) + (size_t)l * NIN * DM, NTOK, NIN, DM, DM};
            pg8::StaticOrder S; S.init(NTOK, NIN, G, bx);
            pg8::EpiBf16Scale E{proj, NCOL, (bf16_t*)(a.ws + WS_KC), (bf16_t*)(a.ws + WS_VC)};
            if (G == 256) {
                pg8::Unit u0; if (S.next(0, u0) && threadIdx.x < 256) { const float* rss = (const float*)(a.ws + WS_RSS) + u0.pm * 256 + threadIdx.x;
                    ((LAS float*)(lds + 131072))[threadIdx.x] = frsq(((rss[0] + rss[NTOK]) + (rss[2 * NTOK] + rss[3 * NTOK])) * (1.f / 1024.f) + EPS); }
                __syncthreads();
                pg8::gemm_phase<pg8::EpiBf16Scale, pg8::StaticOrder>(lds, g, S, E);
            } else {
                for (int i = 0; ; ++i) { pg8::Unit u0; if (!S.next(i, u0)) break;
                    if (threadIdx.x < 256) { const float* rss = (const float*)(a.ws + WS_RSS) + u0.pm * 256 + threadIdx.x;
                        ((LAS float*)(lds + 131072))[threadIdx.x] = frsq(((rss[0] + rss[NTOK]) + (rss[2 * NTOK] + rss[3 * NTOK])) * (1.f / 1024.f) + EPS); }
                    __syncthreads();
                    pg8::StaticOrder S1; S1.init(NTOK, NIN, 1 << 30, i * G + bx);
                    pg8::gemm_phase<pg8::EpiBf16Scale, pg8::StaticOrder>(lds, g, S1, E); __syncthreads(); }
            }
            __syncthreads();
            }
        }
        SEAM(base);
        if (IN(base + 1)) {
            const int NKV = (G >= 64) ? 32 : 0;
            {
            {
                pg8::Gemm g{(const bf16_t*)(a.ws + (l ? WS_MEMH1 : WS_MEMH)), (const bf16_t*)(a.ws + WS_WMEM) + (size_t)l * DM * DM, NMEM, 1024, DM, DM};
                pg8::StaticOrder S; S.init(NMEM, 1024, G, bx);
                pg8::EpiBf16 E{(bf16_t*)(a.ws + WS_KVM), 1024};
                pg8::gemm_phase<pg8::EpiBf16, pg8::StaticOrder>(lds, g, S, E);
                __syncthreads();
            }
            if (bx >= NKV) {
                const int wb = bx - NKV, WG = G - NKV;
                const int tid = otid();
                if (tid < 128) ((LAS float*)(lds + 68608))[tid] = (tid < 64) ? a.mqn[l * 64 + tid] : a.mkn[l * 64 + tid - 64];
                if (tid < 512) ((LAS float*)(lds + 106496))[tid] = ((const float*)(a.ws + WS_LB))[l * 512 + tid];
                __syncthreads();
                { PrepIn cur; int u = wb; moba_prep_load(a, tid, u < 512 ? u : 0, cur);
                  for (; u < 512; u += WG) { PrepIn nxt; moba_prep_unit(a, l, lds, tid, u, cur, nxt, (u + WG < 512) ? u + WG : u); cur = nxt; } }
                { HIn cur; int u = (wb + 160) % WG;     hgrn_load<false>(a, tid, u < 1024 ? u : 0, cur);
                  for (; u < 1024; u += WG) { HIn nxt; hgrn_stage1_unit(a, l, lds, tid, u, cur, nxt, (u + WG < 1024) ? u + WG : u); cur = nxt; } }
                __syncthreads();
            }
            }
        }
        SEAM(base + 1);
        if (IN(base + 2)) {
            { const int lane = threadIdx.x & 63;
              float xq = fabsf(a.mqn[l * 64 + lane]), xk = fabsf(a.mkn[l * 64 + lane]);
              float yq = fmaxf(fabsf(a.memqn[l * 128 + lane]), fabsf(a.memqn[l * 128 + 64 + lane])), yk = fmaxf(fabsf(a.memkn[l * 128 + lane]), fabsf(a.memkn[l * 128 + 64 + lane]));
#pragma unroll
              for (int ofs = 1; ofs < 64; ofs <<= 1) { xq = fmaxf(xq, __shfl_xor(xq, ofs)); xk = fmaxf(xk, __shfl_xor(xk, ofs)); yq = fmaxf(yq, __shfl_xor(yq, ofs)); yk = fmaxf(yk, __shfl_xor(yk, ofs)); }
              if (threadIdx.x == 0) { ((LAS float*)(lds + 80000))[0] = xq * xk * (8.f * 1.03f * LOG2E); ((LAS float*)(lds + 80000))[1] = yq * yk * (11.3137085f * 1.03f * LOG2E); }
              __syncthreads(); }
            {
                for (int u = bx; u < 512; u += G) {
                    int bh, qb; if (G == 256) { bh = bx >> 2; const int s = bx & 3; qb = (u < 256) ? 7 - s : s; } else { bh = u >> 3; qb = 7 - (u & 7); }
                    moba_unit(a, l, lds, bh >> 3, bh & 7, qb);
                }
            }
            for (int u = bx; u < 256; u += G) mem_unit(a, l, lds, u >> 5, (u >> 3) & 3, u & 7);
            hgrn_scan_phase(a);
            __syncthreads();
        }
        SEAM(base + 2);
        if (IN(base + 3)) {
            { const int tid = otid();
              if (tid < 512) ((LAS float*)(lds + 106496))[tid] = ((const float*)(a.ws + WS_LB))[l * 512 + tid];
              if (tid < 128) ((LAS float*)(lds + 106496 + 2048))[tid] = a.hon[l * 128 + tid];
              __syncthreads();
              HIn cur; int u = bx; hgrn_load<true>(a, tid, u < 1024 ? u : 0, cur);
                for (; u < 1024; u += G) { HIn nxt; hgrn_stage3_unit(a, l, lds, tid, u, cur, nxt, (u + G < 1024) ? u + G : u); cur = nxt; } }
            __syncthreads();
        }
        SEAM(base + 3);
        if (IN(base + 4)) {
            pg8::Gemm g{proj, (const bf16_t*)(a.ws + WS_WOUT) + (size_t)l * DM * DMIX, NTOK, DM, DMIX, NCOL};
            pg8::StaticOrder S; S.init(NTOK, DM, G, bx);
            if (l == 0) { {
                pg8::EpiResF32Norm E{a.x, a.out, DM, a.norm_g + DM, (bf16_t*)(a.ws + WS_H), (float*)(a.ws + WS_RSS)};
                pg8::gemm_phase<pg8::EpiResF32Norm, pg8::StaticOrder>(lds, g, S, E); __syncthreads(); } }
            else { pg8::EpiResF32 E{(const float*)a.out, a.out, DM};
                pg8::gemm_phase<pg8::EpiResF32, pg8::StaticOrder>(lds, g, S, E); __syncthreads(); }
        }
        if (l == 0) SEAM(base + 4);
    }
#undef IN
#undef SEAM
}

extern "C" void kernel_launch(void* const* d_in, const int* in_sizes, int n_in, void* d_out, int out_size, void* d_ws, size_t ws_size, hipStream_t stream) {
    static int grid = 0;
    if (grid == 0) {
        if (n_in != 14 || out_size != NTOK * DM || ws_size < WS_BAR + 65536) { fprintf(stderr, "kernel_launch: unexpected shapes (n_in %d out %d ws %zu)\n", n_in, out_size, ws_size); grid = -1; return; }
        int dev = 0, cus = 0, per_cu = 0;
        hipGetDevice(&dev); hipDeviceGetAttribute(&cus, hipDeviceAttributeMultiprocessorCount, dev);
        if (hipFuncSetAttribute((const void*)hymba_fwd, hipFuncAttributeMaxDynamicSharedMemorySize, LDS_BYTES) != hipSuccess) { fprintf(stderr, "kernel_launch: hipFuncSetAttribute failed\n"); grid = -1; return; }
        if (hipOccupancyMaxActiveBlocksPerMultiprocessor(&per_cu, (const void*)hymba_fwd, 512, LDS_BYTES) != hipSuccess || per_cu < 1) { fprintf(stderr, "kernel_launch: occupancy query says %d\n", per_cu); per_cu = 1; }
        (void)hipGetLastError();
        grid = cus * (per_cu > 1 ? 1 : per_cu);
    }
    if (grid < 0) return;
    if (hipMemsetAsync((char*)d_ws + WS_BAR, 0, XCD_BAR_WORDS * 4, stream) != hipSuccess) { fprintf(stderr, "kernel_launch: memset failed\n"); return; }
    Args a{};
    a.x = (const float*)d_in[0]; a.mem = (const float*)d_in[1]; a.pos = (const int*)d_in[2]; a.norm_g = (const float*)d_in[3]; a.w_in = (const float*)d_in[4]; a.w_out = (const float*)d_in[5];
    a.mqn = (const float*)d_in[6]; a.mkn = (const float*)d_in[7]; a.lbl = (const float*)d_in[8]; a.hon = (const float*)d_in[9]; a.mng = (const float*)d_in[10]; a.wmem = (const float*)d_in[11];
    a.memqn = (const float*)d_in[12]; a.memkn = (const float*)d_in[13]; a.out = (float*)d_out; a.ws = (unsigned char*)d_ws; a.rep = 0;
#if MK_ONE_LAUNCH
    a.ph_lo = 0; a.ph_hi = NPHASE;
    void* args[] = {&a};
    hipError_t e = hipLaunchCooperativeKernel((const void*)hymba_fwd, dim3(grid), dim3(512), args, LDS_BYTES, stream);
    if (e != hipSuccess) fprintf(stderr, "cooperative launch failed: %s (grid %d)\n", hipGetErrorString(e), grid);
#else
    for (int p = 0; p < NPHASE; ++p) { a.ph_lo = p; a.ph_hi = p + 1; hipLaunchKernelGGL(hymba_fwd, dim3(grid), dim3(512), LDS_BYTES, stream, a); }
#endif
}
```
